# Optimizing an MI355X kernel written in HIP

```python
import math
import jax, jax.numpy as jnp
from jax import lax
import numpy as np

D_MODEL = 1024
BATCH = 4
SEQ = 8192
DEPTH = 4

CTX_LEN = 256
GRID_W = 64
N_MIXERS = 4
ALPHA = (2 * DEPTH) ** 0.25
BETA = (8 * DEPTH) ** -0.25
LN_EPS = 1e-5
ATT_HEADS = 8
ATT_HEAD_DIM = D_MODEL // (2 * ATT_HEADS)
ROPE_THETA = 10000.0
Q_BLOCK = 128
POOL_WINDOWS = (2, 4, 8, 16)
POOL_GROUP = D_MODEL // len(POOL_WINDOWS)
FFT_GROUPS = 4
FFT_GROUP = D_MODEL // FFT_GROUPS
HY_BANDS = 16
HY_EMB = 2 * HY_BANDS + 1
HY_FILTER_HIDDEN = 64
HY_TARGET = 1e-2
HY_FAST = 0.3
HY_SLOW = 1.5
N_EXPERTS = 16
N_GROUPS = 4
EXPERTS_PER_GROUP = N_EXPERTS // N_GROUPS
TOP_K = 2
D_EXPERT = 1024
MOE_BLOCK = 256

kernel_name = "hybrid_diffusion_interleaved_moe_trunk"


def n_layers_of(kind):
    return len(range(kind, DEPTH, N_MIXERS))


def ctx_needed(i):
    return any(j % N_MIXERS == 0 for j in range(i, DEPTH))


def layer_norm(x, g, b):
    xf = x.astype(jnp.float32)
    mu = xf.mean(-1, keepdims=True)
    var = jnp.square(xf - mu).mean(-1, keepdims=True)
    return ((xf - mu) * lax.rsqrt(var + LN_EPS) * g.astype(jnp.float32) + b.astype(jnp.float32)).astype(x.dtype)


def deepnorm_update(x, y, gate, g, b):
    return layer_norm(ALPHA * x + (1.0 + gate) * y, g, b)


def axial_rope_tables(n_tokens):
    rows = n_tokens // GRID_W
    row = jnp.repeat(jnp.arange(rows), GRID_W).astype(jnp.float32)
    col = jnp.tile(jnp.arange(GRID_W), rows).astype(jnp.float32)
    half = ATT_HEAD_DIM // 2
    inv = ROPE_THETA ** (-jnp.arange(0, half, 2, dtype=jnp.float32) / half)
    ar = row[:, None] * inv
    ac = col[:, None] * inv
    ang = jnp.concatenate([ar, ar, ac, ac], axis=-1)
    return jnp.cos(ang), jnp.sin(ang)


def apply_axial_rope(x, cos, sin):
    a, b, c, d = jnp.split(x, 4, axis=-1)
    rot = jnp.concatenate([-b, a, -d, c], axis=-1)
    cos = cos[None, :, None, None, :].astype(x.dtype)
    sin = sin[None, :, None, None, :].astype(x.dtype)
    return x * cos + rot * sin


def attn_qkv(h, wqkv):
    B, L, _ = h.shape
    q, k, v = jnp.split(h @ wqkv, 3, axis=-1)
    q = q.reshape(B, L, ATT_HEADS, 2, ATT_HEAD_DIM)
    k = k.reshape(B, L, ATT_HEADS, 2, ATT_HEAD_DIM)
    v = v.reshape(B, L, ATT_HEADS, 2 * ATT_HEAD_DIM)
    return q, k, v


def diff_attention(q, k, v, lam, subln, wo, lam_init):
    B, Lq = q.shape[0], q.shape[1]
    lf = lam.astype(jnp.float32)
    lam_full = jnp.exp(jnp.sum(lf[0] * lf[1])) - jnp.exp(jnp.sum(lf[2] * lf[3])) + lam_init
    scale = ATT_HEAD_DIM ** -0.5

    def block(qb):
        s = jnp.einsum('bqhnd,bkhnd->nbhqk', qb, k).astype(jnp.float32) * scale
        p = jax.nn.softmax(s, axis=-1)
        a = p[0] - lam_full * p[1]
        return jnp.einsum('bhqk,bkhe->bqhe', a.astype(v.dtype), v)

    nb = Lq // Q_BLOCK
    qb = q.reshape(B, nb, Q_BLOCK, ATT_HEADS, 2, ATT_HEAD_DIM).swapaxes(0, 1)
    o = lax.map(block, qb)
    o = o.swapaxes(0, 1).reshape(B, Lq, ATT_HEADS, 2 * ATT_HEAD_DIM).astype(jnp.float32)
    o = o * lax.rsqrt(jnp.mean(jnp.square(o), axis=-1, keepdims=True) + LN_EPS)
    o = o * subln.astype(jnp.float32) * (1.0 - lam_init)
    return o.reshape(B, Lq, D_MODEL).astype(q.dtype) @ wo


def pool_mixer(h, w, scale):
    B, L, D = h.shape
    hf = h.astype(jnp.float32)
    csum = jnp.concatenate([jnp.zeros((B, 1, D), jnp.float32), jnp.cumsum(hf, axis=1)], axis=1)
    t = jnp.arange(L)
    groups = []
    for g, win in enumerate(POOL_WINDOWS):
        lo = jnp.clip(t - win // 2, 0, L)
        hi = jnp.clip(t - win // 2 + win, 0, L)
        sl = slice(g * POOL_GROUP, (g + 1) * POOL_GROUP)
        cs = csum[:, :, sl]
        mean = (cs[:, hi] - cs[:, lo]) / (hi - lo).astype(jnp.float32)[:, None]
        groups.append(mean - hf[:, :, sl])
    pooled = jnp.stack(groups, axis=2).astype(h.dtype)
    y = jnp.einsum('blgd,gde->blge', pooled, w).reshape(B, L, D)
    return y * scale


def fourier_mixer(h, w, b):
    B, L, D = h.shape
    hg = h.astype(jnp.float32).reshape(B, L, FFT_GROUPS, FFT_GROUP)
    f = jnp.fft.fft2(hg, axes=(1, 3), norm="ortho").real
    return f.reshape(B, L, D).astype(h.dtype) @ w + b


def hyena_filters(L, f1, fb1, f2, fb2, f3, freq):
    f32 = jnp.float32
    pos = jnp.arange(L, dtype=f32)
    t = pos / L
    bands = jnp.linspace(1e-4, HY_BANDS - 1, HY_BANDS, dtype=f32)
    ang = (2.0 * math.pi / L) * pos[:, None] * bands[None, :]
    z = jnp.concatenate([t[:, None], jnp.cos(ang), jnp.sin(ang)], axis=-1)
    fr = freq.astype(f32)
    a = jnp.sin(fr * (z @ f1.astype(f32) + fb1.astype(f32)))
    a = jnp.sin(fr * (a @ f2.astype(f32) + fb2.astype(f32)))
    k = a @ f3.astype(f32)
    deltas = jnp.abs(jnp.linspace(math.log(HY_TARGET) / HY_SLOW, math.log(HY_TARGET) / HY_FAST, D_MODEL, dtype=f32))
    window = jnp.exp(-t[:, None] * deltas[None, :])
    return k[:, :D_MODEL] * window, k[:, D_MODEL:] * window


def hyena_mixer(h, win, bin_, conv_w, conv_b, f1, fb1, f2, fb2, f3, freq, skip, wo, bo):
    B, L, D = h.shape
    z = h @ win + bin_
    zp = jnp.pad(z, ((0, 0), (1, 1), (0, 0)))
    z = zp[:, :-2] * conv_w[0] + zp[:, 1:-1] * conv_w[1] + zp[:, 2:] * conv_w[2] + conv_b
    x0, x1, v = jnp.split(z, 3, axis=-1)
    v = (v * x1).astype(jnp.float32)
    kf, kb = hyena_filters(L, f1, fb1, f2, fb2, f3, freq)
    k_full = jnp.concatenate([kf, jnp.zeros((1, D), jnp.float32), kb[:0:-1]], axis=0)
    n = 2 * L
    y = jnp.fft.irfft(jnp.fft.rfft(v, n=n, axis=1) * jnp.fft.rfft(k_full, n=n, axis=0)[None], n=n, axis=1)[:, :L]
    y = (y + v * skip.astype(jnp.float32)) * x0.astype(jnp.float32)
    return y.astype(h.dtype) @ wo + bo


def route(h, router_w, router_b):
    T = h.shape[0]
    logits = (h @ router_w).astype(jnp.float32) + router_b.astype(jnp.float32)
    probs = jax.nn.softmax(logits, axis=-1).reshape(T, N_GROUPS, EXPERTS_PER_GROUP)
    gscore = lax.top_k(probs, TOP_K)[0].sum(-1)
    g = jnp.argmax(gscore, axis=-1)
    in_g = probs[jnp.arange(T), g]
    vals, idx = lax.top_k(in_g, TOP_K)
    return g[:, None] * EXPERTS_PER_GROUP + idx, vals / vals.sum(-1, keepdims=True)


def moe_ffn(h, router_w, router_b, wg, wu, wd):
    T, D = h.shape
    eidx, ew = route(h, router_w, router_b)
    A = T * TOP_K
    flat_e = eidx.reshape(A)
    flat_w = ew.reshape(A)
    flat_t = jnp.repeat(jnp.arange(T, dtype=jnp.int32), TOP_K)
    order = jnp.argsort(flat_e)
    se, st, sw = flat_e[order], flat_t[order], flat_w[order]
    counts = jnp.bincount(flat_e, length=N_EXPERTS)
    starts = jnp.cumsum(counts) - counts
    padded = (counts + MOE_BLOCK - 1) // MOE_BLOCK * MOE_BLOCK
    pend = jnp.cumsum(padded)
    pstart = pend - padded
    dest = pstart[se] + jnp.arange(A) - starts[se]
    n_blocks = -(-A // MOE_BLOCK) + N_EXPERTS
    P = n_blocks * MOE_BLOCK
    buf_t = jnp.zeros((P,), jnp.int32).at[dest].set(st)
    buf_w = jnp.zeros((P,), jnp.float32).at[dest].set(sw)
    blk_e = jnp.minimum(jnp.searchsorted(pend, jnp.arange(n_blocks) * MOE_BLOCK, side='right'), N_EXPERTS - 1)
    xs = h[buf_t].reshape(n_blocks, MOE_BLOCK, D)

    def expert_block(args):
        xb, e = args
        return (jax.nn.silu(xb @ wg[e]) * (xb @ wu[e])) @ wd[e]

    ys = lax.map(expert_block, (xs, blk_e)).reshape(P, D)
    out = jnp.zeros((T, D), jnp.float32).at[buf_t].add(ys.astype(jnp.float32) * buf_w[:, None])
    return out.astype(h.dtype)


def setup_inputs(seed: int = 0) -> dict:
    key = jax.random.key(seed)
    ks = list(jax.random.split(key, 40))
    f32 = jnp.float32

    def nrm(i, shape, s):
        return jax.random.normal(ks[i], shape, f32) * s

    nA, nB, nC, nD = n_layers_of(0), n_layers_of(1), n_layers_of(2), n_layers_of(3)
    D = D_MODEL
    return {
        "x": nrm(0, (BATCH, SEQ, D), 1.0),
        "c": nrm(1, (BATCH, D), 1.0),
        "ctx": nrm(2, (BATCH, CTX_LEN, D), 1.0),
        "c_ctx": nrm(3, (D,), 1.0),
        "mod_w": nrm(4, (DEPTH, D, 6 * D), 0.3 * D ** -0.5),
        "mod_b": nrm(5, (DEPTH, 6 * D), 0.02),
        "ln_g": 1.0 + nrm(6, (DEPTH, 2, D), 0.02),
        "ln_b": nrm(7, (DEPTH, 2, D), 0.02),
        "attn_wqkv": nrm(8, (nA, D, 3 * D), D ** -0.5),
        "attn_wo": nrm(9, (nA, D, D), BETA * D ** -0.5),
        "attn_lam": nrm(10, (nA, 4, ATT_HEAD_DIM), 0.1),
        "attn_subln": 1.0 + nrm(11, (nA, 2 * ATT_HEAD_DIM), 0.02),
        "pool_w": nrm(12, (nB, len(POOL_WINDOWS), POOL_GROUP, POOL_GROUP), BETA * POOL_GROUP ** -0.5),
        "pool_scale": 1.0 + nrm(13, (nB, D), 0.02),
        "fnet_w": nrm(14, (nC, D, D), BETA * D ** -0.5),
        "fnet_b": nrm(15, (nC, D), 0.02),
        "hy_win": nrm(16, (nD, D, 3 * D), D ** -0.5),
        "hy_bin": nrm(17, (nD, 3 * D), 0.02),
        "hy_conv_w": nrm(18, (nD, 3, 3 * D), 3 ** -0.5),
        "hy_conv_b": nrm(19, (nD, 3 * D), 0.02),
        "hy_f1": nrm(20, (nD, HY_EMB, HY_FILTER_HIDDEN), HY_EMB ** -0.5),
        "hy_fb1": nrm(21, (nD, HY_FILTER_HIDDEN), 0.02),
        "hy_f2": nrm(22, (nD, HY_FILTER_HIDDEN, HY_FILTER_HIDDEN), HY_FILTER_HIDDEN ** -0.5),
        "hy_fb2": nrm(23, (nD, HY_FILTER_HIDDEN), 0.02),
        "hy_f3": nrm(24, (nD, HY_FILTER_HIDDEN, 2 * D), 0.02),
        "hy_freq": 1.0 + nrm(25, (nD, HY_FILTER_HIDDEN), 0.02),
        "hy_skip": nrm(26, (nD, D), 0.1),
        "hy_wo": nrm(27, (nD, D, D), BETA * D ** -0.5),
        "hy_bo": nrm(28, (nD, D), 0.02),
        "router_w": nrm(29, (D, N_EXPERTS), D ** -0.5),
        "router_b": nrm(30, (N_EXPERTS,), 0.01),
        "moe_wg": nrm(31, (DEPTH, N_EXPERTS, D, D_EXPERT), D ** -0.5),
        "moe_wu": nrm(32, (DEPTH, N_EXPERTS, D, D_EXPERT), D ** -0.5),
        "moe_wd": nrm(33, (DEPTH, N_EXPERTS, D_EXPERT, D), BETA * D_EXPERT ** -0.5),
    }


def reference(x, c, ctx, c_ctx, mod_w, mod_b, ln_g, ln_b, attn_wqkv, attn_wo, attn_lam, attn_subln,
              pool_w, pool_scale, fnet_w, fnet_b, hy_win, hy_bin, hy_conv_w, hy_conv_b, hy_f1, hy_fb1,
              hy_f2, hy_fb2, hy_f3, hy_freq, hy_skip, hy_wo, hy_bo, router_w, router_b, moe_wg, moe_wu, moe_wd):
    B, S, D = x.shape
    rope = axial_rope_tables(S)
    xl, xc = x, ctx
    for i in range(DEPTH):
        kind, j = i % N_MIXERS, i // N_MIXERS
        ctx_in, ctx_out = ctx_needed(i), ctx_needed(i + 1)
        ml = (jax.nn.silu(c) @ mod_w[i] + mod_b[i])[:, None, :]
        sh1, sc1, g1, sh2, sc2, g2 = jnp.split(ml, 6, axis=-1)
        hl = xl * (1.0 + sc1) + sh1
        if ctx_in:
            mc = jax.nn.silu(c_ctx) @ mod_w[i] + mod_b[i]
            csh1, csc1, cg1, csh2, csc2, cg2 = jnp.split(mc, 6)
            hc = xc * (1.0 + csc1) + csh1
        yc = None
        if kind == 0:
            lam_init = 0.8 - 0.6 * math.exp(-0.3 * i)
            ql, kl, vl = attn_qkv(hl, attn_wqkv[j])
            ql = apply_axial_rope(ql, *rope)
            kl = apply_axial_rope(kl, *rope)
            qc, kc, vc = attn_qkv(hc, attn_wqkv[j])
            yl = diff_attention(ql, jnp.concatenate([kl, kc], axis=1), jnp.concatenate([vl, vc], axis=1),
                                attn_lam[j], attn_subln[j], attn_wo[j], lam_init)
            if ctx_out:
                yc = diff_attention(qc, kc, vc, attn_lam[j], attn_subln[j], attn_wo[j], lam_init)
        elif kind == 1:
            yl = pool_mixer(hl, pool_w[j], pool_scale[j])
            if ctx_out:
                yc = pool_mixer(hc, pool_w[j], pool_scale[j])
        elif kind == 2:
            yl = fourier_mixer(hl, fnet_w[j], fnet_b[j])
            if ctx_out:
                yc = fourier_mixer(hc, fnet_w[j], fnet_b[j])
        else:
            hp = (hy_win[j], hy_bin[j], hy_conv_w[j], hy_conv_b[j], hy_f1[j], hy_fb1[j], hy_f2[j], hy_fb2[j],
                  hy_f3[j], hy_freq[j], hy_skip[j], hy_wo[j], hy_bo[j])
            yl = hyena_mixer(hl, *hp)
            if ctx_out:
                yc = hyena_mixer(hc, *hp)
        xl = deepnorm_update(xl, yl, g1, ln_g[i, 0], ln_b[i, 0])
        tokens = (xl * (1.0 + sc2) + sh2).reshape(B * S, D)
        if ctx_out:
            xc = deepnorm_update(xc, yc, cg1, ln_g[i, 0], ln_b[i, 0])
            tokens = jnp.concatenate([tokens, (xc * (1.0 + csc2) + csh2).reshape(-1, D)], axis=0)
        y2 = moe_ffn(tokens, router_w, router_b, moe_wg[i], moe_wu[i], moe_wd[i])
        xl = deepnorm_update(xl, y2[:B * S].reshape(B, S, D), g2, ln_g[i, 1], ln_b[i, 1])
        if ctx_out:
            xc = deepnorm_update(xc, y2[B * S:].reshape(B, -1, D), cg2, ln_g[i, 1], ln_b[i, 1])
    return xl
```

```cpp
#include <hip/hip_runtime.h>
#include <cstdio>
#include <cstdint>

#ifndef MK_ONE_LAUNCH
#define MK_ONE_LAUNCH 1
#endif

#define LAS __attribute__((address_space(3)))
#define GAS __attribute__((address_space(1)))
typedef unsigned short bf16;
typedef short bf16x8 __attribute__((ext_vector_type(8)));
typedef short s16x4 __attribute__((ext_vector_type(4)));
typedef short v4i16_t __attribute__((ext_vector_type(4)));
typedef float f32x4 __attribute__((ext_vector_type(4)));
typedef float f32x2 __attribute__((ext_vector_type(2)));
typedef float f32x16 __attribute__((ext_vector_type(16)));
typedef unsigned u32x4 __attribute__((ext_vector_type(4)));
typedef unsigned u32x2 __attribute__((ext_vector_type(2)));

constexpr int D = 1024, NB = 4, SEQ = 8192, T = NB * SEQ, CTXL = 256, TC = NB * CTXL, LK = SEQ + CTXL, MROWS = T + TC;
constexpr int NLAYER = 4, NEXP = 16;
constexpr float ALPHA = 1.681792830507429f;
constexpr float LN_EPS = 1e-5f;
constexpr int NWAVES = 8, NTHR = 512;

constexpr size_t MiB = 1u << 20;
constexpr size_t WS_CTL = 0, CTL_BYTES = 1 * MiB;
constexpr size_t WS_MODV = 1 * MiB;
constexpr size_t WS_ROPE = WS_MODV + 512 * 1024;
constexpr size_t WS_TOKE = 2 * MiB;
constexpr size_t WS_TOKW = WS_TOKE + 256 * 1024;
constexpr size_t WS_LIST = 3 * MiB;
constexpr size_t WS_DFT = 5 * MiB;
constexpr size_t DFT_F1 = WS_DFT;
constexpr size_t DFT_C256 = DFT_F1 + 128 * 64 * 2;
constexpr size_t DFT_K1 = DFT_C256 + 256 * 256 * 2;
constexpr size_t DFT_H1 = DFT_K1 + 256 * 128 * 2;
constexpr size_t DFT_H2B = DFT_H1 + 256 * 128 * 2;
constexpr size_t DFT_H3 = DFT_H2B + 256 * 256 * 2;
constexpr size_t WS_TWF = 6 * MiB;
constexpr size_t WS_TWH = WS_TWF + 64 * 128 * 8;
constexpr size_t WS_A2 = 8 * MiB;
constexpr size_t WS_A2B = 11 * MiB;
constexpr size_t WS_TRIG = WS_DFT + 512 * 1024;
constexpr size_t WS_WFB = 13 * MiB;
constexpr size_t WS_F3T = 12 * MiB;
constexpr size_t WS_WQKV = 16 * MiB;
constexpr size_t WS_WO = 22 * MiB;
constexpr size_t WS_POOLW = 24 * MiB;
constexpr size_t WS_FW = 25 * MiB;
constexpr size_t WS_HWIN = 29 * MiB;
constexpr size_t WS_HWO = 35 * MiB;
constexpr size_t WS_WGU = 40 * MiB;
constexpr size_t WS_WD = 104 * MiB;
constexpr size_t WS_XR = 136 * MiB;
constexpr size_t WS_HA = 200 * MiB;
constexpr size_t AR = 268 * MiB;
constexpr size_t WS_Q = AR, WS_K = AR + 64 * MiB, WS_V = AR + 130 * MiB, WS_AO = AR + 196 * MiB;
constexpr size_t WS_Y = AR + 260 * MiB;
constexpr size_t WS_HS = AR + 324 * MiB;
constexpr size_t WS_Y2 = AR + 460 * MiB;
constexpr size_t WS_POOLED = AR;
constexpr size_t WS_FT = AR, WS_PQ = AR + 128 * MiB;
constexpr size_t WS_Z = AR, WS_VP = AR + 192 * MiB, WS_X0 = AR + 324 * MiB;
constexpr size_t WS_HT = AR, WS_HG = AR;
constexpr size_t WS_YH = AR + 388 * MiB, WS_YX = AR + 388 * MiB;
constexpr size_t WS_KH = AR + 516 * MiB;
constexpr size_t WS_KFULL = AR + 644 * MiB;
constexpr size_t WS_KT = AR + 676 * MiB;
constexpr size_t WS_END = AR + 756 * MiB;
constexpr size_t PLANE64 = 64 * MiB, PLANE32 = 32 * MiB;

constexpr int CW_BAR = 4096;
constexpr int CW_CNT = 16384;

constexpr int LDS_SCRATCH = 147456;
constexpr int LDS_MISC = LDS_SCRATCH;
constexpr int LDS_BYTES = LDS_SCRATCH + 8192;

__device__ __forceinline__ float bf2f(unsigned short u) { return __uint_as_float((unsigned)u << 16); }
__device__ __forceinline__ float bflo(unsigned w) { return __uint_as_float(w << 16); }
__device__ __forceinline__ float bfhi(unsigned w) { return __uint_as_float(w & 0xffff0000u); }
__device__ __forceinline__ unsigned pk2(float lo, float hi) { unsigned r; asm("v_cvt_pk_bf16_f32 %0, %1, %2" : "=v"(r) : "v"(lo), "v"(hi)); return r; }
__device__ __forceinline__ float fsin_rev(float rev) { return __builtin_amdgcn_sinf(rev); }
__device__ __forceinline__ float fcos_rev(float rev) { return __builtin_amdgcn_cosf(rev); }
__device__ __forceinline__ float frcp(float x) { return __builtin_amdgcn_rcpf(x); }
__device__ __forceinline__ float fsilu(float x) { return x * frcp(1.f + __expf(-x)); }
template <int CTRL> __device__ __forceinline__ float dpp_mov(float x) { return __builtin_bit_cast(float, __builtin_amdgcn_mov_dpp(__builtin_bit_cast(int, x), CTRL, 0xf, 0xf, true)); }
__device__ __forceinline__ float row16_sum(float v) { v += dpp_mov<0xB1>(v); v += dpp_mov<0x4E>(v); v += dpp_mov<0x124>(v); v += dpp_mov<0x128>(v); return v; }
__device__ __forceinline__ float wave_sum(float v) {
    v = row16_sum(v);
    { auto s_ = __builtin_amdgcn_permlane16_swap(__float_as_uint(v), __float_as_uint(v), false, false); v = __uint_as_float(s_[0]) + __uint_as_float(s_[1]); }
    { auto t_ = __builtin_amdgcn_permlane32_swap(__float_as_uint(v), __float_as_uint(v), false, false); v = __uint_as_float(t_[0]) + __uint_as_float(t_[1]); }
    return v;
}
#define LDS_WAIT() asm volatile("s_waitcnt lgkmcnt(0)" ::: "memory")
#define VM_WAIT() asm volatile("s_waitcnt vmcnt(0)" ::: "memory")

#define XB_TMO      128
#define XB_XCNT(j)  (256  + 64 * (j))
#define XB_XSUB(j)  (1280 + 64 * (j))
#define XB_XGEN(j)  (2304 + 64 * (j))
#define XB_TOP      3328
#define XB_TOPGEN   3392
#define XCD_BAR_WORDS 3456
#define XB_SPIN_CAP (1u << 22)

__device__ __forceinline__ unsigned xb_ld(unsigned* p)              { return __hip_atomic_load(p, __ATOMIC_RELAXED, __HIP_MEMORY_SCOPE_AGENT); }
__device__ __forceinline__ unsigned xb_add(unsigned* p, unsigned v) { return __hip_atomic_fetch_add(p, v, __ATOMIC_RELAXED, __HIP_MEMORY_SCOPE_AGENT); }
__device__ __forceinline__ unsigned xb_xcc_id() { return (unsigned)__builtin_amdgcn_s_getreg((3 << 11) | 20) & 0xFu; }
#define XB_SPIN(cond, bar) do { unsigned _sp = 0; while (cond) { __builtin_amdgcn_s_sleep(1); \
    if ((++_sp & 255u) == 0u) { if (xb_ld(&(bar)[XB_TMO])) break; if (_sp > XB_SPIN_CAP) { atomicAdd(&(bar)[XB_TMO], 1u); break; } } } } while (0)

struct XcdBarrier { unsigned* bar; unsigned x; volatile LAS unsigned* st; };

__device__ __forceinline__ int lane_id() { int l; asm volatile("v_mbcnt_lo_u32_b32 %0, -1, 0\n\tv_mbcnt_hi_u32_b32 %0, -1, %0" : "=v"(l)); return l; }
__device__ __forceinline__ XcdBarrier xcd_barrier_post(unsigned* bar, volatile LAS unsigned* st, int wave_s) {
    XcdBarrier b; b.bar = bar; b.x = xb_xcc_id(); b.st = st;
    if (wave_s == 0 && lane_id() == 0) (void)xb_add(&bar[XB_XCNT(b.x)], 1u);
    return b;
}
__device__ __forceinline__ void xcd_barrier_complete(unsigned* bar, unsigned x, unsigned& nloc, unsigned& nx) {
    const unsigned G = gridDim.x * gridDim.y * gridDim.z;
    unsigned sum, cnt, mine, sp = 0u;
    for (;;) {
        sum = 0u; cnt = 0u; mine = 0u;
#pragma unroll
        for (unsigned j = 0; j < 16; ++j) { const unsigned c = xb_ld(&bar[XB_XCNT(j)]); sum += c; cnt += (c > 0u) ? 1u : 0u; mine = (j == x) ? c : mine; }
        if (sum == G) break;
        __builtin_amdgcn_s_sleep(1);
        if ((++sp & 255u) == 0u) { if (xb_ld(&bar[XB_TMO])) break; if (sp > XB_SPIN_CAP) { atomicAdd(&bar[XB_TMO], 1u); break; } }
    }
    nloc = mine > 0u ? mine : 1u; nx = cnt > 0u ? cnt : 1u;
}
__device__ __forceinline__ void xcd_barrier(const XcdBarrier& b, int wave_s) {
    asm volatile("s_waitcnt vmcnt(0)" ::: "memory");
    __syncthreads();
    if (wave_s == 0 && lane_id() == 0) {
        unsigned* bar = b.bar;
        __builtin_amdgcn_s_waitcnt(0);
        unsigned nloc = b.st[0], nx = b.st[1];
        if (nloc == 0u) { xcd_barrier_complete(bar, b.x, nloc, nx); b.st[0] = nloc; b.st[1] = nx; }
        const unsigned old = xb_add(&bar[XB_XSUB(b.x)], 1u);
        const unsigned gen = old / nloc;
        if (old + 1u == (gen + 1u) * nloc) {
            __builtin_amdgcn_fence(__ATOMIC_RELEASE, "agent");
            asm volatile("s_waitcnt vmcnt(0)" ::: "memory");
            const unsigned og = xb_add(&bar[XB_TOP], 1u);
            const unsigned tg = og / nx;
            if (og + 1u == (tg + 1u) * nx) xb_add(&bar[XB_TOPGEN], 1u);
            else XB_SPIN(xb_ld(&bar[XB_TOPGEN]) == tg, bar);
            __builtin_amdgcn_fence(__ATOMIC_ACQUIRE, "agent");
            xb_add(&bar[XB_XGEN(b.x)], 1u);
            asm volatile("s_waitcnt vmcnt(0)" ::: "memory");
        } else {
            XB_SPIN(xb_ld(&bar[XB_XGEN(b.x)]) == gen, bar);
            __builtin_amdgcn_fence(__ATOMIC_ACQUIRE, "agent");
            asm volatile("s_waitcnt vmcnt(0)" ::: "memory");
        }
    }
    __syncthreads();
}
constexpr int SG_PA = 144, SG_ABYTES = 256 * SG_PA, SG_PBK = 544, SG_STAGE = 2 * SG_ABYTES;
static_assert(64 * SG_PBK <= SG_ABYTES && 2 * SG_STAGE <= LDS_SCRATCH, "sgemm LDS");

__device__ __forceinline__ s16x4 ds_tr(unsigned addr) {
    return __builtin_bit_cast(s16x4, __builtin_amdgcn_ds_read_tr16_b64_v4i16((LAS v4i16_t*)(uintptr_t)addr));
}

template <int MT, int BKIND, class P>
__device__ __forceinline__ void sgemm_unit(LAS unsigned char* lds, const int tid_in, const P& p) {
    int tid = tid_in; asm volatile("" : "+v"(tid));
#ifdef MK_SG_ENTRY_SYNC
    __syncthreads();
#endif
    constexpr int MB = MT / 32, NA = MT / 64;
    const int lane = tid & 63, wid = tid >> 6, wr = wid >> 2, wc = wid & 3, fr = lane & 15, fq = lane >> 4;
    f32x4 acc[MB][4];
#pragma unroll
    for (int a = 0; a < MB; ++a)
#pragma unroll
        for (int b = 0; b < 4; ++b) acc[a][b] = (f32x4){0.f, 0.f, 0.f, 0.f};
    int nk = p.K >> 6;
    asm volatile("" : "+s"(nk));
    const int srow = tid >> 3, sch = tid & 7;
    const int krow = tid >> 5, kch = tid & 31;
    const char* abase = (const char*)p.abase(); const char* bbase = (const char*)p.bbase();
    unsigned oa[NA], ob[4];
#pragma unroll
    for (int i = 0; i < NA; ++i) oa[i] = (p.aoff(srow + 64 * i) + sch * 8) * 2u;
    if constexpr (BKIND == 0) {
#pragma unroll
        for (int i = 0; i < 4; ++i) ob[i] = (p.boff(srow + 64 * i) + sch * 8) * 2u;
    }
    u32x4 ra[NA], rb[4];
    const unsigned lbase = (unsigned)(uintptr_t)lds;
    const unsigned wa_off = (unsigned)(srow * SG_PA + sch * 16);
    const unsigned wb_off = BKIND == 0 ? (unsigned)(srow * SG_PA + sch * 16) : (unsigned)(krow * SG_PBK + kch * 16);
#define SG_GLOAD(kt) do { \
        _Pragma("unroll") for (int i = 0; i < NA; ++i) ra[i] = *(const u32x4*)(abase + (size_t)(oa[i] + (unsigned)(kt) * 128u)); \
        if constexpr (BKIND == 0) { _Pragma("unroll") for (int i = 0; i < 4; ++i) rb[i] = *(const u32x4*)(bbase + (size_t)(ob[i] + (unsigned)(kt) * 128u)); } \
        else { _Pragma("unroll") for (int i = 0; i < 4; ++i) rb[i] = *(const u32x4*)(bbase + (size_t)((p.boff((kt) * 64 + krow + 16 * i) + kch * 8) * 2u)); } } while (0)
#define SG_LWRITE(st) do { const unsigned sb_ = lbase + (st) * SG_STAGE; \
        _Pragma("unroll") for (int i = 0; i < NA; ++i) *(LAS u32x4*)(uintptr_t)(sb_ + wa_off + i * 64 * SG_PA) = ra[i]; \
        _Pragma("unroll") for (int i = 0; i < 4; ++i) *(LAS u32x4*)(uintptr_t)(sb_ + SG_ABYTES + wb_off + i * (BKIND == 0 ? 64 * SG_PA : 16 * SG_PBK)) = rb[i]; } while (0)
    const unsigned fa_off = (unsigned)((wr * (MT / 2) + fr) * SG_PA + fq * 16);
    const unsigned fb_off = BKIND == 0 ? (unsigned)((wc * 64 + fr) * SG_PA + fq * 16)
                                       : (unsigned)((8 * fq + (fr >> 2)) * SG_PBK + (wc * 64 + 4 * (fr & 3)) * 2);
    SG_GLOAD(0);
    SG_LWRITE(0);
    __syncthreads();
#pragma nounroll
    for (int kt = 0; kt < nk; ++kt) {
        const int st = kt & 1;
        if (kt + 1 < nk) SG_GLOAD(kt + 1);
        const unsigned sa = lbase + st * SG_STAGE, sb = sa + SG_ABYTES;
#pragma unroll
        for (int ks = 0; ks < 2; ++ks) {
            bf16x8 bfr[4];
            if constexpr (BKIND == 0) {
#pragma unroll
                for (int nb = 0; nb < 4; ++nb) bfr[nb] = *(const LAS bf16x8*)(uintptr_t)(sb + fb_off + nb * 16 * SG_PA + ks * 64);
            } else {
#pragma unroll
                for (int nb = 0; nb < 4; ++nb) {
                    const s16x4 lo = ds_tr(sb + fb_off + ks * 32 * SG_PBK + nb * 32), hi = ds_tr(sb + fb_off + (ks * 32 + 4) * SG_PBK + nb * 32);
                    bfr[nb] = (bf16x8){lo[0], lo[1], lo[2], lo[3], hi[0], hi[1], hi[2], hi[3]};
                }
            }
#pragma unroll
            for (int mg = 0; mg < MB; mg += 4) {
                bf16x8 af[4];
#pragma unroll
                for (int mb = 0; mb < 4; ++mb) af[mb] = *(const LAS bf16x8*)(uintptr_t)(sa + fa_off + (mg + mb) * 16 * SG_PA + ks * 64);
#pragma unroll
                for (int mb = 0; mb < 4; ++mb)
#pragma unroll
                    for (int nb = 0; nb < 4; ++nb) acc[mg + mb][nb] = __builtin_amdgcn_mfma_f32_16x16x32_bf16(bfr[nb], af[mb], acc[mg + mb][nb], 0, 0, 0);
                if (MB > 4) __builtin_amdgcn_sched_barrier(0);
            }
            if (MB > 4) __builtin_amdgcn_sched_barrier(0);
        }
        if (kt + 1 < nk) SG_LWRITE(st ^ 1);
        __syncthreads();
    }
#undef SG_GLOAD
#undef SG_LWRITE
    p.epi(acc, wr, wc, fr, fq);
}
namespace tg {
constexpr int BK = 64, HALF = 128, HTB = HALF * BK * 2, STAGE_BYTES = 8 * HTB;
static_assert(STAGE_BYTES + 16384 <= LDS_SCRATCH, "tgemm LDS");
__device__ __forceinline__ int lds_byte(int r, int c) { const int st = (r >> 4) * 2 + (c >> 5), rr = r & 15, cc = c & 31, ob = rr * 64 + cc * 2; return st * 1024 + (ob ^ (((ob >> 9) & 1) << 5)); }
__device__ __forceinline__ void stage_rc(int b, int& R, int& C) { const int st = b / 1024, sb = b % 1024, swz = sb ^ (((sb >> 9) & 1) << 5); R = (st >> 1) * 16 + swz / 64; C = (st & 1) * 32 + (swz % 64) / 2; }

struct TUnit { const char* a; const char* b; int i0, i1, i2, i3; };

template <bool GATHER, class Sched, class Epi>
__device__ __forceinline__ void tgemm_phase(LAS unsigned char* lds, const int tid_in, const int lda, const int ldb, const int K, const Sched& S, const Epi& E) {
    int tid = tid_in; asm volatile("" : "+v"(tid));
    const int wid = __builtin_amdgcn_readfirstlane(tid >> 6), lane = tid & 63, wr = wid >> 2, wc = wid & 3, fr = lane & 15, fq = lane >> 4;
    const int nt = K / BK;
    unsigned vB[2]; { int R0, C0, R1, C1; stage_rc(tid * 16, R0, C0); stage_rc(tid * 16 + 8192, R1, C1); vB[0] = (unsigned)(R0 * ldb + C0) * 2u; vB[1] = (unsigned)(R1 * ldb + C1) * 2u; }
    const unsigned hstepB = (unsigned)HALF * (unsigned)ldb * 2u;
    unsigned vA[2][2];
    LAS u32x2* const park = (LAS u32x2*)(lds + STAGE_BYTES) + tid * 4;
    const size_t kstep = (size_t)(BK * 2);
    const unsigned ldsw = (unsigned)wid * 1024u;
    const int aoff = lds_byte(wr * 64 + fr, fq * 8), boff = lds_byte(wc * 32 + fr, fq * 8);
#define TG_SA(b, h) (((b) * 2 + (h)) * HTB)
#define TG_SB(b, h) ((4 + (b) * 2 + (h)) * HTB)
#define TG_STAGE2(bufoff, gbase, o0, o1) do { \
        __builtin_amdgcn_global_load_lds((const unsigned*)((const char*)(gbase) + (o0)), (LAS unsigned*)(lds + (bufoff) + ldsw), 16, 0, 0); \
        __builtin_amdgcn_global_load_lds((const unsigned*)((const char*)(gbase) + (o1)), (LAS unsigned*)(lds + (bufoff) + ldsw + 8192), 16, 0, 0); } while (0)
#define TG_STAGE_B(bufoff, gbase, h) TG_STAGE2(bufoff, (gbase) + (size_t)(h) * hstepB, vB[0], vB[1])
#define TG_STAGE_A(bufoff, gbase, h, nx) do { if constexpr (GATHER) { const u32x2 q_ = park[((nx) ? 2 : 0) + (h)]; TG_STAGE2(bufoff, gbase, q_.x, q_.y); } else TG_STAGE2(bufoff, gbase, vA[h][0], vA[h][1]); } while (0)
#define TG_LDA(dst, b, h) do { _Pragma("unroll") for (int m = 0; m < 4; ++m) _Pragma("unroll") for (int k = 0; k < 2; ++k) dst[m][k] = *(const LAS bf16x8*)(lds + TG_SA(b, h) + aoff + m * 2048 + k * 1024); } while (0)
#define TG_LDB(dst, b, h) do { _Pragma("unroll") for (int n = 0; n < 2; ++n) _Pragma("unroll") for (int k = 0; k < 2; ++k) dst[n][k] = *(const LAS bf16x8*)(lds + TG_SB(b, h) + boff + n * 2048 + k * 1024); } while (0)
#define TG_MMA(ai, bj, At, Bt) do { __builtin_amdgcn_s_setprio(1); _Pragma("unroll") for (int m = 0; m < 4; ++m) _Pragma("unroll") for (int n = 0; n < 2; ++n) _Pragma("unroll") for (int k = 0; k < 2; ++k) \
        acc[ai][bj][m][n] = __builtin_amdgcn_mfma_f32_16x16x32_bf16(Bt[n][k], At[m][k], acc[ai][bj][m][n], 0, 0, 0); __builtin_amdgcn_s_setprio(0); } while (0)
#define TG_WAIT_V(n) asm volatile("s_waitcnt vmcnt(" #n ")" ::: "memory")
#define TG_WAIT_L(n) asm volatile("s_waitcnt lgkmcnt(" #n ")" ::: "memory")
#define TG_BAR __builtin_amdgcn_s_barrier()
#define TG_SCHED __builtin_amdgcn_sched_barrier(0)
#define TG_SETOFF(dst, u) do { int tz_ = tid_in; asm volatile("" : "+v"(tz_)); int r0_, c0_, r1_, c1_; stage_rc(tz_ * 16, r0_, c0_); stage_rc(tz_ * 16 + 8192, r1_, c1_); \
        _Pragma("unroll") for (int h = 0; h < 2; ++h) { \
        if constexpr (GATHER) { dst[h][0] = (unsigned)(S.arow(u, h * HALF + r0_) * lda + c0_) * 2u; dst[h][1] = (unsigned)(S.arow(u, h * HALF + r1_) * lda + c1_) * 2u; } \
        else { dst[h][0] = (unsigned)((h * HALF + r0_) * lda + c0_) * 2u; dst[h][1] = (unsigned)((h * HALF + r1_) * lda + c1_) * 2u; } } } while (0)
    TUnit cur, nxt; int ui = 0;
    if (!S.next(0, cur)) return;
    f32x4 acc[2][2][4][2];
#pragma unroll
    for (int a = 0; a < 2; ++a)
#pragma unroll
        for (int b = 0; b < 2; ++b)
#pragma unroll
            for (int m = 0; m < 4; ++m)
#pragma unroll
                for (int n = 0; n < 2; ++n) acc[a][b][m][n] = (f32x4){0.f, 0.f, 0.f, 0.f};
    bf16x8 At[4][2], B0[2][2], B1[2][2];
    const char* cA = cur.a; const char* cB = cur.b;
    TG_SETOFF(vA, cur);
    if constexpr (GATHER) { park[0] = (u32x2){vA[0][0], vA[0][1]}; park[1] = (u32x2){vA[1][0], vA[1][1]}; }
    TG_STAGE_B(TG_SB(0, 0), cB, 0); TG_STAGE_B(TG_SB(0, 1), cB, 1); TG_STAGE_A(TG_SA(0, 0), cA, 0, false); TG_STAGE_A(TG_SA(0, 1), cA, 1, false);
    if (wr == 1) TG_BAR;
    TG_WAIT_V(2); TG_BAR;
    TG_STAGE_B(TG_SB(1, 0), cB + kstep, 0); TG_STAGE_A(TG_SA(1, 0), cA + kstep, 0, false); TG_STAGE_B(TG_SB(1, 1), cB + kstep, 1);
    TG_WAIT_V(6); TG_BAR;
    for (;;) {
        const bool has_next = S.next(ui + 1, nxt);
        const char* nA = has_next ? nxt.a : cA; const char* nB = has_next ? nxt.b : cB;
        if constexpr (GATHER) { if (has_next) { unsigned q[2][2]; TG_SETOFF(q, nxt); park[2] = (u32x2){q[0][0], q[0][1]}; park[3] = (u32x2){q[1][0], q[1][1]}; } else { park[2] = park[0]; park[3] = park[1]; } }
        for (int t = 0; t < nt; t += 2) {
            const bool last = (t == nt - 2);
            const char* a1 = cA + (size_t)(t + 1) * kstep;
            const char* a2 = last ? nA : cA + (size_t)(t + 2) * kstep; const char* b2 = last ? nB : cB + (size_t)(t + 2) * kstep;
            const char* a3 = a2 + kstep; const char* b3 = b2 + kstep;
            TG_LDB(B0, 0, 0); TG_LDB(B1, 0, 1); TG_SCHED; TG_LDA(At, 0, 0); TG_STAGE_A(TG_SA(1, 1), a1, 1, false);
            TG_WAIT_V(8); TG_WAIT_L(0); TG_BAR; TG_MMA(0, 0, At, B0); TG_MMA(0, 1, At, B1); TG_BAR; TG_SCHED;
            TG_LDA(At, 0, 1); TG_STAGE_B(TG_SB(0, 0), b2, 0); TG_STAGE_B(TG_SB(0, 1), b2, 1); TG_STAGE_A(TG_SA(0, 0), a2, 0, last);
            TG_WAIT_V(8); TG_WAIT_L(0); TG_BAR; TG_MMA(1, 0, At, B0); TG_MMA(1, 1, At, B1); TG_BAR; TG_SCHED;
            TG_LDB(B0, 1, 0); TG_LDB(B1, 1, 1); TG_SCHED; TG_LDA(At, 1, 0); TG_STAGE_A(TG_SA(0, 1), a2, 1, last);
            TG_WAIT_V(8); TG_WAIT_L(0); TG_BAR; TG_MMA(0, 0, At, B0); TG_MMA(0, 1, At, B1); TG_BAR; TG_SCHED;
            TG_LDA(At, 1, 1); TG_STAGE_B(TG_SB(1, 0), b3, 0); TG_STAGE_B(TG_SB(1, 1), b3, 1); TG_STAGE_A(TG_SA(1, 0), a3, 0, last);
            TG_WAIT_V(8); TG_WAIT_L(0); TG_BAR; TG_MMA(1, 0, At, B0); TG_MMA(1, 1, At, B1); TG_BAR; TG_SCHED;
        }
        if (wr == 0) TG_BAR;
        E(acc, cur, wr, wc, fr, fq);
        if (!has_next) break;
#pragma unroll
        for (int a = 0; a < 2; ++a)
#pragma unroll
            for (int b = 0; b < 2; ++b)
#pragma unroll
                for (int m = 0; m < 4; ++m)
#pragma unroll
                    for (int n = 0; n < 2; ++n) acc[a][b][m][n] = (f32x4){0.f, 0.f, 0.f, 0.f};
        cur = nxt; cA = nA; cB = nB; ++ui;
        if constexpr (GATHER) { park[0] = park[2]; park[1] = park[3]; }
        if (wr == 1) TG_BAR;
    }
    TG_WAIT_V(0);
    TG_BAR;
#undef TG_SA
#undef TG_SB
#undef TG_STAGE2
#undef TG_STAGE_B
#undef TG_STAGE_A
#undef TG_LDA
#undef TG_LDB
#undef TG_MMA
#undef TG_WAIT_V
#undef TG_WAIT_L
#undef TG_BAR
#undef TG_SCHED
#undef TG_SETOFF
}
}
struct Args { const float* in[34]; float* out; unsigned char* ws; int ph_lo, ph_hi, flip, pad; };
struct Frame {
    LAS unsigned char* lds;
    unsigned char* ws;
    int tid, lane, wave, vcu, G, gw, NGW, flip;
};
enum { I_X = 0, I_C, I_CTX, I_CCTX, I_MODW, I_MODB, I_LNG, I_LNB, I_WQKV, I_WO, I_LAM, I_SUBLN, I_POOLW, I_POOLS, I_FW, I_FB,
       I_HWIN, I_HBIN, I_HCW, I_HCB, I_HF1, I_HFB1, I_HF2, I_HFB2, I_HF3, I_HFREQ, I_HSKIP, I_HWO, I_HBO, I_RW, I_RB, I_WG, I_WU, I_WD };

__device__ __forceinline__ void transpose_item64(const float* W, int ldw, int k0, int n0, bf16* WT, int ldo, int out_row0, int out_row1, LAS float* scr, int lane) {
    const int kq = lane >> 4, c4 = (lane & 15) * 4;
    f32x4 v[16];
#pragma unroll
    for (int i = 0; i < 16; ++i) v[i] = *(const f32x4*)(W + (size_t)(k0 + 4 * i + kq) * ldw + n0 + c4);
#pragma unroll
    for (int i = 0; i < 16; ++i) { const int kk = 4 * i + kq; scr[(c4 + 0) * 65 + kk] = v[i].x; scr[(c4 + 1) * 65 + kk] = v[i].y; scr[(c4 + 2) * 65 + kk] = v[i].z; scr[(c4 + 3) * 65 + kk] = v[i].w; }
    LDS_WAIT(); asm volatile("" ::: "memory");
    const int c = lane & 7;
#pragma unroll
    for (int j = 0; j < 8; ++j) { const int n = (lane >> 3) + 8 * j; const LAS float* s_ = scr + n * 65 + 8 * c;
        u32x4 o; o.x = pk2(s_[0], s_[1]); o.y = pk2(s_[2], s_[3]); o.z = pk2(s_[4], s_[5]); o.w = pk2(s_[6], s_[7]);
        const int orow = n < 32 ? out_row0 + n : out_row1 + (n - 32);
        *(u32x4*)(WT + (size_t)orow * ldo + k0 + 8 * c) = o; }
    LDS_WAIT(); asm volatile("" ::: "memory");
}
__device__ __forceinline__ void transpose_matrix(const Frame& F, const float* W, int K, int N, bf16* WT) {
    LAS float* scr = (LAS float*)(F.lds + F.wave * 16640);
    const int nblk = N / 64, items = (K / 64) * nblk;
    for (int it = F.gw; it < items; it += F.NGW) { const int kb = it / nblk, nb = it % nblk; transpose_item64(W, N, kb * 64, nb * 64, WT, K, nb * 64, nb * 64 + 32, scr, F.lane); }
}
__device__ __forceinline__ void convert_moe_layer(const Frame& F, const float* wg, const float* wu, const float* wd, int layer) {
    LAS float* scr = (LAS float*)(F.lds + F.wave * 16640);
    bf16* WGU = (bf16*)(F.ws + WS_WGU); bf16* WDt = (bf16*)(F.ws + WS_WD);
    constexpr int PER = 16 * 16;
    const int items = 16 * 3 * PER;
    for (int it = F.gw; it < items; it += F.NGW) {
        const int e = it / (3 * PER), r = it % (3 * PER), which = r / PER, q = r % PER, kb = q / 16, nb = q % 16, n0 = nb * 64;
        const size_t moff = ((size_t)layer * 16 + e) * 1024 * 1024;
        if (which < 2) {
            const int rb = (n0 >> 7) * 256 + (n0 & 127) + which * 128;
            transpose_item64((which ? wu : wg) + moff, 1024, kb * 64, n0, WGU + (size_t)e * 2048 * 1024, 1024, rb, rb + 32, scr, F.lane);
        } else transpose_item64(wd + moff, 1024, kb * 64, n0, WDt + (size_t)e * 1024 * 1024, 1024, n0, n0 + 32, scr, F.lane);
    }
}
__device__ __forceinline__ void mod_gemv(const Frame& F, const float* c, const float* cctx, const float* mw, const float* mb) {
    LAS float* sv = (LAS float*)(F.lds + 73728);
    LAS float* red = (LAS float*)(F.lds + 73728 + 20480);
    float* MODV = (float*)(F.ws + WS_MODV);
    for (int i = F.tid; i < 5 * 1024; i += NTHR) { const int v = i >> 10, k = i & 1023; const float x = v < 4 ? c[v * 1024 + k] : cctx[k]; sv[i] = fsilu(x); }
    __syncthreads();
    for (int it = F.vcu; it < 4 * 24; it += F.G) {
        const int layer = it / 24, cc = it % 24, col = cc * 256 + F.lane * 4;
        const float* Wp = mw + (size_t)layer * 1024 * 6144 + col;
        f32x4 a[5];
#pragma unroll
        for (int v = 0; v < 5; ++v) a[v] = (f32x4){0.f, 0.f, 0.f, 0.f};
        const int k0 = F.wave * 128;
        for (int kb = 0; kb < 128; kb += 16) {
            f32x4 w[16];
#pragma unroll
            for (int j = 0; j < 16; ++j) w[j] = *(const f32x4*)(Wp + (size_t)(k0 + kb + j) * 6144);
#pragma unroll
            for (int j = 0; j < 16; ++j)
#pragma unroll
                for (int v = 0; v < 5; ++v) a[v] += w[j] * sv[v * 1024 + k0 + kb + j];
        }
#pragma unroll
        for (int v = 0; v < 5; ++v) *(LAS f32x4*)(red + (F.wave * 5 + v) * 256 + F.lane * 4) = a[v];
        __syncthreads();
        for (int o = F.tid; o < 5 * 256; o += NTHR) { const int v = o >> 8, n = o & 255; float s = mb[layer * 6144 + cc * 256 + n];
#pragma unroll
            for (int w = 0; w < 8; ++w) s += red[(w * 5 + v) * 256 + n];
            MODV[((size_t)layer * 5 + v) * 6144 + cc * 256 + n] = s; }
        __syncthreads();
    }
}
__device__ __forceinline__ int row_f(int R) { return (R >> 5) * 16 + (R & 15); }
__device__ __forceinline__ int row_part(int R) { return (R >> 4) & 1; }
__device__ __forceinline__ void tables(const Frame& F) {
    const int gt = F.vcu * NTHR + F.tid, NGT = F.G * NTHR;
    float* rope = (float*)(F.ws + WS_ROPE);
    for (int i = gt; i < 192 * 16; i += NGT) {
        const int pos = i >> 4, fi = i & 15; const float inv = __expf(-(float)fi * (1.0f / 16.0f) * 9.210340371976184f);
        const int p = pos < 128 ? pos : pos - 128; const float rev = (float)p * inv * 0.15915494309189535f;
        float* base = rope + (pos < 128 ? 0 : 4096);
        base[p * 16 + fi] = fcos_rev(rev); base[(pos < 128 ? 2048 : 1024) + p * 16 + fi] = fsin_rev(rev);
    }
    bf16* f1 = (bf16*)(F.ws + DFT_F1);
    for (int i = gt; i < 128 * 64; i += NGT) { const int R = i >> 6, l1 = i & 63, f = row_f(R), pt = row_part(R); const float rev = (float)((f * l1) & 63) * (1.f / 64.f);
        f1[i] = (bf16)(pk2(pt ? -fsin_rev(rev) : fcos_rev(rev), 0.f) & 0xffff); }
    bf16* c256 = (bf16*)(F.ws + DFT_C256); bf16* h2b = (bf16*)(F.ws + DFT_H2B);
    for (int i = gt; i < 256 * 256; i += NGT) { const int R = i >> 8, k = i & 255, f = row_f(R), pt = row_part(R), l = k & 127, kp = k >> 7;
        const float rev = (float)((f * l) & 127) * (1.f / 128.f), cs = fcos_rev(rev), sn = fsin_rev(rev);
        const float v1 = pt == 0 ? (kp == 0 ? cs : sn) : (kp == 0 ? -sn : cs);
        const float v2 = pt == 0 ? (kp == 0 ? cs : -sn) : (kp == 0 ? sn : cs);
        c256[i] = (bf16)(pk2(v1, 0.f) & 0xffff); h2b[i] = (bf16)(pk2(v2, 0.f) & 0xffff); }
    bf16* k1 = (bf16*)(F.ws + DFT_K1); bf16* h1 = (bf16*)(F.ws + DFT_H1);
    for (int i = gt; i < 256 * 128; i += NGT) { const int R = i >> 7, k = i & 127, f = row_f(R), pt = row_part(R);
        { const float rev = (float)((f * k) & 127) * (1.f / 128.f); k1[i] = (bf16)(pk2(pt ? -fsin_rev(rev) : fcos_rev(rev), 0.f) & 0xffff); }
        { const int s1 = k & 63, kp = k >> 6; const float rev = (float)((f * s1) & 127) * (1.f / 128.f), cs = fcos_rev(rev), sn = fsin_rev(rev);
          const float v = pt == 0 ? (kp == 0 ? cs : sn) : (kp == 0 ? -sn : cs); h1[i] = (bf16)(pk2(v, 0.f) & 0xffff); } }
    bf16* h3 = (bf16*)(F.ws + DFT_H3);
    for (int i = gt; i < 128 * 256; i += NGT) { const int R = i >> 8, k = i & 255, t1 = row_f(R), pt = row_part(R), f1i = k & 127, kp = k >> 7;
        const float rev = (float)((t1 * f1i) & 127) * (1.f / 128.f), cs = fcos_rev(rev), sn = fsin_rev(rev);
        const float v = pt == 0 ? (kp == 0 ? cs : -sn) : (kp == 0 ? sn : cs); h3[i] = (bf16)(pk2(v, 0.f) & 0xffff); }
    bf16* trig = (bf16*)(F.ws + WS_TRIG); const float fsc = 1.0f / sqrtf(8192.0f * 256.0f);
    for (int i = gt; i < 2 * 256 * 256; i += NGT) { const int tg_ = i >> 16, k = (i >> 8) & 255, c = i & 255; const float rev = (float)((k * c) & 255) * (1.f / 256.f);
        trig[i] = (bf16)(pk2(fsc * (tg_ ? fsin_rev(rev) : fcos_rev(rev)), 0.f) & 0xffff); }
    f32x2* twf = (f32x2*)(F.ws + WS_TWF);
    for (int i = gt; i < 64 * 128; i += NGT) { const int a = i >> 7, b = i & 127; const float rev = (float)((a * b) & 8191) * (1.f / 8192.f); twf[i] = (f32x2){fcos_rev(rev), fsin_rev(rev)}; }
    f32x2* twh = (f32x2*)(F.ws + WS_TWH);
    for (int i = gt; i < 128 * 128; i += NGT) { const int a = i >> 7, b = i & 127; const float rev = (float)((a * b) & 16383) * (1.f / 16384.f); twh[i] = (f32x2){fcos_rev(rev), fsin_rev(rev)}; }
}
__device__ __forceinline__ void fourier_w_copy(const Frame& F, const float* w) {
    bf16* WFB = (bf16*)(F.ws + WS_WFB); const int gt = F.vcu * NTHR + F.tid, NGT = F.G * NTHR;
    for (int i = gt; i < 1024 * 1024 / 8; i += NGT) { const f32x4 a = *(const f32x4*)(w + (size_t)i * 8), b2 = *(const f32x4*)(w + (size_t)i * 8 + 4);
        *(u32x4*)(WFB + (size_t)i * 8) = (u32x4){pk2(a.x, a.y), pk2(a.z, a.w), pk2(b2.x, b2.y), pk2(b2.z, b2.w)}; }
}
__device__ __forceinline__ void hyena_a2(const Frame& F, const float* f1, const float* fb1, const float* f2, const float* fb2, const float* freq) {
    float* A2 = (float*)(F.ws + WS_A2);
    LAS float* sc = (LAS float*)(F.lds + 143360 + F.wave * 512);
    const int j = F.lane; const float fr = freq[j];
    for (int t = F.gw; t < SEQ; t += F.NGW) {
        float zv = 0.f;
        if (j == 0) zv = (float)t * (1.f / 8192.f);
        else if (j < 33) { const int b = (j - 1) & 15; const float band = 1e-4f + (float)b * ((15.0f - 1e-4f) / 15.0f); const float rev = (float)t * band * (1.f / 8192.f);
            const float rr = rev - floorf(rev); zv = j < 17 ? fcos_rev(rr) : fsin_rev(rr); }
        sc[j] = zv; LDS_WAIT(); asm volatile("" ::: "memory");
        float s = fb1[j];
        for (int i = 0; i < 33; ++i) s += sc[i] * f1[i * 64 + j];
        const float a1 = __sinf(fr * s);
        LDS_WAIT(); asm volatile("" ::: "memory");
        sc[64 + j] = a1; LDS_WAIT(); asm volatile("" ::: "memory");
        float s2 = fb2[j];
        for (int i = 0; i < 64; ++i) s2 += sc[64 + i] * f2[i * 64 + j];
        { const float a2v = __sinf(fr * s2); A2[(size_t)t * 64 + j] = a2v; ((bf16*)(F.ws + WS_A2B))[(size_t)t * 64 + j] = (bf16)(pk2(a2v, 0.f) & 0xffff); }
        LDS_WAIT(); asm volatile("" ::: "memory");
    }
}
__device__ __forceinline__ void ld16f(const float* p, float (&v)[16], int lane) {
    const f32x4 a = *(const f32x4*)(p + lane * 8), b = *(const f32x4*)(p + lane * 8 + 4), c = *(const f32x4*)(p + 512 + lane * 8), d = *(const f32x4*)(p + 512 + lane * 8 + 4);
    v[0] = a.x; v[1] = a.y; v[2] = a.z; v[3] = a.w; v[4] = b.x; v[5] = b.y; v[6] = b.z; v[7] = b.w;
    v[8] = c.x; v[9] = c.y; v[10] = c.z; v[11] = c.w; v[12] = d.x; v[13] = d.y; v[14] = d.z; v[15] = d.w;
}
__device__ __forceinline__ void ld16b(const bf16* p, float (&v)[16], int lane) {
    const u32x4 a = *(const u32x4*)(p + lane * 8), c = *(const u32x4*)(p + 512 + lane * 8);
    v[0] = bflo(a.x); v[1] = bfhi(a.x); v[2] = bflo(a.y); v[3] = bfhi(a.y); v[4] = bflo(a.z); v[5] = bfhi(a.z); v[6] = bflo(a.w); v[7] = bfhi(a.w);
    v[8] = bflo(c.x); v[9] = bfhi(c.x); v[10] = bflo(c.y); v[11] = bfhi(c.y); v[12] = bflo(c.z); v[13] = bfhi(c.z); v[14] = bflo(c.w); v[15] = bfhi(c.w);
}
__device__ __forceinline__ void ldraw(const bf16* p, u32x4& a, u32x4& c, int lane) { a = *(const u32x4*)(p + lane * 8); c = *(const u32x4*)(p + 512 + lane * 8); }
__device__ __forceinline__ void unpack16(const u32x4 a, const u32x4 c, float (&v)[16]) {
    v[0] = bflo(a.x); v[1] = bfhi(a.x); v[2] = bflo(a.y); v[3] = bfhi(a.y); v[4] = bflo(a.z); v[5] = bfhi(a.z); v[6] = bflo(a.w); v[7] = bfhi(a.w);
    v[8] = bflo(c.x); v[9] = bfhi(c.x); v[10] = bflo(c.y); v[11] = bfhi(c.y); v[12] = bflo(c.z); v[13] = bfhi(c.z); v[14] = bflo(c.w); v[15] = bfhi(c.w);
}
__device__ __forceinline__ void st16b(bf16* p, const float (&v)[16], int lane) {
    u32x4 a, c; a.x = pk2(v[0], v[1]); a.y = pk2(v[2], v[3]); a.z = pk2(v[4], v[5]); a.w = pk2(v[6], v[7]);
    c.x = pk2(v[8], v[9]); c.y = pk2(v[10], v[11]); c.z = pk2(v[12], v[13]); c.w = pk2(v[14], v[15]);
    *(u32x4*)(p + lane * 8) = a; *(u32x4*)(p + 512 + lane * 8) = c;
}
__device__ __forceinline__ void st16f(float* p, const float (&v)[16], int lane) {
    *(f32x4*)(p + lane * 8) = (f32x4){v[0], v[1], v[2], v[3]}; *(f32x4*)(p + lane * 8 + 4) = (f32x4){v[4], v[5], v[6], v[7]};
    *(f32x4*)(p + 512 + lane * 8) = (f32x4){v[8], v[9], v[10], v[11]}; *(f32x4*)(p + 512 + lane * 8 + 4) = (f32x4){v[12], v[13], v[14], v[15]};
}
__device__ __forceinline__ void modulate0(const Frame& F, const float* x, const float* ctx) {
    const float* MODV = (const float*)(F.ws + WS_MODV); bf16* HA = (bf16*)(F.ws + WS_HA); bf16* XR = (bf16*)(F.ws + WS_XR);
    for (int m = F.gw; m < MROWS; m += F.NGW) {
        const int v = m < T ? m / SEQ : 4; const float* mv = MODV + (size_t)v * 6144;
        float xv[16], sh[16], sc[16];
        ld16f(m < T ? x + (size_t)m * D : ctx + (size_t)(m - T) * D, xv, F.lane); ld16f(mv, sh, F.lane); ld16f(mv + 1024, sc, F.lane);
        if (m < T) st16b(XR + (size_t)m * D, xv, F.lane);
#pragma unroll
        for (int i = 0; i < 16; ++i) xv[i] = xv[i] * (1.f + sc[i]) + sh[i];
        st16b(HA + (size_t)m * D, xv, F.lane);
    }
}
__device__ __forceinline__ void ln16(float (&v)[16], const float (&gam)[16], const float (&bet)[16]) {
    float s = 0.f;
#pragma unroll
    for (int i = 0; i < 16; ++i) s += v[i];
    const float mean = wave_sum(s) * (1.f / D); float q = 0.f;
#pragma unroll
    for (int i = 0; i < 16; ++i) { v[i] -= mean; q += v[i] * v[i]; }
    const float rstd = 1.0f / sqrtf(wave_sum(q) * (1.f / D) + LN_EPS);
#pragma unroll
    for (int i = 0; i < 16; ++i) v[i] = v[i] * rstd * gam[i] + bet[i];
}
__device__ __forceinline__ void ln1_route(const Frame& F, int layer, const float* lng, const float* lnb, const float* rw, const float* rb) {
    const float* MODV = (const float*)(F.ws + WS_MODV); bf16* HA = (bf16*)(F.ws + WS_HA); bf16* XR = (bf16*)(F.ws + WS_XR); const bf16* Y = (const bf16*)(F.ws + WS_Y);
    int* TOKE = (int*)(F.ws + WS_TOKE); float* TOKW = (float*)(F.ws + WS_TOKW); int* LIST = (int*)(F.ws + WS_LIST);
    unsigned* CNT = (unsigned*)(F.ws + WS_CTL) + CW_CNT + layer * 16 * 64;
    LAS float* srw = (LAS float*)F.lds;
    LAS float* slog = (LAS float*)(F.lds + 65536);
    LAS int* s_e = (LAS int*)(F.lds + 66560);
    LAS int* s_r = (LAS int*)(F.lds + 66560 + 2048);
    LAS int* s_hist = (LAS int*)(F.lds + 66560 + 4096);
    const int TPB = T / F.G, t0 = (F.flip ? (F.G - 1 - F.vcu) : F.vcu) * TPB;
    for (int idx = F.tid; idx < 1024 * 16; idx += NTHR) { const int c = idx >> 4, e = idx & 15, ln = (c & 511) >> 3, i = ((c >> 9) << 3) | (c & 7);
        srw[(((i * 4 + (e >> 2)) * 64 + ln) << 2) + (e & 3)] = rw[idx]; }
    if (F.tid < 32) s_hist[F.tid] = 0;
    __syncthreads();
    const int bt = t0 / SEQ; const float* mv = MODV + ((size_t)layer * 5 + bt) * 6144;
    float cy[16], gam[16], bet[16], sc2[16], sh2[16];
    ld16f(mv + 2048, cy, F.lane); ld16f(lng + (size_t)(layer * 2 + 0) * D, gam, F.lane); ld16f(lnb + (size_t)(layer * 2 + 0) * D, bet, F.lane);
    ld16f(mv + 4096, sc2, F.lane); ld16f(mv + 3072, sh2, F.lane);
#pragma unroll
    for (int i = 0; i < 16; ++i) { cy[i] += 1.f; sc2[i] += 1.f; }
    u32x4 pxa, pxc, pya, pyc;
    ldraw(XR + (size_t)(t0 + F.wave) * D, pxa, pxc, F.lane); ldraw(Y + (size_t)(t0 + F.wave) * D, pya, pyc, F.lane);
    for (int r = F.wave; r < TPB; r += NWAVES) {
        const int t = t0 + r; float v[16], y[16];
        unpack16(pxa, pxc, v); unpack16(pya, pyc, y);
        if (r + NWAVES < TPB) { ldraw(XR + (size_t)(t + NWAVES) * D, pxa, pxc, F.lane); ldraw(Y + (size_t)(t + NWAVES) * D, pya, pyc, F.lane); }
#pragma unroll
        for (int i = 0; i < 16; ++i) v[i] = ALPHA * v[i] + cy[i] * y[i];
        ln16(v, gam, bet);
        st16b(XR + (size_t)t * D, v, F.lane);
#pragma unroll
        for (int i = 0; i < 16; ++i) v[i] = v[i] * sc2[i] + sh2[i];
        st16b(HA + (size_t)t * D, v, F.lane);
#ifdef MK_Y2_SENTINEL
        { bf16* y2 = (bf16*)(F.ws + WS_Y2); const u32x4 q_ = {0x7fc07fc0u, 0x7fc07fc0u, 0x7fc07fc0u, 0x7fc07fc0u};
          *(u32x4*)(y2 + (size_t)(2 * t) * D + F.lane * 8) = q_; *(u32x4*)(y2 + (size_t)(2 * t) * D + 512 + F.lane * 8) = q_;
          *(u32x4*)(y2 + (size_t)(2 * t + 1) * D + F.lane * 8) = q_; *(u32x4*)(y2 + (size_t)(2 * t + 1) * D + 512 + F.lane * 8) = q_; }
#endif
        float lg[16];
#pragma unroll
        for (int e = 0; e < 16; ++e) lg[e] = 0.f;
#pragma unroll
        for (int i = 0; i < 16; ++i) {
            const LAS f32x4* wp = (const LAS f32x4*)srw + (i * 4) * 64 + F.lane;
            const f32x4 w0 = wp[0], w1 = wp[64], w2 = wp[128], w3 = wp[192];
            lg[0] += v[i] * w0.x; lg[1] += v[i] * w0.y; lg[2] += v[i] * w0.z; lg[3] += v[i] * w0.w;
            lg[4] += v[i] * w1.x; lg[5] += v[i] * w1.y; lg[6] += v[i] * w1.z; lg[7] += v[i] * w1.w;
            lg[8] += v[i] * w2.x; lg[9] += v[i] * w2.y; lg[10] += v[i] * w2.z; lg[11] += v[i] * w2.w;
            lg[12] += v[i] * w3.x; lg[13] += v[i] * w3.y; lg[14] += v[i] * w3.z; lg[15] += v[i] * w3.w;
        }
        {
            float s8[8], t4[4];
#pragma unroll
            for (int k = 0; k < 8; ++k) { auto r_ = __builtin_amdgcn_permlane32_swap(__float_as_uint(lg[2 * k]), __float_as_uint(lg[2 * k + 1]), false, false); s8[k] = __uint_as_float(r_[0]) + __uint_as_float(r_[1]); }
#pragma unroll
            for (int j = 0; j < 4; ++j) { auto r_ = __builtin_amdgcn_permlane16_swap(__float_as_uint(s8[2 * j]), __float_as_uint(s8[2 * j + 1]), false, false); t4[j] = row16_sum(__uint_as_float(r_[0]) + __uint_as_float(r_[1])); }
            LAS float* sl = slog + F.wave * 16; const int rr = F.lane >> 4, ex = ((rr & 1) << 1) | (rr >> 1);
            if ((F.lane & 15) == 0) { sl[ex] = t4[0]; sl[4 + ex] = t4[1]; sl[8 + ex] = t4[2]; sl[12 + ex] = t4[3]; }
            LDS_WAIT(); asm volatile("" ::: "memory");
            const f32x4 q0_ = *(const LAS f32x4*)sl, q1_ = *(const LAS f32x4*)(sl + 4), q2_ = *(const LAS f32x4*)(sl + 8), q3_ = *(const LAS f32x4*)(sl + 12);
            lg[0] = q0_.x; lg[1] = q0_.y; lg[2] = q0_.z; lg[3] = q0_.w; lg[4] = q1_.x; lg[5] = q1_.y; lg[6] = q1_.z; lg[7] = q1_.w;
            lg[8] = q2_.x; lg[9] = q2_.y; lg[10] = q2_.z; lg[11] = q2_.w; lg[12] = q3_.x; lg[13] = q3_.y; lg[14] = q3_.z; lg[15] = q3_.w;
            LDS_WAIT(); asm volatile("" ::: "memory");
        }
        float mx = lg[0] + rb[0];
#pragma unroll
        for (int e = 0; e < 16; ++e) { lg[e] += rb[e]; mx = fmaxf(mx, lg[e]); }
        float pe[16];
#pragma unroll
        for (int e = 0; e < 16; ++e) pe[e] = __expf(lg[e] - mx);
        float best = -1.f; int bg = 0; float q0 = 0.f, q1 = 0.f, q2 = 0.f, q3 = 0.f;
#pragma unroll
        for (int g = 0; g < 4; ++g) {
            const float a = pe[4 * g], b = pe[4 * g + 1], c = pe[4 * g + 2], d = pe[4 * g + 3];
            const float m1 = fmaxf(fmaxf(a, b), fmaxf(c, d));
            const float m2 = fmaxf(fmaxf(fminf(a, b), fminf(c, d)), fminf(fmaxf(a, b), fmaxf(c, d)));
            const float gs = m1 + m2; const bool better = gs > best;
            best = better ? gs : best; bg = better ? g : bg; q0 = better ? a : q0; q1 = better ? b : q1; q2 = better ? c : q2; q3 = better ? d : q3;
        }
        int i0 = 0; float v0 = q0;
        if (q1 > v0) { v0 = q1; i0 = 1; } if (q2 > v0) { v0 = q2; i0 = 2; } if (q3 > v0) { v0 = q3; i0 = 3; }
        int i1 = -1; float v1 = -1.f;
        if (i0 != 0 && q0 > v1) { v1 = q0; i1 = 0; } if (i0 != 1 && q1 > v1) { v1 = q1; i1 = 1; }
        if (i0 != 2 && q2 > v1) { v1 = q2; i1 = 2; } if (i0 != 3 && q3 > v1) { v1 = q3; i1 = 3; }
        const float inv = 1.0f / (v0 + v1);
        if (F.lane == 0) {
            const int e0 = bg * 4 + i0, e1 = bg * 4 + i1;
            TOKE[2 * t] = e0; TOKE[2 * t + 1] = e1; TOKW[2 * t] = v0 * inv; TOKW[2 * t + 1] = v1 * inv;
            s_e[2 * r] = e0; s_e[2 * r + 1] = e1;
            s_r[2 * r] = atomicAdd((int*)&s_hist[e0], 1); s_r[2 * r + 1] = atomicAdd((int*)&s_hist[e1], 1);
        }
    }
    __syncthreads();
    if (F.tid < 16) s_hist[16 + F.tid] = (int)atomicAdd(CNT + F.tid * 64, (unsigned)s_hist[F.tid]);
    __syncthreads();
    for (int i = F.tid; i < 2 * TPB; i += NTHR) { const int e = s_e[i]; const int rk = F.flip ? (s_hist[e] - 1 - s_r[i]) : s_r[i]; LIST[e * T + s_hist[16 + e] + rk] = (t0 + (i >> 1)) * 2 + (i & 1); }
    __syncthreads();
}
__device__ __forceinline__ void ln2_phase(const Frame& F, int layer, const float* lng, const float* lnb, float* out) {
    const float* MODV = (const float*)(F.ws + WS_MODV); bf16* HA = (bf16*)(F.ws + WS_HA); bf16* XR = (bf16*)(F.ws + WS_XR); const bf16* Y2 = (const bf16*)(F.ws + WS_Y2);
    const int TPB = T / F.G, t0 = F.vcu * TPB, bt = t0 / SEQ;
    const float* mv = MODV + ((size_t)layer * 5 + bt) * 6144; const float* mvn = MODV + ((size_t)(layer + 1 < NLAYER ? layer + 1 : layer) * 5 + bt) * 6144;
    float cy[16], gam[16], bet[16], sc1[16], sh1[16];
    ld16f(mv + 5120, cy, F.lane); ld16f(lng + (size_t)(layer * 2 + 1) * D, gam, F.lane); ld16f(lnb + (size_t)(layer * 2 + 1) * D, bet, F.lane);
    ld16f(mvn + 1024, sc1, F.lane); ld16f(mvn, sh1, F.lane);
#pragma unroll
    for (int i = 0; i < 16; ++i) { cy[i] += 1.f; sc1[i] += 1.f; }
    u32x4 pxa, pxc, paa, pac, pba, pbc;
    ldraw(XR + (size_t)(t0 + F.wave) * D, pxa, pxc, F.lane); ldraw(Y2 + (size_t)(2 * (t0 + F.wave)) * D, paa, pac, F.lane); ldraw(Y2 + (size_t)(2 * (t0 + F.wave) + 1) * D, pba, pbc, F.lane);
    for (int r = F.wave; r < TPB; r += NWAVES) {
        const int t = t0 + r; float v[16], ya[16], yb[16];
        unpack16(pxa, pxc, v); unpack16(paa, pac, ya); unpack16(pba, pbc, yb);
        if (r + NWAVES < TPB) { const int tn = t + NWAVES; ldraw(XR + (size_t)tn * D, pxa, pxc, F.lane); ldraw(Y2 + (size_t)(2 * tn) * D, paa, pac, F.lane); ldraw(Y2 + (size_t)(2 * tn + 1) * D, pba, pbc, F.lane); }
#pragma unroll
        for (int i = 0; i < 16; ++i) v[i] = ALPHA * v[i] + cy[i] * (ya[i] + yb[i]);
        ln16(v, gam, bet);
#ifdef MK_DBG4
        if (layer == NLAYER - 1) {
            unsigned hi_ = 0u, ho_ = 0u;
            { float a_[16], b_[16], c_[16]; ld16b(XR + (size_t)t * D, a_, F.lane); ld16b(Y2 + (size_t)(2 * t) * D, b_, F.lane); ld16b(Y2 + (size_t)(2 * t + 1) * D, c_, F.lane);
#pragma unroll
              for (int i = 0; i < 16; ++i) hi_ = hi_ * 0x9E3779B1u + (__float_as_uint(a_[i]) ^ (__float_as_uint(b_[i]) * 3u) ^ (__float_as_uint(c_[i]) * 7u)) * (2u * i + 1u); }
#pragma unroll
            for (int i = 0; i < 16; ++i) ho_ = ho_ * 0x9E3779B1u + __float_as_uint(v[i]) * (2u * i + 1u);
#pragma unroll
            for (int o = 1; o < 64; o <<= 1) { hi_ += __shfl_xor(hi_, o) * 31u; ho_ += __shfl_xor(ho_, o) * 31u; }
            unsigned* HH = (unsigned*)(F.ws + (F.flip ? 11 : 10) * MiB);
            if (F.lane == 0) { HH[2 * t] = hi_; HH[2 * t + 1] = ho_; }
        }
#endif
        if (layer == NLAYER - 1) {
#ifdef MK_DBG_STOP
            st16b(XR + (size_t)t * D, v, F.lane);
#endif
            st16f(out + (size_t)t * D, v, F.lane);
        } else {
            st16b(XR + (size_t)t * D, v, F.lane);
#pragma unroll
            for (int i = 0; i < 16; ++i) v[i] = v[i] * sc1[i] + sh1[i];
            st16b(HA + (size_t)t * D, v, F.lane);
        }
    }
#ifdef MK_READBACK
    if (layer == NLAYER - 1) {
        asm volatile("s_waitcnt vmcnt(0)" ::: "memory");
        const int r_last = F.wave + ((TPB - 1 - F.wave) / NWAVES) * NWAVES;
        const unsigned long long* p0 = (const unsigned long long*)(out + (size_t)(t0 + r_last) * D + F.lane * 8); const unsigned long long* p1 = p0 + 256;
        unsigned long long x = 0;
#pragma unroll
        for (int i = 0; i < 4; ++i) { x ^= __hip_atomic_load(p0 + i, __ATOMIC_RELAXED, __HIP_MEMORY_SCOPE_SYSTEM); x ^= __hip_atomic_load(p1 + i, __ATOMIC_RELAXED, __HIP_MEMORY_SCOPE_SYSTEM); }
        asm volatile("s_waitcnt vmcnt(0)" :: "v"(x) : "memory");
    }
#endif
}
__device__ __forceinline__ void pool_pre(const Frame& F) {
    const bf16* HA = (const bf16*)(F.ws + WS_HA); bf16* PO = (bf16*)(F.ws + WS_POOLED);
    const int w0 = F.lane < 32 ? 2 : 4, w1 = F.lane < 32 ? 8 : 16;
    for (int t = F.gw; t < T; t += F.NGW) {
        const int l = t % SEQ; float s0[8], s1[8], c0[8], c1[8];
#pragma unroll
        for (int i = 0; i < 8; ++i) { s0[i] = 0.f; s1[i] = 0.f; }
        int n0 = 0, n1 = 0;
#pragma unroll
        for (int dt = -8; dt < 8; ++dt) {
            const int ll = l + dt; const bool inb = ll >= 0 && ll < SEQ;
            const bool u0 = inb && dt >= -(w0 >> 1) && dt < (w0 >> 1), u1 = inb && dt >= -(w1 >> 1) && dt < (w1 >> 1);
            const bf16* row = HA + (size_t)(t + dt) * D;
            if (u0) { const u32x4 a = *(const u32x4*)(row + F.lane * 8); n0++;
                const float f[8] = {bflo(a.x), bfhi(a.x), bflo(a.y), bfhi(a.y), bflo(a.z), bfhi(a.z), bflo(a.w), bfhi(a.w)};
#pragma unroll
                for (int i = 0; i < 8; ++i) { s0[i] += f[i]; if (dt == 0) c0[i] = f[i]; } }
            if (u1) { const u32x4 a = *(const u32x4*)(row + 512 + F.lane * 8); n1++;
                const float f[8] = {bflo(a.x), bfhi(a.x), bflo(a.y), bfhi(a.y), bflo(a.z), bfhi(a.z), bflo(a.w), bfhi(a.w)};
#pragma unroll
                for (int i = 0; i < 8; ++i) { s1[i] += f[i]; if (dt == 0) c1[i] = f[i]; } }
        }
        const float r0 = 1.0f / (float)n0, r1 = 1.0f / (float)n1; float o[16];
#pragma unroll
        for (int i = 0; i < 8; ++i) { o[i] = s0[i] * r0 - c0[i]; o[8 + i] = s1[i] * r1 - c1[i]; }
        st16b(PO + (size_t)t * D, o, F.lane);
    }
}
__device__ __forceinline__ void hyena_conv(const Frame& F, const float* cw, const float* cb) {
    const bf16* Z = (const bf16*)(F.ws + WS_Z); bf16* VP = (bf16*)(F.ws + WS_VP); bf16* X0 = (bf16*)(F.ws + WS_X0);
    for (int task = F.gw; task < (T / 32) * 2; task += F.NGW) {
        const int chunk = task >> 1, half = task & 1, t0 = chunk * 32, l0 = t0 % SEQ, cbase = half * 512 + F.lane * 8;
        float w[3][3][8], bia[3][8];
#pragma unroll
        for (int s = 0; s < 3; ++s) {
#pragma unroll
            for (int tp = 0; tp < 3; ++tp) { const f32x4 a = *(const f32x4*)(cw + tp * 3072 + s * 1024 + cbase), b = *(const f32x4*)(cw + tp * 3072 + s * 1024 + cbase + 4);
                w[s][tp][0] = a.x; w[s][tp][1] = a.y; w[s][tp][2] = a.z; w[s][tp][3] = a.w; w[s][tp][4] = b.x; w[s][tp][5] = b.y; w[s][tp][6] = b.z; w[s][tp][7] = b.w; }
            const f32x4 a = *(const f32x4*)(cb + s * 1024 + cbase), b = *(const f32x4*)(cb + s * 1024 + cbase + 4);
            bia[s][0] = a.x; bia[s][1] = a.y; bia[s][2] = a.z; bia[s][3] = a.w; bia[s][4] = b.x; bia[s][5] = b.y; bia[s][6] = b.z; bia[s][7] = b.w;
        }
        u32x4 prv[3], cur[3], nxt[3];
#pragma unroll
        for (int s = 0; s < 3; ++s) {
            prv[s] = l0 > 0 ? *(const u32x4*)(Z + (size_t)(t0 - 1) * 3072 + s * 1024 + cbase) : (u32x4){0u, 0u, 0u, 0u};
            cur[s] = *(const u32x4*)(Z + (size_t)t0 * 3072 + s * 1024 + cbase);
        }
        for (int r = 0; r < 32; ++r) {
            const int t = t0 + r; const bool hasn = (l0 + r + 1) < SEQ;
#pragma unroll
            for (int s = 0; s < 3; ++s) nxt[s] = hasn ? *(const u32x4*)(Z + (size_t)(t + 1) * 3072 + s * 1024 + cbase) : (u32x4){0u, 0u, 0u, 0u};
            float o[3][8];
#pragma unroll
            for (int s = 0; s < 3; ++s) {
                const unsigned pw[4] = {prv[s].x, prv[s].y, prv[s].z, prv[s].w}, cwd[4] = {cur[s].x, cur[s].y, cur[s].z, cur[s].w}, nw[4] = {nxt[s].x, nxt[s].y, nxt[s].z, nxt[s].w};
#pragma unroll
                for (int i = 0; i < 4; ++i) {
                    o[s][2 * i] = bflo(pw[i]) * w[s][0][2 * i] + bflo(cwd[i]) * w[s][1][2 * i] + bflo(nw[i]) * w[s][2][2 * i] + bia[s][2 * i];
                    o[s][2 * i + 1] = bfhi(pw[i]) * w[s][0][2 * i + 1] + bfhi(cwd[i]) * w[s][1][2 * i + 1] + bfhi(nw[i]) * w[s][2][2 * i + 1] + bia[s][2 * i + 1];
                }
            }
            u32x4 ov, ox;
            ov.x = pk2(o[2][0] * o[1][0], o[2][1] * o[1][1]); ov.y = pk2(o[2][2] * o[1][2], o[2][3] * o[1][3]);
            ov.z = pk2(o[2][4] * o[1][4], o[2][5] * o[1][5]); ov.w = pk2(o[2][6] * o[1][6], o[2][7] * o[1][7]);
            ox.x = pk2(o[0][0], o[0][1]); ox.y = pk2(o[0][2], o[0][3]); ox.z = pk2(o[0][4], o[0][5]); ox.w = pk2(o[0][6], o[0][7]);
            *(u32x4*)(VP + (size_t)t * D + cbase) = ov; *(u32x4*)(X0 + (size_t)t * D + cbase) = ox;
#pragma unroll
            for (int s = 0; s < 3; ++s) { prv[s] = cur[s]; cur[s] = nxt[s]; }
        }
    }
}
__device__ __forceinline__ void hyena_kfull(const Frame& F, const float* f3) {
    const float* A2 = (const float*)(F.ws + WS_A2); bf16* KF = (bf16*)(F.ws + WS_KFULL);
    const float dlo = -3.0701134573253943f, dhi = -15.350567286626972f;
    for (int n = F.gw; n < 2 * SEQ; n += F.NGW) {
        float o[16];
        if (n == SEQ) {
#pragma unroll
            for (int i = 0; i < 16; ++i) o[i] = 0.f;
        } else {
            const int t = n < SEQ ? n : 2 * SEQ - n, coff = n < SEQ ? 0 : 1024;
            const float a = A2[(size_t)t * 64 + F.lane];
#pragma unroll
            for (int i = 0; i < 16; ++i) o[i] = 0.f;
            for (int j = 0; j < 64; ++j) {
                const float aj = __shfl(a, j); float fv[16];
                ld16f(f3 + (size_t)j * 2048 + coff, fv, F.lane);
#pragma unroll
                for (int i = 0; i < 16; ++i) o[i] += aj * fv[i];
            }
            const float tt = (float)t * (1.f / 8192.f);
#pragma unroll
            for (int i = 0; i < 16; ++i) { const int d = (i < 8 ? 0 : 512) + F.lane * 8 + (i & 7); const float delta = -(dlo + (dhi - dlo) * (float)d * (1.f / 1023.f)); o[i] *= __expf(-tt * delta); }
        }
        st16b(KF + (size_t)n * D, o, F.lane);
    }
}
namespace att {
constexpr int QBLK = 32, KVBLK = 64;
constexpr float SCALE = 0.125f, THR = 8.f;
constexpr int SHM_V = KVBLK * 128 * 2, SHM_K = KVBLK * 64 * 2;
constexpr int OFF_V = 0, OFF_K = 2 * SHM_V, OFF_WS = OFF_K + 2 * SHM_K, OFF_O0 = OFF_WS + NWAVES * 64 * 4;
constexpr int LDS_NEED = OFF_O0 + NWAVES * 8192;
static_assert(LDS_NEED <= LDS_SCRATCH, "attention LDS");
#define KSWZ64(row, colB) ((row) * 128 + ((colB) ^ (((row) & 7) << 4)))
#define SBAR() __builtin_amdgcn_sched_barrier(0)
__device__ __forceinline__ int crow(int r, int hi) { return (r & 3) + 8 * (r >> 2) + 4 * hi; }
__device__ __forceinline__ unsigned cvtpk(float lo, float hi) { unsigned r; asm volatile("v_cvt_pk_bf16_f32 %0, %1, %2" : "=v"(r) : "v"(lo), "v"(hi)); return r; }

__device__ __forceinline__ void partialSM(f32x16& p0, f32x16& p1, float& m_reg, float& mn, float& alpha) {
    constexpr float C = SCALE * 1.4426950408889634f;
    float pmax = p0[0];
#pragma unroll
    for (int r = 1; r < 16; ++r) pmax = fmaxf(pmax, p0[r]);
#pragma unroll
    for (int r = 0; r < 16; ++r) pmax = fmaxf(pmax, p1[r]);
    { auto rr = __builtin_amdgcn_permlane32_swap(__float_as_uint(pmax), __float_as_uint(pmax), false, false);
      pmax = fmaxf(__uint_as_float(rr[0]), __uint_as_float(rr[1])); }
    if (__builtin_expect(__all(pmax - m_reg <= THR / SCALE), 1)) { mn = m_reg; alpha = 1.f; }
    else { mn = fmaxf(m_reg, pmax); alpha = __builtin_amdgcn_exp2f((m_reg - mn) * C); m_reg = mn; }
    const float mnC = -mn * C;
#pragma unroll
    for (int r = 0; r < 16; ++r) p0[r] = fmaf(p0[r], C, mnC);
#pragma unroll
    for (int r = 0; r < 16; ++r) p1[r] = fmaf(p1[r], C, mnC);
#pragma unroll
    for (int r = 0; r < 16; ++r) p0[r] = __builtin_amdgcn_exp2f(p0[r]);
}
__device__ __forceinline__ void finishSM(f32x16& p0, f32x16& p1, float alpha, float& l_reg, bf16x8& pa0, bf16x8& pa1, bf16x8& pa2, bf16x8& pa3) {
#pragma unroll
    for (int r = 0; r < 16; ++r) p1[r] = __builtin_amdgcn_exp2f(p1[r]);
    float ps = 0;
#pragma unroll
    for (int r = 0; r < 16; ++r) ps += p0[r];
#pragma unroll
    for (int r = 0; r < 16; ++r) ps += p1[r];
    { auto rr = __builtin_amdgcn_permlane32_swap(__float_as_uint(ps), __float_as_uint(ps), false, false);
      ps = __uint_as_float(rr[0]) + __uint_as_float(rr[1]); }
    l_reg = l_reg * alpha + ps;
#define PK4(P, BASE, OUT) do { unsigned a0 = cvtpk(P[BASE + 0], P[BASE + 1]), a1 = cvtpk(P[BASE + 2], P[BASE + 3]);   \
    unsigned b0 = cvtpk(P[BASE + 4], P[BASE + 5]), b1 = cvtpk(P[BASE + 6], P[BASE + 7]);                              \
    auto r0 = __builtin_amdgcn_permlane32_swap(a0, b0, false, false); auto r1 = __builtin_amdgcn_permlane32_swap(a1, b1, false, false); \
    u32x4 w = {r0[0], r1[0], r0[1], r1[1]}; OUT = *reinterpret_cast<bf16x8*>(&w); } while (0)
    PK4(p0, 0, pa0); PK4(p0, 8, pa1); PK4(p1, 0, pa2); PK4(p1, 8, pa3);
#undef PK4
}
__device__ __forceinline__ void qkt(f32x16& p0, f32x16& p1, const LAS unsigned char* Ks, const bf16x8* qr, int r32, int hi) {
    p0 = f32x16{}; p1 = f32x16{};
#pragma unroll
    for (int d0 = 0; d0 < 4; ++d0) { const int cb = (d0 * 16 + hi * 8) * 2;
        const bf16x8 b0 = *(const LAS bf16x8*)(Ks + KSWZ64(r32, cb));
        const bf16x8 b1 = *(const LAS bf16x8*)(Ks + KSWZ64(32 + r32, cb));
        p0 = __builtin_amdgcn_mfma_f32_32x32x16_bf16(b0, qr[d0], p0, 0, 0, 0);
        p1 = __builtin_amdgcn_mfma_f32_32x32x16_bf16(b1, qr[d0], p1, 0, 0, 0); }
}
__device__ __forceinline__ int v_st(int k, int c) { const int kk = (k & ~0xC) | ((k & 4) << 1) | ((k & 8) >> 1); return ((kk >> 3) * 4 + (c >> 5)) * 512 + ((kk & 7) * 32 + (c & 31)) * 2; }
__device__ __forceinline__ int v_rd_base(int lane) { return ((lane & 3) << 3) | (((lane >> 2) & 3) << 6) | (((lane >> 4) & 1) << 5) | (((lane >> 5) & 1) << 8); }
constexpr int v_rd_off(int d0, int ks, int half) { return d0 * 512 + ks * 4096 + half * 2048; }
template <int OFF> __device__ __forceinline__ s16x4 tr_read(int vb) {
    s16x4 r; asm volatile("ds_read_b64_tr_b16 %0, %1 offset:%2" : "=&v"(r) : "v"(vb), "i"(OFF) : "memory"); return r;
}
template <int D0> __device__ __forceinline__ void pv_one(f32x16& od, int vb, bf16x8 pa0, bf16x8 pa1, bf16x8 pa2, bf16x8 pa3) {
    const s16x4 l0 = tr_read<v_rd_off(D0, 0, 0)>(vb), h0 = tr_read<v_rd_off(D0, 0, 1)>(vb), l1 = tr_read<v_rd_off(D0, 1, 0)>(vb), h1 = tr_read<v_rd_off(D0, 1, 1)>(vb);
    const s16x4 l2 = tr_read<v_rd_off(D0, 2, 0)>(vb), h2 = tr_read<v_rd_off(D0, 2, 1)>(vb), l3 = tr_read<v_rd_off(D0, 3, 0)>(vb), h3 = tr_read<v_rd_off(D0, 3, 1)>(vb);
    asm volatile("s_waitcnt lgkmcnt(0)" ::: "memory"); SBAR();
#define PK(L, H) (bf16x8){L[0], L[1], L[2], L[3], H[0], H[1], H[2], H[3]}
    od = __builtin_amdgcn_mfma_f32_32x32x16_bf16(pa0, PK(l0, h0), od, 0, 0, 0);
    od = __builtin_amdgcn_mfma_f32_32x32x16_bf16(pa1, PK(l1, h1), od, 0, 0, 0);
    od = __builtin_amdgcn_mfma_f32_32x32x16_bf16(pa2, PK(l2, h2), od, 0, 0, 0);
    od = __builtin_amdgcn_mfma_f32_32x32x16_bf16(pa3, PK(l3, h3), od, 0, 0, 0);
#undef PK
}
__device__ __forceinline__ void pv_d0(f32x16* o, int vb, bf16x8 pa0, bf16x8 pa1, bf16x8 pa2, bf16x8 pa3) {
    pv_one<0>(o[0], vb, pa0, pa1, pa2, pa3); pv_one<1>(o[1], vb, pa0, pa1, pa2, pa3); pv_one<2>(o[2], vb, pa0, pa1, pa2, pa3); pv_one<3>(o[3], vb, pa0, pa1, pa2, pa3);
}

template <int PASS>
__device__ __forceinline__ void attn_pass(const bf16* __restrict__ Qb, const bf16* __restrict__ Kh, const bf16* __restrict__ Vh, bf16* __restrict__ Ob,
                                          float lam, const float* __restrict__ subln, float post, LAS unsigned char* lds, const int tid_in) {
    constexpr int LDK = 1024, seq = LK;
    int tid = tid_in; asm volatile("" : "+v"(tid));
    const int wid = tid >> 6, lane = tid & 63, r32 = lane & 31, hi = lane >> 5;
    LAS unsigned char* V_lds = lds + OFF_V; LAS unsigned char* K_lds = lds + OFF_K;
    LAS float* wsl = (LAS float*)(lds + OFF_WS) + wid * 64; LAS float* li_l = wsl; LAS float* al_l = wsl + 32;
    LAS unsigned* park = (LAS unsigned*)(lds + OFF_O0 + wid * 8192);
    float m_reg = -1e30f, l_reg = 0; f32x16 o[4] = {}; bf16x8 qr[4];
    const bf16* Qw = Qb + (size_t)(wid * QBLK + r32) * 1024 + hi * 8;
#pragma unroll
    for (int d0 = 0; d0 < 4; ++d0) qr[d0] = *(const bf16x8*)(Qw + d0 * 16);
    const int sr = tid >> 4, sc = (tid & 15) * 8, vst0 = v_st(sr, sc), vst1 = v_st(32 + sr, sc);
    const int kr = tid >> 3, kc = (tid & 7) * 8, kst = KSWZ64(kr, kc * 2);
    const int vb0 = (int)(uintptr_t)V_lds + v_rd_base(lane);
    struct { bf16x8 vs0, vs1, ks0; } sr_[1];
#define SLOAD(i, k0) do { sr_[i].vs0 = *(const bf16x8*)(&Vh[(size_t)((k0) + sr) * LDK + sc]); sr_[i].vs1 = *(const bf16x8*)(&Vh[(size_t)((k0) + 32 + sr) * LDK + sc]); \
    sr_[i].ks0 = *(const bf16x8*)(&Kh[(size_t)((k0) + kr) * LDK + kc]); } while (0)
#define SWRITE(b, i) do { *(LAS bf16x8*)(V_lds + (b) * SHM_V + vst0) = sr_[i].vs0; *(LAS bf16x8*)(V_lds + (b) * SHM_V + vst1) = sr_[i].vs1; \
    *(LAS bf16x8*)(K_lds + (b) * SHM_K + kst) = sr_[i].ks0; } while (0)
#define SWAIT() asm volatile("s_waitcnt vmcnt(0)" ::: "memory")
#define RESC(a) do { if (__any((a) < 1.f)) { if (hi == 0) al_l[r32] = (a); asm volatile("s_waitcnt lgkmcnt(0)" ::: "memory"); \
    _Pragma("unroll") for (int d = 0; d < 4; ++d) _Pragma("unroll") for (int r = 0; r < 16; ++r) o[d][r] *= al_l[crow(r, hi)]; } } while (0)
    f32x16 pA0, pA1, pB0, pB1; float mnA, mnB, alA, alB; bf16x8 pa0, pa1, pa2, pa3; constexpr int NT = seq / KVBLK;
    constexpr int SE = 0, SO = 0;
    SLOAD(SE, 0); asm volatile("s_waitcnt vmcnt(0)" ::: "memory"); SWRITE(0, SE); __syncthreads();
    qkt(pA0, pA1, K_lds, qr, r32, hi); partialSM(pA0, pA1, m_reg, mnA, alA);
    SLOAD(SO, KVBLK);
    SWAIT(); SWRITE(1, SO); __syncthreads();
    for (int j = 1; j + 1 < NT; j += 2) {
        SBAR(); qkt(pB0, pB1, K_lds + SHM_K, qr, r32, hi);
        finishSM(pA0, pA1, alA, l_reg, pa0, pa1, pa2, pa3); SBAR();
        SLOAD(SO, (j + 1) * KVBLK); SBAR();
        pv_d0(o, vb0, pa0, pa1, pa2, pa3); partialSM(pB0, pB1, m_reg, mnB, alB);
        __syncthreads(); SWAIT(); SWRITE(0, SE);
        RESC(alB); __syncthreads();
        SBAR(); qkt(pA0, pA1, K_lds, qr, r32, hi);
        finishSM(pB0, pB1, alB, l_reg, pa0, pa1, pa2, pa3); SBAR();
        SLOAD(SE, (j + 2) * KVBLK); SBAR();
        pv_d0(o, vb0 + SHM_V, pa0, pa1, pa2, pa3); partialSM(pA0, pA1, m_reg, mnA, alA);
        __syncthreads(); SWAIT(); SWRITE(1, SO);
        RESC(alA); __syncthreads();
    }
    SBAR(); qkt(pB0, pB1, K_lds + SHM_K, qr, r32, hi);
    finishSM(pA0, pA1, alA, l_reg, pa0, pa1, pa2, pa3); SBAR();
    pv_d0(o, vb0, pa0, pa1, pa2, pa3); partialSM(pB0, pB1, m_reg, mnB, alB);
    __syncthreads(); RESC(alB);
    finishSM(pB0, pB1, alB, l_reg, pa0, pa1, pa2, pa3); SBAR();
    pv_d0(o, vb0 + SHM_V, pa0, pa1, pa2, pa3);
    if (hi == 0) li_l[r32] = l_reg; asm volatile("s_waitcnt lgkmcnt(0)" ::: "memory");
    float rli[16];
#pragma unroll
    for (int r = 0; r < 16; ++r) rli[r] = __builtin_amdgcn_rcpf(li_l[crow(r, hi)]);
    if constexpr (PASS == 0) {
#pragma unroll
        for (int d0 = 0; d0 < 4; ++d0)
#pragma unroll
            for (int r = 0; r < 16; r += 2) park[(d0 * 8 + (r >> 1)) * 64 + lane] = cvtpk(o[d0][r] * rli[r], o[d0][r + 1] * rli[r + 1]);
    } else {
        float ss[16];
#pragma unroll
        for (int r = 0; r < 16; r += 2) {
            float s0 = 0.f, s1 = 0.f;
#pragma unroll
            for (int d0 = 0; d0 < 4; ++d0) { const unsigned w = park[(d0 * 8 + (r >> 1)) * 64 + lane];
                const float a = bflo(w) - lam * (o[d0][r] * rli[r]), b = bfhi(w) - lam * (o[d0][r + 1] * rli[r + 1]);
                o[d0][r] = a; o[d0][r + 1] = b; s0 += a * a; s1 += b * b; }
            ss[r] = s0; ss[r + 1] = s1;
        }
#pragma unroll
        for (int r = 0; r < 16; ++r) {
            float s = ss[r];
            s += __shfl_xor(s, 1); s += __shfl_xor(s, 2); s += __shfl_xor(s, 4); s += __shfl_xor(s, 8); s += __shfl_xor(s, 16);
            ss[r] = post * (1.0f / sqrtf(s * (1.f / 128.f) + LN_EPS));
        }
        float sl[4];
#pragma unroll
        for (int d0 = 0; d0 < 4; ++d0) sl[d0] = subln[d0 * 32 + r32];
        bf16* Ow = Ob + (size_t)(wid * QBLK) * 1024;
#pragma unroll
        for (int r = 0; r < 16; ++r) { const int orow = crow(r, hi);
#pragma unroll
            for (int d0 = 0; d0 < 4; ++d0) Ow[(size_t)orow * 1024 + d0 * 32 + r32] = (bf16)(cvtpk(o[d0][r] * ss[r] * sl[d0], 0.f) & 0xffff); }
    }
    __syncthreads();
#undef SLOAD
#undef SWRITE
#undef SWAIT
#undef RESC
}
}
__device__ __forceinline__ void st4(bf16* p, f32x4 v) { *(u32x2*)p = (u32x2){pk2(v.x, v.y), pk2(v.z, v.w)}; }

template <int lda, int ldb, int ldc, int KK>
struct PlainP {
    const bf16* a0; const bf16* b0; bf16* out; const float* bias; const float* scale;
    static constexpr int K = KK;
    __device__ __forceinline__ const bf16* abase() const { return a0; }
    __device__ __forceinline__ const bf16* bbase() const { return b0; }
    __device__ __forceinline__ unsigned aoff(int r) const { return (unsigned)(r * lda); }
    __device__ __forceinline__ unsigned boff(int r) const { return (unsigned)(r * ldb); }
    __device__ __forceinline__ void epi(f32x4 (&acc)[8][4], int wr, int wc, int fr, int fq) const {
#pragma unroll
        for (int nb = 0; nb < 4; ++nb) {
            const int col = wc * 64 + nb * 16 + 4 * fq;
            const f32x4 bv = bias ? *(const f32x4*)(bias + col) : (f32x4){0.f, 0.f, 0.f, 0.f};
            const f32x4 sv = scale ? *(const f32x4*)(scale + col) : (f32x4){1.f, 1.f, 1.f, 1.f};
#pragma unroll
            for (int mb = 0; mb < 8; ++mb) st4(out + (size_t)(wr * 128 + mb * 16 + fr) * ldc + col, (acc[mb][nb] + bv) * sv);
        }
    }
};
struct QkvP {
    const bf16* a0; const bf16* b0; int pm, pn; bf16 *Q, *Kb, *Vb; const float* rope;
    static constexpr int K = 1024;
    __device__ __forceinline__ const bf16* abase() const { return a0; }
    __device__ __forceinline__ const bf16* bbase() const { return b0; }
    __device__ __forceinline__ unsigned aoff(int r) const { return (unsigned)(r * 1024); }
    __device__ __forceinline__ unsigned boff(int r) const { return (unsigned)(r * 1024); }
    __device__ __forceinline__ void epi(f32x4 (&acc)[8][4], int wr, int wc, int fr, int fq) const {
        const int part = pn >> 2, cbase = (pn & 3) * 256 + wc * 64 + 4 * fq;
#pragma unroll
        for (int mb = 0; mb < 8; ++mb) {
            const int m = pm * 256 + wr * 128 + mb * 16 + fr; const bool latent = m < T;
            int kvrow, l = 0;
            if (latent) { const int b = m / SEQ; l = m % SEQ; kvrow = b * LK + l; } else { const int mm = m - T; kvrow = (mm / CTXL) * LK + SEQ + (mm % CTXL); }
            f32x4 v0 = acc[mb][0], v1 = acc[mb][1], v2 = acc[mb][2], v3 = acc[mb][3];
            if (part < 2 && latent) {
                const int rp = l >> 6, cp = l & 63;
                const f32x4 cr = *(const f32x4*)(rope + rp * 16 + 4 * fq), sr = *(const f32x4*)(rope + 2048 + rp * 16 + 4 * fq);
                const f32x4 cc = *(const f32x4*)(rope + 4096 + cp * 16 + 4 * fq), sc = *(const f32x4*)(rope + 5120 + cp * 16 + 4 * fq);
                const f32x4 a = v0, b = v1, c = v2, d = v3;
                v0 = a * cr - b * sr; v1 = b * cr + a * sr; v2 = c * cc - d * sc; v3 = d * cc + c * sc;
            }
            bf16* dst = (part == 0 ? Q + (size_t)m * 1024 : (part == 1 ? Kb : Vb) + (size_t)kvrow * 1024) + cbase;
            if (part > 0 || latent) { st4(dst, v0); st4(dst + 16, v1); st4(dst + 32, v2); st4(dst + 48, v3); }
        }
    }
};
struct GuP {
    const bf16* HA; const int* list; int cnt, rt; const bf16* b0; bf16* out;
    static constexpr int K = 1024;
    __device__ __forceinline__ const bf16* abase() const { return HA; }
    __device__ __forceinline__ const bf16* bbase() const { return b0; }
    __device__ __forceinline__ unsigned aoff(int r) const { const int idx = rt * 256 + r; const int tok = idx < cnt ? (list[idx] >> 1) : 0; return (unsigned)(tok * 1024); }
    __device__ __forceinline__ unsigned boff(int r) const { return (unsigned)(r * 1024); }
    __device__ __forceinline__ void epi(f32x4 (&acc)[8][4], int wr, int wc, int fr, int fq) const {
#pragma unroll
        for (int mb = 0; mb < 8; ++mb)
#pragma unroll
            for (int nb = 0; nb < 2; ++nb) {
                const f32x4 g = acc[mb][nb], u = acc[mb][nb + 2];
                const f32x4 h = {fsilu(g.x) * u.x, fsilu(g.y) * u.y, fsilu(g.z) * u.z, fsilu(g.w) * u.w};
                st4(out + (size_t)(wr * 128 + mb * 16 + fr) * 1024 + wc * 32 + nb * 16 + 4 * fq, h);
            }
    }
};
struct DnP {
    const bf16* a0; const bf16* b0; const int* list; const float* tokw; int cnt, rt; bf16* Y2; int col0;
    static constexpr int K = 1024;
    __device__ __forceinline__ const bf16* abase() const { return a0; }
    __device__ __forceinline__ const bf16* bbase() const { return b0; }
    __device__ __forceinline__ unsigned aoff(int r) const { return (unsigned)(r * 1024); }
    __device__ __forceinline__ unsigned boff(int r) const { return (unsigned)(r * 1024); }
    __device__ __forceinline__ void epi(f32x4 (&acc)[8][4], int wr, int wc, int fr, int fq) const {
#pragma unroll
        for (int mb = 0; mb < 8; ++mb) {
            const int idx = rt * 256 + wr * 128 + mb * 16 + fr;
            if (idx < cnt) { const int slot = list[idx]; const float w = tokw[slot];
#pragma unroll
                for (int nb = 0; nb < 4; ++nb) st4(Y2 + (size_t)slot * 1024 + col0 + wc * 64 + nb * 16 + 4 * fq, acc[mb][nb] * w); }
        }
    }
};
struct FwP {
    const bf16* A; const bf16* B; bf16* FW; int kbase, colk, ct;
    static constexpr int K = 256;
    __device__ __forceinline__ const bf16* abase() const { return A; }
    __device__ __forceinline__ const bf16* bbase() const { return B; }
    __device__ __forceinline__ unsigned aoff(int r) const { return (unsigned)(r * 256); }
    __device__ __forceinline__ unsigned boff(int k) const { return (unsigned)(k * 1024); }
    __device__ __forceinline__ void epi(f32x4 (&acc)[4][4], int wr, int wc, int fr, int fq) const {
#pragma unroll
        for (int mb = 0; mb < 4; ++mb) { const int kidx = kbase + wr * 64 + mb * 16 + fr;
#pragma unroll
            for (int nb = 0; nb < 4; ++nb) { const int n = ct * 256 + wc * 64 + nb * 16 + 4 * fq; bf16* o = FW + (size_t)n * 2048 + colk + kidx; const f32x4 v = acc[mb][nb];
                o[0] = (bf16)(pk2(v.x, 0.f) & 0xffff); o[2048] = (bf16)(pk2(v.y, 0.f) & 0xffff); o[4096] = (bf16)(pk2(v.z, 0.f) & 0xffff); o[6144] = (bf16)(pk2(v.w, 0.f) & 0xffff); } }
    }
};
struct KfP {
    const bf16* A2b; const bf16* F3T; bf16* KF; int rt, ct;
    static constexpr int K = 64;
    __device__ __forceinline__ const bf16* abase() const { return A2b; }
    __device__ __forceinline__ const bf16* bbase() const { return F3T; }
    __device__ __forceinline__ unsigned aoff(int r) const { const int n = rt * 256 + r; const int t = n < SEQ ? n : (n == SEQ ? 0 : 2 * SEQ - n); return (unsigned)(t * 64); }
    __device__ __forceinline__ unsigned boff(int r) const { return (unsigned)(((rt >= 32 ? 1024 : 0) + ct * 256 + r) * 64); }
    __device__ __forceinline__ void epi(f32x4 (&acc)[8][4], int wr, int wc, int fr, int fq) const {
        const float dlo = -3.0701134573253943f, dhi = -15.350567286626972f;
#pragma unroll
        for (int nb = 0; nb < 4; ++nb) {
            const int d = ct * 256 + wc * 64 + nb * 16 + 4 * fq;
            f32x4 dl; dl.x = -(dlo + (dhi - dlo) * (float)(d + 0) * (1.f / 1023.f)); dl.y = -(dlo + (dhi - dlo) * (float)(d + 1) * (1.f / 1023.f));
            dl.z = -(dlo + (dhi - dlo) * (float)(d + 2) * (1.f / 1023.f)); dl.w = -(dlo + (dhi - dlo) * (float)(d + 3) * (1.f / 1023.f));
#pragma unroll
            for (int mb = 0; mb < 8; ++mb) {
                const int n = rt * 256 + wr * 128 + mb * 16 + fr; const int t = n < SEQ ? n : 2 * SEQ - n; const float tt = -(float)t * (1.f / 8192.f);
                f32x4 v = acc[mb][nb]; v.x *= __expf(tt * dl.x); v.y *= __expf(tt * dl.y); v.z *= __expf(tt * dl.z); v.w *= __expf(tt * dl.w);
                if (n == SEQ) v = (f32x4){0.f, 0.f, 0.f, 0.f};
                st4(KF + (size_t)n * 1024 + d, v);
            }
        }
    }
};
enum { E_TW = 0, E_TWC = 1, E_PLANES = 2, E_KHAT = 3, E_MULK = 4, E_HY = 5 };
template <int MT, int EK>
struct DftP {
    const bf16* A; int K; const bf16* bs0; unsigned seg1; int ksplit; unsigned kstride;
    bf16* out0; bf16* out1; size_t rstride;
    const f32x2* tw; int twi; int fbase;
    float* kh;
    const bf16* vp; const bf16* x0; const float* skip;
    __device__ __forceinline__ const bf16* abase() const { return A; }
    __device__ __forceinline__ const bf16* bbase() const { return bs0; }
    __device__ __forceinline__ unsigned aoff(int r) const { return (unsigned)(r * K); }
    __device__ __forceinline__ unsigned boff(int k) const { return k < ksplit ? (unsigned)k * kstride : seg1 + (unsigned)(k - ksplit) * kstride; }
    __device__ __forceinline__ void epi(f32x4 (&acc)[MT / 32][4], int wr, int wc, int fr, int fq) const {
#pragma unroll
        for (int mp = 0; mp < MT / 64; ++mp) {
            const int f = fbase + ((wr * (MT / 2) + mp * 32) >> 5) * 16 + fr;
#pragma unroll
            for (int nb = 0; nb < 4; ++nb) {
                const int col = wc * 64 + nb * 16 + 4 * fq;
                f32x4 re = acc[2 * mp][nb], im = acc[2 * mp + 1][nb];
                if constexpr (EK == E_TW || EK == E_TWC) {
                    const f32x2 t = tw[f * 128 + twi]; const float c = t.x, s = (EK == E_TW) ? t.y : -t.y;
                    const f32x4 r2 = re * c + im * s, i2 = im * c - re * s; re = r2; im = i2;
                }
                if constexpr (EK == E_MULK) {
                    const f32x4 k0 = *(const f32x4*)(kh + ((size_t)f * 1024 + col) * 2), k1 = *(const f32x4*)(kh + ((size_t)f * 1024 + col) * 2 + 4);
                    const f32x4 kr = {k0.x, k0.z, k1.x, k1.z}, ki = {k0.y, k0.w, k1.y, k1.w};
                    const f32x4 r2 = re * kr - im * ki, i2 = re * ki + im * kr; re = r2; im = i2;
                }
                if constexpr (EK == E_KHAT) {
                    const float sc = 1.0f / 16384.0f;
                    *(f32x4*)(kh + ((size_t)f * 1024 + col) * 2) = (f32x4){re.x * sc, im.x * sc, re.y * sc, im.y * sc};
                    *(f32x4*)(kh + ((size_t)f * 1024 + col) * 2 + 4) = (f32x4){re.z * sc, im.z * sc, re.w * sc, im.w * sc};
                } else if constexpr (EK == E_HY) {
                    const size_t ro = (size_t)(128 * f + twi) * 1024 + col, ro1 = ro + (size_t)SEQ * 1024;
                    const f32x4 sk = *(const f32x4*)(skip + col);
                    const u32x2 va = *(const u32x2*)(vp + ro), vb = *(const u32x2*)(vp + ro1), xa = *(const u32x2*)(x0 + ro), xb = *(const u32x2*)(x0 + ro1);
                    const f32x4 v0 = {bflo(va.x), bfhi(va.x), bflo(va.y), bfhi(va.y)}, v1 = {bflo(vb.x), bfhi(vb.x), bflo(vb.y), bfhi(vb.y)};
                    const f32x4 g0 = {bflo(xa.x), bfhi(xa.x), bflo(xa.y), bfhi(xa.y)}, g1 = {bflo(xb.x), bfhi(xb.x), bflo(xb.y), bfhi(xb.y)};
                    st4(out0 + ro, (re + v0 * sk) * g0); st4(out0 + ro1, (im + v1 * sk) * g1);
                } else {
                    st4(out0 + (size_t)f * rstride + col, re); st4(out1 + (size_t)f * rstride + col, im);
                }
            }
        }
    }
};
namespace tgx {
using tg::TUnit;
struct DenseSched {
    const char* A; const char* B; int nN, nU, G, vcu; size_t astep, bstep;
    __device__ __forceinline__ bool next(int i, TUnit& u) const {
        const int L = i * G + vcu; if (L >= nU) return false;
        const int pm = L / nN, pn = L - pm * nN; u.a = A + (size_t)pm * astep; u.b = B + (size_t)pn * bstep; u.i0 = pm; u.i1 = pn; u.i2 = 0; u.i3 = 0; return true; }
};
struct EpiPlain {
    bf16* out; int ldc; const float* bias; const float* scale;
    __device__ __forceinline__ void operator()(const f32x4 (&acc)[2][2][4][2], const TUnit& u, int wr, int wc, int fr, int fq) const {
        const int col0 = u.i1 * 256 + wc * 32 + 4 * fq;
        f32x4 bv[2][2];
#pragma unroll
        for (int bj = 0; bj < 2; ++bj)
#pragma unroll
            for (int n = 0; n < 2; ++n) bv[bj][n] = bias ? *(const f32x4*)(bias + col0 + bj * 128 + n * 16) : (f32x4){0.f, 0.f, 0.f, 0.f};
        if (scale) {
#pragma unroll
            for (int ai = 0; ai < 2; ++ai)
#pragma unroll
                for (int m = 0; m < 4; ++m) { bf16* rowp = out + (size_t)(u.i0 * 256 + ai * 128 + wr * 64 + m * 16 + fr) * ldc + col0;
#pragma unroll
                    for (int bj = 0; bj < 2; ++bj)
#pragma unroll
                        for (int n = 0; n < 2; ++n) st4(rowp + bj * 128 + n * 16, acc[ai][bj][m][n] * *(const f32x4*)(scale + col0 + bj * 128 + n * 16)); }
            return;
        }
#pragma unroll
        for (int ai = 0; ai < 2; ++ai)
#pragma unroll
            for (int m = 0; m < 4; ++m) { bf16* rowp = out + (size_t)(u.i0 * 256 + ai * 128 + wr * 64 + m * 16 + fr) * ldc + col0;
#pragma unroll
                for (int bj = 0; bj < 2; ++bj)
#pragma unroll
                    for (int n = 0; n < 2; ++n) st4(rowp + bj * 128 + n * 16, acc[ai][bj][m][n] + bv[bj][n]); }
    }
};
struct PoolSched {
    const char* A; const char* B; int G, vcu;
    __device__ __forceinline__ bool next(int i, TUnit& u) const {
        const int L = i * G + vcu; if (L >= 512) return false;
        const int pm = L >> 2, g = L & 3; u.a = A + (size_t)pm * (256 * 1024 * 2) + g * 512; u.b = B + (size_t)g * (65536 * 2); u.i0 = pm; u.i1 = g; u.i2 = 0; u.i3 = 0; return true; }
};
struct QkvSched {
    const char* A; const char* B; int G, vcu;
    __device__ __forceinline__ bool next(int i, TUnit& u) const {
        const int L = i * G + vcu; if (L >= 1536 + 32) return false;
        int pm, pn; if (L < 1536) { pm = L / 12; pn = L - pm * 12; } else { const int L2 = L - 1536; pm = 128 + (L2 >> 3); pn = 4 + (L2 & 7); }
        u.a = A + (size_t)pm * (256 * 1024 * 2); u.b = B + (size_t)pn * (256 * 1024 * 2); u.i0 = pm; u.i1 = pn; u.i2 = 0; u.i3 = 0; return true; }
};
struct EpiQkv {
    bf16 *Q, *Kb, *Vb; const float* rope;
    __device__ __forceinline__ void operator()(const f32x4 (&acc)[2][2][4][2], const TUnit& u, int wr, int wc, int fr, int fq) const {
        const int pm = u.i0, pn = u.i1, part = pn >> 2, cb = (pn & 3) * 256 + wc * 32 + 4 * fq;
        const int ang = (wc & 1) ? 4096 : 0;
#pragma unroll
        for (int ai = 0; ai < 2; ++ai)
#pragma unroll
            for (int m = 0; m < 4; ++m) {
                const int mg = pm * 256 + ai * 128 + wr * 64 + m * 16 + fr; const bool latent = mg < T;
                int kvrow, l = 0;
                if (latent) { const int b = mg / SEQ; l = mg % SEQ; kvrow = b * LK + l; } else { const int mm = mg - T; kvrow = (mm / CTXL) * LK + SEQ + (mm % CTXL); }
                f32x4 cs = {1.f, 1.f, 1.f, 1.f}, sn = {0.f, 0.f, 0.f, 0.f};
                if (part < 2 && latent) { const int p = (wc & 1) ? (l & 63) : (l >> 6); cs = *(const f32x4*)(rope + ang + p * 16 + 4 * fq); sn = *(const f32x4*)(rope + ang + ((wc & 1) ? 1024 : 2048) + p * 16 + 4 * fq); }
                bf16* dst = (part == 0 ? Q + (size_t)mg * 1024 : (part == 1 ? Kb : Vb) + (size_t)kvrow * 1024) + cb;
#pragma unroll
                for (int bj = 0; bj < 2; ++bj) { const f32x4 a = acc[ai][bj][m][0], b = acc[ai][bj][m][1];
                    if (part > 0 || latent) { st4(dst + bj * 128, a * cs - b * sn); st4(dst + bj * 128 + 16, b * cs + a * sn); } }
            }
    }
};
struct GuSched {
    const char* HA; const char* W; const int* LIST; const LAS int* mt; int G, vcu, ntl;
    __device__ __forceinline__ bool next(int i, TUnit& u) const {
        const int L = i * G + vcu; if (L >= ntl * 8) return false;
        const int ti = L >> 3, pn = L & 7; int e = 0;
        for (int k = 1; k < 16; ++k) if (mt[16 + k] <= ti) e = k;
        u.a = HA; u.b = W + ((size_t)e * 2048 + pn * 256) * 2048; u.i0 = ti; u.i1 = pn; u.i2 = e; u.i3 = ti - mt[16 + e]; return true; }
    __device__ __forceinline__ int arow(const TUnit& u, int r) const { const int idx = u.i3 * 256 + r; return idx < mt[u.i2] ? (LIST[(size_t)u.i2 * T + idx] >> 1) : 0; }
};
struct EpiGu {
    bf16* HS;
    __device__ __forceinline__ void operator()(const f32x4 (&acc)[2][2][4][2], const TUnit& u, int wr, int wc, int fr, int fq) const {
        bf16* base = HS + (size_t)u.i0 * 256 * 1024 + u.i1 * 128 + wc * 32 + 4 * fq;
#pragma unroll
        for (int ai = 0; ai < 2; ++ai)
#pragma unroll
            for (int m = 0; m < 4; ++m)
#pragma unroll
                for (int n = 0; n < 2; ++n) { const f32x4 g = acc[ai][0][m][n], up = acc[ai][1][m][n];
                    const f32x4 h = {fsilu(g.x) * up.x, fsilu(g.y) * up.y, fsilu(g.z) * up.z, fsilu(g.w) * up.w};
                    st4(base + (size_t)(ai * 128 + wr * 64 + m * 16 + fr) * 1024 + n * 16, h); }
    }
};
struct DnSched {
    const char* HS; const char* W; const LAS int* mt; int G, vcu, ntl;
    __device__ __forceinline__ bool next(int i, TUnit& u) const {
        const int L = i * G + vcu; if (L >= ntl * 4) return false;
        const int ti = L >> 2, pn = L & 3; int e = 0;
        for (int k = 1; k < 16; ++k) if (mt[16 + k] <= ti) e = k;
        u.a = HS + (size_t)ti * (256 * 1024 * 2); u.b = W + ((size_t)e * 1024 + pn * 256) * 2048; u.i0 = ti; u.i1 = pn; u.i2 = e; u.i3 = ti - mt[16 + e]; return true; }
};
struct EpiDn {
    bf16* Y2; const int* LIST; const float* TOKW; const LAS int* mt;
    __device__ __forceinline__ void operator()(const f32x4 (&acc)[2][2][4][2], const TUnit& u, int wr, int wc, int fr, int fq) const {
        const int cnt = mt[u.i2], col0 = u.i1 * 256 + wc * 32 + 4 * fq;
#pragma unroll
        for (int ai = 0; ai < 2; ++ai)
#pragma unroll
            for (int m = 0; m < 4; ++m) { const int idx = u.i3 * 256 + ai * 128 + wr * 64 + m * 16 + fr;
                if (idx < cnt) { const int slot = LIST[(size_t)u.i2 * T + idx]; const float w = TOKW[slot]; bf16* rowp = Y2 + (size_t)slot * 1024 + col0;
#pragma unroll
                    for (int bj = 0; bj < 2; ++bj)
#pragma unroll
                        for (int n = 0; n < 2; ++n) st4(rowp + bj * 128 + n * 16, acc[ai][bj][m][n] * w); } }
    }
};
}
#ifndef MK_ONLY
#define MK_ONLY -1
#endif
#define EN(k) (MK_ONLY < 0 || MK_ONLY == (k))
#ifndef F1_UNITS
#define F1_UNITS (NB * 128 * 4)
#endif
#ifndef F1_K
#define F1_K 64
#define F1_AMAT DFT_F1
#endif
#ifndef F1_EK
#define F1_EK E_TW
#endif
#ifndef MK_REP
#define MK_REP -1
#endif
#ifndef SETTLE_TICKS
#define SETTLE_TICKS 0
#endif
enum { PH_P0 = 0, PH_MOD, PH_QKV, PH_ATT, PH_AWO, PH_M0, PH_POOLPRE = PH_M0 + 4, PH_POOLG, PH_M1, PH_F1 = PH_M1 + 4, PH_F2, PH_F3, PH_M2,
       PH_H1 = PH_M2 + 4, PH_H2, PH_H3, PH_H4, PH_H5, PH_H6, PH_H7, PH_M3, NPH = PH_M3 + 4 };

__device__ __forceinline__ void dense_gemm(const Frame& F, const bf16* A, int lda, int Mrows, const bf16* Bt, int ldb, int N, int K, bf16* out, int ldc, const float* bias) {
    tgx::DenseSched S{(const char*)A, (const char*)Bt, N / 256, (Mrows / 256) * (N / 256), F.G, F.vcu, (size_t)256 * lda * 2, (size_t)256 * ldb * 2};
    tgx::EpiPlain E{out, ldc, bias, nullptr};
    tg::tgemm_phase<false>(F.lds, F.tid, lda, ldb, K, S, E);
}
__device__ __forceinline__ Frame make_frame(LAS unsigned char* lds, unsigned char* ws, int wave_s) {
    Frame F; F.lds = lds; F.ws = ws;
    int t = wave_s * 64 + lane_id(); asm volatile("" : "+v"(t));
    int bx = blockIdx.x; asm volatile("" : "+s"(bx));
    F.tid = t; F.lane = t & 63; F.wave = __builtin_amdgcn_readfirstlane(t >> 6);
    F.G = gridDim.x; F.vcu = (F.G % 8 == 0) ? (bx % 8) * (F.G / 8) + bx / 8 : bx;
    F.gw = F.vcu * NWAVES + F.wave; F.NGW = F.G * NWAVES;
    return F;
}
__global__ void __launch_bounds__(NTHR, 2) mk_fwd(Args args) {
    extern __shared__ __attribute__((aligned(16))) unsigned char lds_raw[];
    LAS unsigned char* const lds0 = (LAS unsigned char*)lds_raw;
    volatile LAS unsigned* MISC = (volatile LAS unsigned*)(lds0 + LDS_MISC);
    const int wave_s = __builtin_amdgcn_readfirstlane((int)threadIdx.x >> 6);
    if (wave_s == 0) MISC[lane_id()] = 0u;
    __syncthreads();
    typedef const Args __attribute__((address_space(4))) CArgs;
#define MKF() CArgs* ka = (CArgs*)__builtin_amdgcn_kernarg_segment_ptr(); asm volatile("" : "+s"(ka)); unsigned char* const ws = ka->ws; Frame F_ = make_frame(lds0, ws, wave_s); F_.flip = ka->flip; const Frame F = F_; (void)ws
    const int lo = args.ph_lo, hi = args.ph_hi;
    const bool multi = (hi - lo) > 1;
    unsigned* ctl = (unsigned*)(args.ws + WS_CTL);
    XcdBarrier bar; bar.bar = ctl + CW_BAR; bar.x = 0; bar.st = MISC;
    if (multi) bar = xcd_barrier_post(ctl + CW_BAR, MISC, wave_s);
#define IN(k) (lo <= (k) && (k) < hi)
#define SEAM_FORCE() do { XcdBarrier b_ = bar; unsigned* bp_ = b_.bar; asm volatile("" : "+s"(bp_)); b_.bar = bp_; xcd_barrier(b_, wave_s); } while (0)
#define SEAM(k) do { if (IN(k) && IN((k) + 1)) { XcdBarrier b_ = bar; unsigned* bp_ = b_.bar; asm volatile("" : "+s"(bp_)); b_.bar = bp_; xcd_barrier(b_, wave_s); } } while (0)

    for (int rep_ = 0; rep_ < (MK_REP == (PH_P0) ? 2 : 1); ++rep_) if (EN(PH_P0) && IN(PH_P0)) { if (rep_) { SEAM_FORCE(); } MKF();
        mod_gemv(F, ka->in[I_C], ka->in[I_CCTX], ka->in[I_MODW], ka->in[I_MODB]);
        __syncthreads();
        transpose_matrix(F, ka->in[I_WQKV], 1024, 3072, (bf16*)(ws + WS_WQKV));
        transpose_matrix(F, ka->in[I_WO], 1024, 1024, (bf16*)(ws + WS_WO));
        transpose_matrix(F, ka->in[I_HWIN], 1024, 3072, (bf16*)(ws + WS_HWIN));
        transpose_matrix(F, ka->in[I_HWO], 1024, 1024, (bf16*)(ws + WS_HWO));
        transpose_matrix(F, ka->in[I_HF3], 64, 2048, (bf16*)(ws + WS_F3T));
        for (int g = 0; g < 4; ++g) transpose_matrix(F, ka->in[I_POOLW] + g * 65536, 256, 256, (bf16*)(ws + WS_POOLW) + g * 65536);
        convert_moe_layer(F, ka->in[I_WG], ka->in[I_WU], ka->in[I_WD], 0);
        __syncthreads();
        tables(F);
        fourier_w_copy(F, ka->in[I_FW]);
        hyena_a2(F, ka->in[I_HF1], ka->in[I_HFB1], ka->in[I_HF2], ka->in[I_HFB2], ka->in[I_HFREQ]);
        __syncthreads();
    }
    SEAM(PH_P0);
    for (int rep_ = 0; rep_ < (MK_REP == (PH_MOD) ? 2 : 1); ++rep_) if (EN(PH_MOD) && IN(PH_MOD)) { if (rep_) { SEAM_FORCE(); } MKF(); modulate0(F, ka->in[I_X], ka->in[I_CTX]);
        for (int un = F.vcu; un < 64; un += F.G) {
            const int ct = un & 3, rh = (un >> 2) & 1, tg_ = (un >> 3) & 1, g = un >> 4;
            FwP p{(const bf16*)(ws + WS_TRIG) + (size_t)(tg_ * 256 + rh * 128) * 256, (const bf16*)(ws + WS_WFB) + (size_t)(g * 256) * 1024 + ct * 256, (bf16*)(ws + WS_FW), rh * 128, tg_ * 1024 + g * 256, ct};
            sgemm_unit<128, 1>(F.lds, F.tid, p);
        }
    }
    SEAM(PH_MOD);

    for (int rep_ = 0; rep_ < (MK_REP == (PH_QKV) ? 2 : 1); ++rep_) if (EN(PH_QKV) && IN(PH_QKV)) { if (rep_) { SEAM_FORCE(); } MKF();
        tgx::QkvSched S{(const char*)(ws + WS_HA), (const char*)(ws + WS_WQKV), F.G, F.vcu};
        tgx::EpiQkv E{(bf16*)(ws + WS_Q), (bf16*)(ws + WS_K), (bf16*)(ws + WS_V), (const float*)(ws + WS_ROPE)};
        tg::tgemm_phase<false>(F.lds, F.tid, 1024, 1024, 1024, S, E);
    }
    SEAM(PH_QKV);
    for (int rep_ = 0; rep_ < (MK_REP == (PH_ATT) ? 2 : 1); ++rep_) if (EN(PH_ATT) && IN(PH_ATT)) { if (rep_) { SEAM_FORCE(); } MKF();
        const float* lamp = ka->in[I_LAM]; float d01 = 0.f, d23 = 0.f;
        for (int i = 0; i < 64; ++i) { d01 += lamp[i] * lamp[64 + i]; d23 += lamp[128 + i] * lamp[192 + i]; }
        const float lam_init = 0.2f, lam = __expf(d01) - __expf(d23) + lam_init;
        const bf16* Q = (const bf16*)(ws + WS_Q); const bf16* Kb = (const bf16*)(ws + WS_K); const bf16* Vb = (const bf16*)(ws + WS_V); bf16* AO = (bf16*)(ws + WS_AO);
        for (int u = F.vcu; u < NB * 8 * 32; u += F.G) {
            const int qb = u & 31, h = (u >> 5) & 7, b = u >> 8;
            const bf16* q0 = Q + (size_t)(b * SEQ + qb * 256) * 1024 + h * 128; const bf16* k0 = Kb + (size_t)b * LK * 1024 + h * 128; const bf16* v0 = Vb + (size_t)b * LK * 1024 + h * 128;
            bf16* o0 = AO + (size_t)(b * SEQ + qb * 256) * 1024 + h * 128;
            att::attn_pass<0>(q0, k0, v0, o0, lam, ka->in[I_SUBLN], 1.f - lam_init, F.lds, F.tid);
            att::attn_pass<1>(q0 + 64, k0 + 64, v0, o0, lam, ka->in[I_SUBLN], 1.f - lam_init, F.lds, F.tid);
        }
    }
    SEAM(PH_ATT);
    for (int rep_ = 0; rep_ < (MK_REP == (PH_AWO) ? 2 : 1); ++rep_) if (EN(PH_AWO) && IN(PH_AWO)) { if (rep_) { SEAM_FORCE(); } MKF(); dense_gemm(F, (const bf16*)(ws + WS_AO), 1024, T, (const bf16*)(ws + WS_WO), 1024, 1024, 1024, (bf16*)(ws + WS_Y), 1024, nullptr); }
    SEAM(PH_AWO);

    { constexpr int layer = 0;
        constexpr int pb = layer == 0 ? PH_M0 : layer == 1 ? PH_M1 : layer == 2 ? PH_M2 : PH_M3;
        for (int rep_ = 0; rep_ < (MK_REP == (100) ? 2 : 1); ++rep_) if (EN(100) && IN(pb)) { if (rep_) { SEAM_FORCE(); } MKF(); ln1_route(F, layer, ka->in[I_LNG], ka->in[I_LNB], ka->in[I_RW], ka->in[I_RB]); }
        SEAM(pb);
        LAS int* mt = (LAS int*)(lds0 + LDS_MISC + 256);
        if (IN(pb + 1) || IN(pb + 2)) { MKF();
            if (F.tid < 16) mt[F.tid] = (int)__hip_atomic_load(ctl + CW_CNT + (layer * 16 + F.tid) * 64, __ATOMIC_RELAXED, __HIP_MEMORY_SCOPE_AGENT);
            __syncthreads();
            if (F.tid == 0) { int s = 0; for (int e = 0; e < 16; ++e) { mt[16 + e] = s; s += (mt[e] + 255) >> 8; } mt[32] = s; }
            __syncthreads();
        }
        for (int rep_ = 0; rep_ < (MK_REP == (101) ? 2 : 1); ++rep_) if (EN(101) && IN(pb + 1)) { if (rep_) { SEAM_FORCE(); } MKF();
            tgx::GuSched S{(const char*)(ws + WS_HA), (const char*)(ws + WS_WGU), (const int*)(ws + WS_LIST), mt, F.G, F.vcu, mt[32]};
            tgx::EpiGu E{(bf16*)(ws + WS_HS)};
            tg::tgemm_phase<true>(F.lds, F.tid, 1024, 1024, 1024, S, E);
        }
        SEAM(pb + 1);
        for (int rep_ = 0; rep_ < (MK_REP == (102) ? 2 : 1); ++rep_) if (EN(102) && IN(pb + 2)) { if (rep_) { SEAM_FORCE(); } MKF();
            tgx::DnSched S{(const char*)(ws + WS_HS), (const char*)(ws + WS_WD), mt, F.G, F.vcu, mt[32]};
            tgx::EpiDn E{(bf16*)(ws + WS_Y2), (const int*)(ws + WS_LIST), (const float*)(ws + WS_TOKW), mt};
            tg::tgemm_phase<false>(F.lds, F.tid, 1024, 1024, 1024, S, E);
        }
        SEAM(pb + 2);
#ifdef MK_PRE_DELAY
        if (layer == NLAYER - 1 && IN(pb + 3)) { const unsigned long long t0_ = __builtin_amdgcn_s_memrealtime(); while (__builtin_amdgcn_s_memrealtime() - t0_ < (unsigned long long)MK_PRE_DELAY) __builtin_amdgcn_s_sleep(16); }
#endif
        for (int rep_ = 0; rep_ < ((MK_REP == 203 && layer == 3) ? 2 : 1); ++rep_) if (EN(103) && IN(pb + 3)) { if (rep_) { SEAM_FORCE(); } MKF();
            ln2_phase(F, layer, ka->in[I_LNG], ka->in[I_LNB], ka->out);
            if (layer + 1 < NLAYER) { for (int cr_ = 0; cr_ < (MK_REP == 303 ? 2 : 1); ++cr_) { __syncthreads(); convert_moe_layer(F, ka->in[I_WG], ka->in[I_WU], ka->in[I_WD], layer + 1); } }
        }
        if (layer + 1 < NLAYER) SEAM(pb + 3);
    }
    { constexpr int layer = 1;
        if (layer == 1) {
            for (int rep_ = 0; rep_ < (MK_REP == (PH_POOLPRE) ? 2 : 1); ++rep_) if (EN(PH_POOLPRE) && IN(PH_POOLPRE)) { if (rep_) { SEAM_FORCE(); } MKF(); pool_pre(F); }
            SEAM(PH_POOLPRE);
            for (int rep_ = 0; rep_ < (MK_REP == (PH_POOLG) ? 2 : 1); ++rep_) if (EN(PH_POOLG) && IN(PH_POOLG)) { if (rep_) { SEAM_FORCE(); } MKF();
                tgx::PoolSched S{(const char*)(ws + WS_POOLED), (const char*)(ws + WS_POOLW), F.G, F.vcu};
                tgx::EpiPlain E{(bf16*)(ws + WS_Y), 1024, nullptr, ka->in[I_POOLS]};
                tg::tgemm_phase<false>(F.lds, F.tid, 1024, 256, 256, S, E);
            }
            SEAM(PH_POOLG);
        }
    }
    { constexpr int layer = 1;
        constexpr int pb = layer == 0 ? PH_M0 : layer == 1 ? PH_M1 : layer == 2 ? PH_M2 : PH_M3;
        for (int rep_ = 0; rep_ < (MK_REP == (100) ? 2 : 1); ++rep_) if (EN(100) && IN(pb)) { if (rep_) { SEAM_FORCE(); } MKF(); ln1_route(F, layer, ka->in[I_LNG], ka->in[I_LNB], ka->in[I_RW], ka->in[I_RB]); }
        SEAM(pb);
        LAS int* mt = (LAS int*)(lds0 + LDS_MISC + 256);
        if (IN(pb + 1) || IN(pb + 2)) { MKF();
            if (F.tid < 16) mt[F.tid] = (int)__hip_atomic_load(ctl + CW_CNT + (layer * 16 + F.tid) * 64, __ATOMIC_RELAXED, __HIP_MEMORY_SCOPE_AGENT);
            __syncthreads();
            if (F.tid == 0) { int s = 0; for (int e = 0; e < 16; ++e) { mt[16 + e] = s; s += (mt[e] + 255) >> 8; } mt[32] = s; }
            __syncthreads();
        }
        for (int rep_ = 0; rep_ < (MK_REP == (101) ? 2 : 1); ++rep_) if (EN(101) && IN(pb + 1)) { if (rep_) { SEAM_FORCE(); } MKF();
            tgx::GuSched S{(const char*)(ws + WS_HA), (const char*)(ws + WS_WGU), (const int*)(ws + WS_LIST), mt, F.G, F.vcu, mt[32]};
            tgx::EpiGu E{(bf16*)(ws + WS_HS)};
            tg::tgemm_phase<true>(F.lds, F.tid, 1024, 1024, 1024, S, E);
        }
        SEAM(pb + 1);
        for (int rep_ = 0; rep_ < (MK_REP == (102) ? 2 : 1); ++rep_) if (EN(102) && IN(pb + 2)) { if (rep_) { SEAM_FORCE(); } MKF();
            tgx::DnSched S{(const char*)(ws + WS_HS), (const char*)(ws + WS_WD), mt, F.G, F.vcu, mt[32]};
            tgx::EpiDn E{(bf16*)(ws + WS_Y2), (const int*)(ws + WS_LIST), (const float*)(ws + WS_TOKW), mt};
            tg::tgemm_phase<false>(F.lds, F.tid, 1024, 1024, 1024, S, E);
        }
        SEAM(pb + 2);
#ifdef MK_PRE_DELAY
        if (layer == NLAYER - 1 && IN(pb + 3)) { const unsigned long long t0_ = __builtin_amdgcn_s_memrealtime(); while (__builtin_amdgcn_s_memrealtime() - t0_ < (unsigned long long)MK_PRE_DELAY) __builtin_amdgcn_s_sleep(16); }
#endif
        for (int rep_ = 0; rep_ < ((MK_REP == 203 && layer == 3) ? 2 : 1); ++rep_) if (EN(103) && IN(pb + 3)) { if (rep_) { SEAM_FORCE(); } MKF();
            ln2_phase(F, layer, ka->in[I_LNG], ka->in[I_LNB], ka->out);
            if (layer + 1 < NLAYER) { for (int cr_ = 0; cr_ < (MK_REP == 303 ? 2 : 1); ++cr_) { __syncthreads(); convert_moe_layer(F, ka->in[I_WG], ka->in[I_WU], ka->in[I_WD], layer + 1); } }
        }
        if (layer + 1 < NLAYER) SEAM(pb + 3);
    }
    { constexpr int layer = 2;
        if (layer == 2) {
            for (int rep_ = 0; rep_ < (MK_REP == (PH_F1) ? 2 : 1); ++rep_) if (EN(PH_F1) && IN(PH_F1)) { if (rep_) { SEAM_FORCE(); } MKF();
                for (int u = F.vcu; u < F1_UNITS; u += F.G) {
                    const int nt = u & 3, l2 = (u >> 2) & 127, b = u >> 9, col0 = nt * 256;
                    DftP<128, F1_EK> p{};
                    p.A = (const bf16*)(ws + F1_AMAT); p.K = F1_K; p.bs0 = (const bf16*)(ws + WS_HA) + ((size_t)b * SEQ + l2) * 1024 + col0; p.seg1 = 0; p.ksplit = F1_K; p.kstride = 128 * 1024;
                    p.out0 = (bf16*)(ws + WS_FT) + ((size_t)(b * 64) * 128 + l2) * 1024 + col0; p.out1 = p.out0 + PLANE64 / 2; p.rstride = 128 * 1024;
                    p.tw = (const f32x2*)(ws + WS_TWF); p.twi = l2;
                    sgemm_unit<128, 1>(F.lds, F.tid, p);
                }
            }
            SEAM(PH_F1);
            for (int rep_ = 0; rep_ < (MK_REP == (PH_F2) ? 2 : 1); ++rep_) if (EN(PH_F2) && IN(PH_F2)) { if (rep_) { SEAM_FORCE(); } MKF();
                for (int u = F.vcu; u < (NB * 64 * 4); u += F.G) {
                    const int nt = u & 3, k1 = (u >> 2) & 63, b = u >> 8, col0 = nt * 256;
                    DftP<256, E_PLANES> p{};
                    p.A = (const bf16*)(ws + DFT_C256); p.K = 256; p.fbase = 0; p.bs0 = (const bf16*)(ws + WS_FT) + ((size_t)(b * 64 + k1) * 128) * 1024 + col0; p.seg1 = (unsigned)(PLANE64 / 2); p.ksplit = 128; p.kstride = 1024;
                    p.out0 = (bf16*)(ws + WS_PQ) + ((size_t)b * SEQ + k1) * 2048 + col0; p.out1 = p.out0 + 1024; p.rstride = 64 * 2048;
                    sgemm_unit<256, 1>(F.lds, F.tid, p);
                }
            }
            SEAM(PH_F2);
            for (int rep_ = 0; rep_ < (MK_REP == (PH_F3) ? 2 : 1); ++rep_) if (EN(PH_F3) && IN(PH_F3)) { if (rep_) { SEAM_FORCE(); } MKF(); dense_gemm(F, (const bf16*)(ws + WS_PQ), 2048, T, (const bf16*)(ws + WS_FW), 2048, 1024, 2048, (bf16*)(ws + WS_Y), 1024, ka->in[I_FB]); }
            SEAM(PH_F3);
        }
    }
    { constexpr int layer = 2;
        constexpr int pb = layer == 0 ? PH_M0 : layer == 1 ? PH_M1 : layer == 2 ? PH_M2 : PH_M3;
        for (int rep_ = 0; rep_ < (MK_REP == (100) ? 2 : 1); ++rep_) if (EN(100) && IN(pb)) { if (rep_) { SEAM_FORCE(); } MKF(); ln1_route(F, layer, ka->in[I_LNG], ka->in[I_LNB], ka->in[I_RW], ka->in[I_RB]); }
        SEAM(pb);
        LAS int* mt = (LAS int*)(lds0 + LDS_MISC + 256);
        if (IN(pb + 1) || IN(pb + 2)) { MKF();
            if (F.tid < 16) mt[F.tid] = (int)__hip_atomic_load(ctl + CW_CNT + (layer * 16 + F.tid) * 64, __ATOMIC_RELAXED, __HIP_MEMORY_SCOPE_AGENT);
            __syncthreads();
            if (F.tid == 0) { int s = 0; for (int e = 0; e < 16; ++e) { mt[16 + e] = s; s += (mt[e] + 255) >> 8; } mt[32] = s; }
            __syncthreads();
        }
        for (int rep_ = 0; rep_ < (MK_REP == (101) ? 2 : 1); ++rep_) if (EN(101) && IN(pb + 1)) { if (rep_) { SEAM_FORCE(); } MKF();
            tgx::GuSched S{(const char*)(ws + WS_HA), (const char*)(ws + WS_WGU), (const int*)(ws + WS_LIST), mt, F.G, F.vcu, mt[32]};
            tgx::EpiGu E{(bf16*)(ws + WS_HS)};
            tg::tgemm_phase<true>(F.lds, F.tid, 1024, 1024, 1024, S, E);
        }
        SEAM(pb + 1);
        for (int rep_ = 0; rep_ < (MK_REP == (102) ? 2 : 1); ++rep_) if (EN(102) && IN(pb + 2)) { if (rep_) { SEAM_FORCE(); } MKF();
            tgx::DnSched S{(const char*)(ws + WS_HS), (const char*)(ws + WS_WD), mt, F.G, F.vcu, mt[32]};
            tgx::EpiDn E{(bf16*)(ws + WS_Y2), (const int*)(ws + WS_LIST), (const float*)(ws + WS_TOKW), mt};
            tg::tgemm_phase<false>(F.lds, F.tid, 1024, 1024, 1024, S, E);
        }
        SEAM(pb + 2);
#ifdef MK_PRE_DELAY
        if (layer == NLAYER - 1 && IN(pb + 3)) { const unsigned long long t0_ = __builtin_amdgcn_s_memrealtime(); while (__builtin_amdgcn_s_memrealtime() - t0_ < (unsigned long long)MK_PRE_DELAY) __builtin_amdgcn_s_sleep(16); }
#endif
        for (int rep_ = 0; rep_ < ((MK_REP == 203 && layer == 3) ? 2 : 1); ++rep_) if (EN(103) && IN(pb + 3)) { if (rep_) { SEAM_FORCE(); } MKF();
            ln2_phase(F, layer, ka->in[I_LNG], ka->in[I_LNB], ka->out);
            if (layer + 1 < NLAYER) { for (int cr_ = 0; cr_ < (MK_REP == 303 ? 2 : 1); ++cr_) { __syncthreads(); convert_moe_layer(F, ka->in[I_WG], ka->in[I_WU], ka->in[I_WD], layer + 1); } }
        }
        if (layer + 1 < NLAYER) SEAM(pb + 3);
    }
    { constexpr int layer = 3;
        if (layer == 3) {
            for (int rep_ = 0; rep_ < (MK_REP == (PH_H1) ? 2 : 1); ++rep_) if (EN(PH_H1) && IN(PH_H1)) { if (rep_) { SEAM_FORCE(); } MKF();
                dense_gemm(F, (const bf16*)(ws + WS_HA), 1024, T, (const bf16*)(ws + WS_HWIN), 1024, 3072, 1024, (bf16*)(ws + WS_Z), 3072, ka->in[I_HBIN]);
                for (int un = F.vcu; un < 64 * 4; un += F.G) {
                    KfP p{(const bf16*)(ws + WS_A2B), (const bf16*)(ws + WS_F3T), (bf16*)(ws + WS_KFULL), un >> 2, un & 3};
                    sgemm_unit<256, 0>(F.lds, F.tid, p);
                }
            }
            SEAM(PH_H1);
            for (int rep_ = 0; rep_ < (MK_REP == (PH_H2) ? 2 : 1); ++rep_) if (EN(PH_H2) && IN(PH_H2)) { if (rep_) { SEAM_FORCE(); } MKF();
                hyena_conv(F, ka->in[I_HCW], ka->in[I_HCB]);
                for (int u = F.vcu; u < (128 * 4); u += F.G) {
                    const int nt = u & 3, n2 = u >> 2, col0 = nt * 256;
                    DftP<256, E_TW> p{};
                    p.A = (const bf16*)(ws + DFT_K1); p.K = 128; p.fbase = 0; p.bs0 = (const bf16*)(ws + WS_KFULL) + (size_t)n2 * 1024 + col0; p.seg1 = 0; p.ksplit = 128; p.kstride = 128 * 1024;
                    p.out0 = (bf16*)(ws + WS_KT) + (size_t)n2 * 1024 + col0; p.out1 = p.out0 + PLANE32 / 2; p.rstride = 128 * 1024;
                    p.tw = (const f32x2*)(ws + WS_TWH); p.twi = n2;
                    sgemm_unit<256, 1>(F.lds, F.tid, p);
                }
            }
            SEAM(PH_H2);
            for (int rep_ = 0; rep_ < (MK_REP == (PH_H3) ? 2 : 1); ++rep_) if (EN(PH_H3) && IN(PH_H3)) { if (rep_) { SEAM_FORCE(); } MKF();
                for (int u = F.vcu; u < (2 * 128 * 4); u += F.G) {
                    const int nt = u & 3, s2 = (u >> 2) & 127, pp = u >> 9, col0 = nt * 256;
                    DftP<256, E_TW> p{};
                    p.A = (const bf16*)(ws + DFT_H1); p.K = 128; p.fbase = 0; p.bs0 = (const bf16*)(ws + WS_VP) + ((size_t)(2 * pp) * SEQ + s2) * 1024 + col0; p.seg1 = (unsigned)(SEQ * 1024); p.ksplit = 64; p.kstride = 128 * 1024;
                    p.out0 = (bf16*)(ws + WS_HT) + ((size_t)(pp * 128) * 128 + s2) * 1024 + col0; p.out1 = p.out0 + PLANE64 / 2; p.rstride = 128 * 1024;
                    p.tw = (const f32x2*)(ws + WS_TWH); p.twi = s2;
                    sgemm_unit<256, 1>(F.lds, F.tid, p);
                }
                for (int u = F.vcu; u < (128 * 4); u += F.G) {
                    const int nt = u & 3, f1 = u >> 2, col0 = nt * 256;
                    DftP<256, E_KHAT> p{};
                    p.A = (const bf16*)(ws + DFT_C256); p.K = 256; p.fbase = 0; p.bs0 = (const bf16*)(ws + WS_KT) + (size_t)(f1 * 128) * 1024 + col0; p.seg1 = (unsigned)(PLANE32 / 2); p.ksplit = 128; p.kstride = 1024;
                    p.kh = (float*)(ws + WS_KH) + ((size_t)(f1 * 128) * 1024 + col0) * 2;
                    sgemm_unit<256, 1>(F.lds, F.tid, p);
                }
            }
            SEAM(PH_H3);
            for (int rep_ = 0; rep_ < (MK_REP == (PH_H4) ? 2 : 1); ++rep_) if (EN(PH_H4) && IN(PH_H4)) { if (rep_) { SEAM_FORCE(); } MKF();
                for (int u = F.vcu; u < (2 * 128 * 4); u += F.G) {
                    const int nt = u & 3, f1 = (u >> 2) & 127, pp = u >> 9, col0 = nt * 256;
                    DftP<256, E_MULK> p{};
                    p.A = (const bf16*)(ws + DFT_C256); p.K = 256; p.fbase = 0; p.bs0 = (const bf16*)(ws + WS_HT) + ((size_t)(pp * 128 + f1) * 128) * 1024 + col0; p.seg1 = (unsigned)(PLANE64 / 2); p.ksplit = 128; p.kstride = 1024;
                    p.out0 = (bf16*)(ws + WS_YH) + ((size_t)(pp * 128 + f1) * 128) * 1024 + col0; p.out1 = p.out0 + PLANE64 / 2; p.rstride = 1024;
                    p.kh = (float*)(ws + WS_KH) + ((size_t)(f1 * 128) * 1024 + col0) * 2;
                    sgemm_unit<256, 1>(F.lds, F.tid, p);
                }
            }
            SEAM(PH_H4);
            for (int rep_ = 0; rep_ < (MK_REP == (PH_H5) ? 2 : 1); ++rep_) if (EN(PH_H5) && IN(PH_H5)) { if (rep_) { SEAM_FORCE(); } MKF();
                for (int u = F.vcu; u < (2 * 128 * 4); u += F.G) {
                    const int nt = u & 3, f1 = (u >> 2) & 127, pp = u >> 9, col0 = nt * 256;
                    DftP<256, E_TWC> p{};
                    p.A = (const bf16*)(ws + DFT_H2B); p.K = 256; p.fbase = 0; p.bs0 = (const bf16*)(ws + WS_YH) + ((size_t)(pp * 128 + f1) * 128) * 1024 + col0; p.seg1 = (unsigned)(PLANE64 / 2); p.ksplit = 128; p.kstride = 1024;
                    p.out0 = (bf16*)(ws + WS_HG) + ((size_t)(pp * 128 + f1) * 128) * 1024 + col0; p.out1 = p.out0 + PLANE64 / 2; p.rstride = 1024;
                    p.tw = (const f32x2*)(ws + WS_TWH); p.twi = f1;
                    sgemm_unit<256, 1>(F.lds, F.tid, p);
                }
            }
            SEAM(PH_H5);
            for (int rep_ = 0; rep_ < (MK_REP == (PH_H6) ? 2 : 1); ++rep_) if (EN(PH_H6) && IN(PH_H6)) { if (rep_) { SEAM_FORCE(); } MKF();
                for (int u = F.vcu; u < 2 * 128 * 4; u += F.G) {
                    const int nt = u & 3, t2 = (u >> 2) & 127, pp = u >> 9, col0 = nt * 256;
                    DftP<128, E_HY> p{};
                    p.A = (const bf16*)(ws + DFT_H3); p.K = 256; p.bs0 = (const bf16*)(ws + WS_HG) + ((size_t)(pp * 128) * 128 + t2) * 1024 + col0; p.seg1 = (unsigned)(PLANE64 / 2); p.ksplit = 128; p.kstride = 128 * 1024;
                    p.out0 = (bf16*)(ws + WS_YX) + (size_t)(2 * pp) * SEQ * 1024 + col0; p.twi = t2;
                    p.vp = (const bf16*)(ws + WS_VP) + (size_t)(2 * pp) * SEQ * 1024 + col0; p.x0 = (const bf16*)(ws + WS_X0) + (size_t)(2 * pp) * SEQ * 1024 + col0; p.skip = ka->in[I_HSKIP] + col0;
                    sgemm_unit<128, 1>(F.lds, F.tid, p);
                }
            }
            SEAM(PH_H6);
            for (int rep_ = 0; rep_ < (MK_REP == (PH_H7) ? 2 : 1); ++rep_) if (EN(PH_H7) && IN(PH_H7)) { if (rep_) { SEAM_FORCE(); } MKF(); dense_gemm(F, (const bf16*)(ws + WS_YX), 1024, T, (const bf16*)(ws + WS_HWO), 1024, 1024, 1024, (bf16*)(ws + WS_Y), 1024, ka->in[I_HBO]); }
            SEAM(PH_H7);
        }
    }
    { constexpr int layer = 3;
        constexpr int pb = layer == 0 ? PH_M0 : layer == 1 ? PH_M1 : layer == 2 ? PH_M2 : PH_M3;
        for (int rep_ = 0; rep_ < (MK_REP == (100) ? 2 : 1); ++rep_) if (EN(100) && IN(pb)) { if (rep_) { SEAM_FORCE(); } MKF(); ln1_route(F, layer, ka->in[I_LNG], ka->in[I_LNB], ka->in[I_RW], ka->in[I_RB]); }
        SEAM(pb);
        LAS int* mt = (LAS int*)(lds0 + LDS_MISC + 256);
        if (IN(pb + 1) || IN(pb + 2)) { MKF();
            if (F.tid < 16) mt[F.tid] = (int)__hip_atomic_load(ctl + CW_CNT + (layer * 16 + F.tid) * 64, __ATOMIC_RELAXED, __HIP_MEMORY_SCOPE_AGENT);
            __syncthreads();
            if (F.tid == 0) { int s = 0; for (int e = 0; e < 16; ++e) { mt[16 + e] = s; s += (mt[e] + 255) >> 8; } mt[32] = s; }
            __syncthreads();
        }
        for (int rep_ = 0; rep_ < (MK_REP == (101) ? 2 : 1); ++rep_) if (EN(101) && IN(pb + 1)) { if (rep_) { SEAM_FORCE(); } MKF();
            tgx::GuSched S{(const char*)(ws + WS_HA), (const char*)(ws + WS_WGU), (const int*)(ws + WS_LIST), mt, F.G, F.vcu, mt[32]};
            tgx::EpiGu E{(bf16*)(ws + WS_HS)};
            tg::tgemm_phase<true>(F.lds, F.tid, 1024, 1024, 1024, S, E);
        }
        SEAM(pb + 1);
        for (int rep_ = 0; rep_ < (MK_REP == (102) ? 2 : 1); ++rep_) if (EN(102) && IN(pb + 2)) { if (rep_) { SEAM_FORCE(); } MKF();
            tgx::DnSched S{(const char*)(ws + WS_HS), (const char*)(ws + WS_WD), mt, F.G, F.vcu, mt[32]};
            tgx::EpiDn E{(bf16*)(ws + WS_Y2), (const int*)(ws + WS_LIST), (const float*)(ws + WS_TOKW), mt};
            tg::tgemm_phase<false>(F.lds, F.tid, 1024, 1024, 1024, S, E);
        }
        SEAM(pb + 2);
#ifdef MK_PRE_DELAY
        if (layer == NLAYER - 1 && IN(pb + 3)) { const unsigned long long t0_ = __builtin_amdgcn_s_memrealtime(); while (__builtin_amdgcn_s_memrealtime() - t0_ < (unsigned long long)MK_PRE_DELAY) __builtin_amdgcn_s_sleep(16); }
#endif
        for (int rep_ = 0; rep_ < ((MK_REP == 203 && layer == 3) ? 2 : 1); ++rep_) if (EN(103) && IN(pb + 3)) { if (rep_) { SEAM_FORCE(); } MKF();
            ln2_phase(F, layer, ka->in[I_LNG], ka->in[I_LNB], ka->out);
            if (layer + 1 < NLAYER) { for (int cr_ = 0; cr_ < (MK_REP == 303 ? 2 : 1); ++cr_) { __syncthreads(); convert_moe_layer(F, ka->in[I_WG], ka->in[I_WU], ka->in[I_WD], layer + 1); } }
        }
        if (layer + 1 < NLAYER) SEAM(pb + 3);
    }
#ifdef MK_FINAL_BARRIER
    if (multi) { XcdBarrier b_ = bar; unsigned* bp_ = b_.bar; asm volatile("" : "+s"(bp_)); b_.bar = bp_; xcd_barrier(b_, wave_s); }
#endif
    asm volatile("s_waitcnt vmcnt(0)" ::: "memory");
    __builtin_amdgcn_fence(__ATOMIC_RELEASE, "");
    asm volatile("s_waitcnt vmcnt(0)" ::: "memory");
    if (SETTLE_TICKS > 0 && lo <= NPH - 1 && NPH - 1 < hi) {
        const unsigned long long t0_ = __builtin_amdgcn_s_memrealtime(); while (__builtin_amdgcn_s_memrealtime() - t0_ < (unsigned long long)SETTLE_TICKS) __builtin_amdgcn_s_sleep(16); }
#undef IN
#undef SEAM
}

#ifdef MK_DBG4
__global__ void __launch_bounds__(256) dbg_sweep(const unsigned* p, size_t n, unsigned* sink) {
    unsigned x = 0; for (size_t i = (size_t)blockIdx.x * 256 + threadIdx.x; i < n; i += (size_t)gridDim.x * 256) x ^= p[i];
    if (x == 0x12345678u) sink[0] = x;
}
__global__ void __launch_bounds__(256) dbg_cmp4(const unsigned* h0, const unsigned* h1, float* out) {
    const int row = blockIdx.x * 4 + (threadIdx.x >> 6), lane = threadIdx.x & 63;
    const float vi = h0[2 * row] != h1[2 * row] ? 100.f : 0.f, vo = h0[2 * row + 1] != h1[2 * row + 1] ? 100.f : 0.f;
    for (int i = lane; i < D; i += 64) out[(size_t)row * D + i] = i < 512 ? vi : vo;
}
#endif
#ifdef MK_DBG9
__global__ void __launch_bounds__(256) dbg_copy(const u32x4* src, u32x4* dst, size_t n16) {
    for (size_t i = (size_t)blockIdx.x * 256 + threadIdx.x; i < n16; i += (size_t)gridDim.x * 256) dst[i] = src[i];
}
__global__ void __launch_bounds__(256) dbg_cmp9(const unsigned* a, const unsigned* b, float* out, size_t npairs) {
    for (size_t i = (size_t)blockIdx.x * 256 + threadIdx.x; i < npairs; i += (size_t)gridDim.x * 256) { const float v = (a[i] != b[i]) ? 1.0e4f : 0.f; out[2 * i] = v; out[2 * i + 1] = v; }
}
#endif
#ifdef MK_DBG7
__global__ void __launch_bounds__(256) dbg_y2_hash(const unsigned* Y2, unsigned* h) {
    const int row = blockIdx.x * 4 + (threadIdx.x >> 6), lane = threadIdx.x & 63; unsigned x = 0;
    for (int i = lane; i < 512; i += 64) x = x * 0x9E3779B1u + Y2[(size_t)row * 512 + i] * (2u * i + 1u);
    for (int o = 1; o < 64; o <<= 1) x += __shfl_xor(x, o) * 31u;
    if (lane == 0) h[row] = x;
}
__global__ void __launch_bounds__(256) dbg_cmp7(const unsigned* h0, const unsigned* h1, float* out) {
    const int row = blockIdx.x * 4 + (threadIdx.x >> 6), lane = threadIdx.x & 63; const float v = (h0[2 * row] != h1[2 * row] || h0[2 * row + 1] != h1[2 * row + 1]) ? 100.f : 0.f;
    for (int i = lane; i < D; i += 64) out[(size_t)row * D + i] = v;
}
#endif
#ifdef MK_DBG6
__global__ void __launch_bounds__(256) dbg_hs_hash(const int* LIST, const unsigned* CNT, const unsigned* HS, unsigned* h) {
    const int e = blockIdx.y; int tstart = 0; for (int k = 0; k < e; ++k) tstart += ((int)CNT[k * 64] + 255) >> 8;
    const int cnt = (int)CNT[e * 64], lane = threadIdx.x & 63;
    for (int idx = blockIdx.x * 4 + (threadIdx.x >> 6); idx < cnt; idx += gridDim.x * 4) {
        const unsigned* row = HS + ((size_t)tstart * 256 + idx) * 512; unsigned x = 0;
        for (int i = lane; i < 512; i += 64) x = x * 0x9E3779B1u + row[i] * (2u * i + 1u);
        for (int o = 1; o < 64; o <<= 1) x += __shfl_xor(x, o) * 31u;
        if (lane == 0) h[LIST[(size_t)e * T + idx]] = x;
    }
}
__global__ void __launch_bounds__(256) dbg_cmp6(const unsigned* h0, const unsigned* h1, float* out) {
    const int row = blockIdx.x * 4 + (threadIdx.x >> 6), lane = threadIdx.x & 63; const float v = (h0[row] != h1[row] || h0[row + T] != h1[row + T]) ? 100.f : 0.f;
    for (int i = lane; i < D; i += 64) out[(size_t)row * D + i] = v;
}
#endif
#ifdef MK_DBG5
__global__ void __launch_bounds__(256) dbg_list_mark(const int* LIST, const unsigned* CNT, int* seen) {
    const int e = blockIdx.y; const int cnt = (int)CNT[e * 64];
    for (int i = blockIdx.x * 256 + threadIdx.x; i < cnt; i += gridDim.x * 256) { const int s = LIST[(size_t)e * T + i]; if (s >= 0 && s < 2 * T) atomicAdd(seen + s, 1); else atomicAdd(seen + 2 * T, 1); }
}
__global__ void __launch_bounds__(256) dbg_list_out(const int* seen, float* out) {
    const int row = blockIdx.x * 4 + (threadIdx.x >> 6), lane = threadIdx.x & 63;
    const float v = (seen[row] != 1 || seen[row + T] != 1 || (row == 0 && seen[2 * T] != 0)) ? 100.f : 0.f;
    for (int i = lane; i < D; i += 64) out[(size_t)row * D + i] = v;
}
#endif
#ifdef MK_DBG3
__global__ void __launch_bounds__(256) dbg_hash(const unsigned* out, unsigned* h) {
    const int row = blockIdx.x * 4 + (threadIdx.x >> 6), lane = threadIdx.x & 63; unsigned x = 0;
    for (int i = lane; i < D; i += 64) x = x * 0x9E3779B1u + out[(size_t)row * D + i] * (2u * i + 1u);
    for (int o = 1; o < 64; o <<= 1) x += __shfl_xor(x, o) * 31u;
    if (lane == 0) h[row] = x;
}
__global__ void __launch_bounds__(256) dbg_cmp3(const unsigned* h0, const unsigned* h1, float* out) {
    const int row = blockIdx.x * 4 + (threadIdx.x >> 6), lane = threadIdx.x & 63; const float v = h0[row] != h1[row] ? 100.f : 0.f;
    for (int i = lane; i < D; i += 64) out[(size_t)row * D + i] = v;
}
#endif
#if defined(MK_DBG2) || defined(MK_DBG8)
__global__ void __launch_bounds__(256) dbg_cmp(const unsigned* a, const unsigned* b, float* out, size_t npairs, size_t nout) {
    for (size_t i = (size_t)blockIdx.x * 256 + threadIdx.x; i < npairs; i += (size_t)gridDim.x * 256) out[nout / 2 + i] = (a[i] != b[i]) ? 1.0e4f : 0.f;
}
__global__ void __launch_bounds__(256) dbg_zero(float* out, size_t n) {
    for (size_t i = (size_t)blockIdx.x * 256 + threadIdx.x; i < n; i += (size_t)gridDim.x * 256) out[i] = 0.f;
}
#endif
#ifdef MK_DBG_STOP
__global__ void __launch_bounds__(256) dbg_dump(const unsigned short* src, float* out, size_t n) {
    for (size_t i = (size_t)blockIdx.x * 256 + threadIdx.x; i < n; i += (size_t)gridDim.x * 256) out[i] = __uint_as_float((unsigned)src[i] << 16);
}
#endif
#ifdef MK_TAIL
__global__ void __launch_bounds__(256) dbg_tail(unsigned* p) { p[blockIdx.x * 256 + threadIdx.x] = 1u; }
#endif
extern "C" void kernel_launch(void* const* d_in, const int* in_sizes, int n_in, void* d_out, int out_size, void* d_ws, size_t ws_size, hipStream_t stream) {
    static int grid = 0;
    if (grid == 0) {
        if (n_in != 34 || in_sizes[0] != T * D || out_size != T * D || ws_size < WS_END) {
            fprintf(stderr, "kernel_launch: unexpected shapes: n_in %d in0 %d out %d ws %zu (need %zu)\n", n_in, n_in > 0 ? in_sizes[0] : -1, out_size, ws_size, (size_t)WS_END); grid = -1; return; }
        int dev = 0, cus = 0, per_cu = 0;
        if (hipGetDevice(&dev) != hipSuccess || hipDeviceGetAttribute(&cus, hipDeviceAttributeMultiprocessorCount, dev) != hipSuccess) { grid = -1; return; }
        if (hipFuncSetAttribute((const void*)mk_fwd, hipFuncAttributeMaxDynamicSharedMemorySize, LDS_BYTES) != hipSuccess) { fprintf(stderr, "kernel_launch: hipFuncSetAttribute failed\n"); grid = -1; return; }
        if (hipOccupancyMaxActiveBlocksPerMultiprocessor(&per_cu, (const void*)mk_fwd, NTHR, LDS_BYTES) != hipSuccess || per_cu < 1) fprintf(stderr, "kernel_launch: occupancy query says %d\n", per_cu);
        (void)hipGetLastError();
        grid = 256; while (grid > cus) grid >>= 1;
    }
    if (grid < 0) return;
#ifdef MK_SENT
    (void)hipMemsetAsync(d_out, 0xFF, (size_t)T * D * 4, stream);
#endif
#ifdef MK_POISON
    (void)hipMemsetAsync((char*)d_ws, 0xAA, WS_END, stream);
#endif
    (void)hipMemsetAsync((char*)d_ws + WS_CTL, 0, CTL_BYTES, stream);
    Args a{};
    for (int i = 0; i < 34; ++i) a.in[i] = (const float*)d_in[i];
    a.out = (float*)d_out; a.ws = (unsigned char*)d_ws;
#if MK_ONE_LAUNCH
    a.ph_lo = 0; a.ph_hi = NPH;
    hipLaunchKernelGGL(mk_fwd, dim3(grid), dim3(NTHR), LDS_BYTES, stream, a);
#else
#ifdef MK_DBG9
    for (int k = 0; k <= MK_DBG9; ++k) { a.ph_lo = k; a.ph_hi = k + 1; hipLaunchKernelGGL(mk_fwd, dim3(grid), dim3(NTHR), LDS_BYTES, stream, a); }
    a.ph_lo = MK_DBG9; a.ph_hi = MK_DBG9 + 1; hipLaunchKernelGGL(mk_fwd, dim3(grid), dim3(NTHR), LDS_BYTES, stream, a);
    hipLaunchKernelGGL(dbg_copy, dim3(2048), dim3(256), 0, stream, (const u32x4*)((char*)d_ws + MK_DBG_BUF), (u32x4*)((char*)d_ws + MK_DBG_TMP), (size_t)T * D * 2 / 16);
    hipLaunchKernelGGL(mk_fwd, dim3(grid), dim3(NTHR), LDS_BYTES, stream, a);
    hipLaunchKernelGGL(dbg_cmp9, dim3(2048), dim3(256), 0, stream, (const unsigned*)((char*)d_ws + MK_DBG_TMP), (const unsigned*)((char*)d_ws + MK_DBG_BUF), (float*)d_out, (size_t)T * D / 2);
#elif defined(MK_DBG8)
    for (int k = 0; k <= MK_DBG8; ++k) { a.ph_lo = k; a.ph_hi = k + 1; hipLaunchKernelGGL(mk_fwd, dim3(grid), dim3(NTHR), LDS_BYTES, stream, a); }
#ifdef MK_DBG8_TWICE
    a.ph_lo = MK_DBG8; a.ph_hi = MK_DBG8 + 1; hipLaunchKernelGGL(mk_fwd, dim3(grid), dim3(NTHR), LDS_BYTES, stream, a);
#endif
    (void)hipMemcpyAsync(d_out, (char*)d_ws + MK_DBG_BUF, (size_t)T * D * 2, hipMemcpyDeviceToDevice, stream);
#ifndef MK_DBG8_NOMEMSET
    (void)hipMemsetAsync((char*)d_ws + MK_DBG_BUF, 0xAA, (size_t)T * D * 2, stream);
#endif
    a.ph_lo = MK_DBG8; a.ph_hi = MK_DBG8 + 1; hipLaunchKernelGGL(mk_fwd, dim3(grid), dim3(NTHR), LDS_BYTES, stream, a);
    hipLaunchKernelGGL(dbg_cmp, dim3(2048), dim3(256), 0, stream, (const unsigned*)d_out, (const unsigned*)((char*)d_ws + MK_DBG_BUF), (float*)d_out, (size_t)T * D / 2, (size_t)T * D);
    hipLaunchKernelGGL(dbg_zero, dim3(2048), dim3(256), 0, stream, (float*)d_out, (size_t)T * D / 2);
#elif defined(MK_DBG7)
    for (int k = 0; k <= MK_DBG7; ++k) { a.ph_lo = k; a.ph_hi = k + 1; hipLaunchKernelGGL(mk_fwd, dim3(grid), dim3(NTHR), LDS_BYTES, stream, a); }
    hipLaunchKernelGGL(dbg_y2_hash, dim3(2 * T / 4), dim3(256), 0, stream, (const unsigned*)((char*)d_ws + WS_Y2), (unsigned*)((char*)d_ws + 10 * MiB));
    (void)hipMemsetAsync((char*)d_ws + WS_CTL, 0, CTL_BYTES, stream);
    a.flip = 1;
    for (int k = 0; k <= MK_DBG7; ++k) { a.ph_lo = k; a.ph_hi = k + 1; hipLaunchKernelGGL(mk_fwd, dim3(grid), dim3(NTHR), LDS_BYTES, stream, a); }
    hipLaunchKernelGGL(dbg_y2_hash, dim3(2 * T / 4), dim3(256), 0, stream, (const unsigned*)((char*)d_ws + WS_Y2), (unsigned*)((char*)d_ws + 10 * MiB + 512 * 1024));
    hipLaunchKernelGGL(dbg_cmp7, dim3(T / 4), dim3(256), 0, stream, (const unsigned*)((char*)d_ws + 10 * MiB), (const unsigned*)((char*)d_ws + 10 * MiB + 512 * 1024), (float*)d_out);
#elif defined(MK_DBG6)
    for (int k = 0; k <= MK_DBG6; ++k) { a.ph_lo = k; a.ph_hi = k + 1; hipLaunchKernelGGL(mk_fwd, dim3(grid), dim3(NTHR), LDS_BYTES, stream, a); }
    hipLaunchKernelGGL(dbg_hs_hash, dim3(64, 16), dim3(256), 0, stream, (const int*)((char*)d_ws + WS_LIST), (const unsigned*)((char*)d_ws + WS_CTL) + CW_CNT + MK_DBG6_LAYER * 16 * 64, (const unsigned*)((char*)d_ws + WS_HS), (unsigned*)((char*)d_ws + 10 * MiB));
    (void)hipMemsetAsync((char*)d_ws + WS_CTL, 0, CTL_BYTES, stream);
    a.flip = 1;
    for (int k = 0; k <= MK_DBG6; ++k) { a.ph_lo = k; a.ph_hi = k + 1; hipLaunchKernelGGL(mk_fwd, dim3(grid), dim3(NTHR), LDS_BYTES, stream, a); }
    hipLaunchKernelGGL(dbg_hs_hash, dim3(64, 16), dim3(256), 0, stream, (const int*)((char*)d_ws + WS_LIST), (const unsigned*)((char*)d_ws + WS_CTL) + CW_CNT + MK_DBG6_LAYER * 16 * 64, (const unsigned*)((char*)d_ws + WS_HS), (unsigned*)((char*)d_ws + 10 * MiB + 512 * 1024));
    hipLaunchKernelGGL(dbg_cmp6, dim3(T / 4), dim3(256), 0, stream, (const unsigned*)((char*)d_ws + 10 * MiB), (const unsigned*)((char*)d_ws + 10 * MiB + 512 * 1024), (float*)d_out);
#elif defined(MK_DBG5)
    (void)hipMemsetAsync((char*)d_ws + 10 * MiB, 0, (2 * T + 64) * 4, stream);
    for (int k = 0; k <= MK_DBG5; ++k) { a.ph_lo = k; a.ph_hi = k + 1; hipLaunchKernelGGL(mk_fwd, dim3(grid), dim3(NTHR), LDS_BYTES, stream, a); }
    hipLaunchKernelGGL(dbg_list_mark, dim3(64, 16), dim3(256), 0, stream, (const int*)((char*)d_ws + WS_LIST), (const unsigned*)((char*)d_ws + WS_CTL) + CW_CNT + MK_DBG5_LAYER * 16 * 64, (int*)((char*)d_ws + 10 * MiB));
    hipLaunchKernelGGL(dbg_list_out, dim3(T / 4), dim3(256), 0, stream, (const int*)((char*)d_ws + 10 * MiB), (float*)d_out);
#elif defined(MK_DBG4)
    a.flip = 0;
    for (int k = 0; k < NPH; ++k) { a.ph_lo = k; a.ph_hi = k + 1; hipLaunchKernelGGL(mk_fwd, dim3(grid), dim3(NTHR), LDS_BYTES, stream, a); }
    (void)hipMemsetAsync((char*)d_ws + 12 * MiB, 0xAA, WS_END - 12 * MiB, stream);
    (void)hipMemsetAsync((char*)d_ws, 0xAA, 10 * MiB, stream);
    hipLaunchKernelGGL(dbg_sweep, dim3(4096), dim3(256), 0, stream, (const unsigned*)d_in[31], (size_t)64 * 1024 * 1024, (unsigned*)((char*)d_ws + 9 * MiB));
    (void)hipMemsetAsync((char*)d_ws + WS_CTL, 0, CTL_BYTES, stream);
    a.flip = 1;
    for (int k = 0; k < NPH; ++k) { a.ph_lo = k; a.ph_hi = k + 1; hipLaunchKernelGGL(mk_fwd, dim3(grid), dim3(NTHR), LDS_BYTES, stream, a); }
    hipLaunchKernelGGL(dbg_cmp4, dim3(T / 4), dim3(256), 0, stream, (const unsigned*)((char*)d_ws + 10 * MiB), (const unsigned*)((char*)d_ws + 11 * MiB), (float*)d_out);
#elif defined(MK_DBG3)
    for (int k = 0; k < NPH; ++k) { a.ph_lo = k; a.ph_hi = k + 1; hipLaunchKernelGGL(mk_fwd, dim3(grid), dim3(NTHR), LDS_BYTES, stream, a); }
    hipLaunchKernelGGL(dbg_hash, dim3(T / 4), dim3(256), 0, stream, (const unsigned*)d_out, (unsigned*)((char*)d_ws + 10 * MiB));
#ifdef MK_DBG3_POISON
    (void)hipMemsetAsync((char*)d_ws + 12 * MiB, 0xAA, WS_END - 12 * MiB, stream);
    (void)hipMemsetAsync((char*)d_ws, 0xAA, 10 * MiB, stream);
#endif
    (void)hipMemsetAsync((char*)d_ws + WS_CTL, 0, CTL_BYTES, stream);
    a.flip = 1;
    for (int k = 0; k < NPH; ++k) { a.ph_lo = k; a.ph_hi = k + 1; hipLaunchKernelGGL(mk_fwd, dim3(grid), dim3(NTHR), LDS_BYTES, stream, a); }
    hipLaunchKernelGGL(dbg_hash, dim3(T / 4), dim3(256), 0, stream, (const unsigned*)d_out, (unsigned*)((char*)d_ws + 11 * MiB));
    hipLaunchKernelGGL(dbg_cmp3, dim3(T / 4), dim3(256), 0, stream, (const unsigned*)((char*)d_ws + 10 * MiB), (const unsigned*)((char*)d_ws + 11 * MiB), (float*)d_out);
#elif defined(MK_DBG2)
    for (int k = 0; k <= MK_DBG2; ++k) { a.ph_lo = k; a.ph_hi = k + 1; hipLaunchKernelGGL(mk_fwd, dim3(grid), dim3(NTHR), LDS_BYTES, stream, a); }
    (void)hipMemcpyAsync(d_out, (char*)d_ws + MK_DBG_BUF, (size_t)T * D * 2, hipMemcpyDeviceToDevice, stream);
    (void)hipMemsetAsync((char*)d_ws, 0xAA, WS_END, stream);
    (void)hipMemsetAsync((char*)d_ws + WS_CTL, 0, CTL_BYTES, stream);
    a.flip = 1;
    for (int k = 0; k <= MK_DBG2; ++k) { a.ph_lo = k; a.ph_hi = k + 1; hipLaunchKernelGGL(mk_fwd, dim3(grid), dim3(NTHR), LDS_BYTES, stream, a); }
    hipLaunchKernelGGL(dbg_cmp, dim3(2048), dim3(256), 0, stream, (const unsigned*)d_out, (const unsigned*)((char*)d_ws + MK_DBG_BUF), (float*)d_out, (size_t)T * D / 2, (size_t)T * D);
    hipLaunchKernelGGL(dbg_zero, dim3(2048), dim3(256), 0, stream, (float*)d_out, (size_t)T * D / 2);
#elif defined(MK_DBG_STOP)
    for (int k = 0; k <= MK_DBG_STOP; ++k) { a.ph_lo = k; a.ph_hi = k + 1; hipLaunchKernelGGL(mk_fwd, dim3(grid), dim3(NTHR), LDS_BYTES, stream, a); }
#ifdef MK_DBG_F32
    (void)hipMemcpyAsync(d_out, (char*)d_ws + MK_DBG_BUF, (size_t)T * D * 4, hipMemcpyDeviceToDevice, stream);
#else
    hipLaunchKernelGGL(dbg_dump, dim3(2048), dim3(256), 0, stream, (const unsigned short*)((char*)d_ws + MK_DBG_BUF), (float*)d_out, (size_t)T * D);
#endif
#else
    for (int k = 0; k < NPH; ++k) { a.ph_lo = k; a.ph_hi = k + 1; hipLaunchKernelGGL(mk_fwd, dim3(grid), dim3(NTHR), LDS_BYTES, stream, a); }
#endif
#endif
#ifdef MK_TAIL
    hipLaunchKernelGGL(dbg_tail, dim3(256), dim3(256), 0, stream, (unsigned*)((char*)d_ws + 10 * MiB));
#endif
    const hipError_t le = hipPeekAtLastError();
    if (le != hipSuccess) fprintf(stderr, "kernel_launch: launch failed: %s\n", hipGetErrorName(le));
}
```

```cpp
#include <hip/hip_runtime.h>
#include <cstdio>
#include <cstdint>

#ifndef MK_ONE_LAUNCH
#define MK_ONE_LAUNCH 1
#endif

#define LAS __attribute__((address_space(3)))
#define GAS __attribute__((address_space(1)))
typedef unsigned short bf16;
typedef short bf16x8 __attribute__((ext_vector_type(8)));
typedef short s16x4 __attribute__((ext_vector_type(4)));
typedef short v4i16_t __attribute__((ext_vector_type(4)));
typedef float f32x4 __attribute__((ext_vector_type(4)));
typedef float f32x2 __attribute__((ext_vector_type(2)));
typedef float f32x16 __attribute__((ext_vector_type(16)));
typedef unsigned u32x4 __attribute__((ext_vector_type(4)));
typedef unsigned u32x2 __attribute__((ext_vector_type(2)));

constexpr int D = 1024, NB = 4, SEQ = 8192, T = NB * SEQ, CTXL = 256, TC = NB * CTXL, LK = SEQ + CTXL, MROWS = T + TC;
constexpr int NLAYER = 4, NEXP = 16;
constexpr float ALPHA = 1.681792830507429f;
constexpr float LN_EPS = 1e-5f;
constexpr int NWAVES = 8, NTHR = 512;

constexpr size_t MiB = 1u << 20;
constexpr size_t WS_CTL = 0, CTL_BYTES = 1 * MiB;
constexpr size_t WS_MODV = 1 * MiB;
constexpr size_t WS_ROPE = WS_MODV + 512 * 1024;
constexpr size_t WS_TOKE = 2 * MiB;
constexpr size_t WS_TOKW = WS_TOKE + 256 * 1024;
constexpr size_t WS_LIST = 3 * MiB;
constexpr size_t WS_DFT = 5 * MiB;
constexpr size_t DFT_F1 = WS_DFT;
constexpr size_t DFT_C256 = DFT_F1 + 128 * 64 * 2;
constexpr size_t DFT_K1 = DFT_C256 + 256 * 256 * 2;
constexpr size_t DFT_H1 = DFT_K1 + 256 * 128 * 2;
constexpr size_t DFT_H2B = DFT_H1 + 256 * 128 * 2;
constexpr size_t DFT_H3 = DFT_H2B + 256 * 256 * 2;
constexpr size_t WS_TWF = 6 * MiB;
constexpr size_t WS_TWH = WS_TWF + 64 * 128 * 8;
constexpr size_t WS_A2 = 8 * MiB;
constexpr size_t WS_A2B = 11 * MiB;
constexpr size_t WS_TRIG = WS_DFT + 512 * 1024;
constexpr size_t WS_WFB = 13 * MiB;
constexpr size_t WS_RWT = 15 * MiB;
constexpr size_t WS_F3T = 12 * MiB;
constexpr size_t WS_WQKV = 16 * MiB;
constexpr size_t WS_WO = 22 * MiB;
constexpr size_t WS_POOLW = 24 * MiB;
constexpr size_t WS_FW = 25 * MiB;
constexpr size_t WS_HWIN = 29 * MiB;
constexpr size_t WS_HWO = 35 * MiB;
constexpr size_t WS_WGU = 40 * MiB;
constexpr size_t WS_WD = 104 * MiB;
constexpr size_t WS_XR = 136 * MiB;
constexpr size_t WS_HA = 200 * MiB;
constexpr size_t AR = 268 * MiB;
constexpr size_t WS_Q = AR, WS_K = AR + 64 * MiB, WS_V = AR + 130 * MiB, WS_AO = AR + 196 * MiB;
constexpr size_t WS_Y = AR + 260 * MiB;
constexpr size_t WS_HS = AR + 324 * MiB;
constexpr size_t WS_Y2 = AR + 460 * MiB;
constexpr size_t WS_POOLED = AR;
constexpr size_t WS_FT = AR, WS_PQ = AR + 128 * MiB;
constexpr size_t WS_Z = AR, WS_VP = AR + 192 * MiB, WS_X0 = AR + 324 * MiB;
constexpr size_t WS_HT = AR, WS_HG = AR;
constexpr size_t WS_YH = AR + 388 * MiB, WS_YX = AR + 388 * MiB;
constexpr size_t WS_KH = AR + 516 * MiB;
constexpr size_t WS_KFULL = AR + 644 * MiB;
constexpr size_t WS_KT = AR + 676 * MiB;
constexpr size_t WS_END = AR + 756 * MiB;
constexpr size_t PLANE64 = 64 * MiB, PLANE32 = 32 * MiB;

constexpr int CW_BAR = 4096;
constexpr int CW_CNT = 16384;

constexpr int LDS_SCRATCH = 147456;
constexpr int LDS_MISC = LDS_SCRATCH;
constexpr int LDS_BYTES = LDS_SCRATCH + 8192;

__device__ __forceinline__ float bf2f(unsigned short u) { return __uint_as_float((unsigned)u << 16); }
__device__ __forceinline__ float bflo(unsigned w) { return __uint_as_float(w << 16); }
__device__ __forceinline__ float bfhi(unsigned w) { return __uint_as_float(w & 0xffff0000u); }
__device__ __forceinline__ unsigned pk2(float lo, float hi) { unsigned r; asm("v_cvt_pk_bf16_f32 %0, %1, %2" : "=v"(r) : "v"(lo), "v"(hi)); return r; }
__device__ __forceinline__ float fsin_rev(float rev) { return __builtin_amdgcn_sinf(rev); }
__device__ __forceinline__ float fcos_rev(float rev) { return __builtin_amdgcn_cosf(rev); }
__device__ __forceinline__ float frcp(float x) { return __builtin_amdgcn_rcpf(x); }
__device__ __forceinline__ float fsilu(float x) { return x * frcp(1.f + __expf(-x)); }
template <int CTRL> __device__ __forceinline__ float dpp_mov(float x) { return __builtin_bit_cast(float, __builtin_amdgcn_mov_dpp(__builtin_bit_cast(int, x), CTRL, 0xf, 0xf, true)); }
__device__ __forceinline__ float row16_sum(float v) { v += dpp_mov<0xB1>(v); v += dpp_mov<0x4E>(v); v += dpp_mov<0x124>(v); v += dpp_mov<0x128>(v); return v; }
__device__ __forceinline__ float wave_sum(float v) {
    v = row16_sum(v);
    { auto s_ = __builtin_amdgcn_permlane16_swap(__float_as_uint(v), __float_as_uint(v), false, false); v = __uint_as_float(s_[0]) + __uint_as_float(s_[1]); }
    { auto t_ = __builtin_amdgcn_permlane32_swap(__float_as_uint(v), __float_as_uint(v), false, false); v = __uint_as_float(t_[0]) + __uint_as_float(t_[1]); }
    return v;
}
#define LDS_WAIT() asm volatile("s_waitcnt lgkmcnt(0)" ::: "memory")
#define VM_WAIT() asm volatile("s_waitcnt vmcnt(0)" ::: "memory")

#define XB_TMO      128
#define XB_XCNT(j)  (256  + 64 * (j))
#define XB_XSUB(j)  (1280 + 64 * (j))
#define XB_XGEN(j)  (2304 + 64 * (j))
#define XB_TOP      3328
#define XB_TOPGEN   3392
#define XCD_BAR_WORDS 3456
#define XB_SPIN_CAP (1u << 22)

__device__ __forceinline__ unsigned xb_ld(unsigned* p)              { return __hip_atomic_load(p, __ATOMIC_RELAXED, __HIP_MEMORY_SCOPE_AGENT); }
__device__ __forceinline__ unsigned xb_add(unsigned* p, unsigned v) { return __hip_atomic_fetch_add(p, v, __ATOMIC_RELAXED, __HIP_MEMORY_SCOPE_AGENT); }
__device__ __forceinline__ unsigned xb_xcc_id() { return (unsigned)__builtin_amdgcn_s_getreg((3 << 11) | 20) & 0xFu; }
#define XB_SPIN(cond, bar) do { unsigned _sp = 0; while (cond) { __builtin_amdgcn_s_sleep(1); \
    if ((++_sp & 255u) == 0u) { if (xb_ld(&(bar)[XB_TMO])) break; if (_sp > XB_SPIN_CAP) { atomicAdd(&(bar)[XB_TMO], 1u); break; } } } } while (0)

struct XcdBarrier { unsigned* bar; unsigned x; volatile LAS unsigned* st; };

__device__ __forceinline__ int lane_id() { int l; asm volatile("v_mbcnt_lo_u32_b32 %0, -1, 0\n\tv_mbcnt_hi_u32_b32 %0, -1, %0" : "=v"(l)); return l; }
__device__ __forceinline__ XcdBarrier xcd_barrier_post(unsigned* bar, volatile LAS unsigned* st, int wave_s) {
    XcdBarrier b; b.bar = bar; b.x = xb_xcc_id(); b.st = st;
    if (wave_s == 0 && lane_id() == 0) (void)xb_add(&bar[XB_XCNT(b.x)], 1u);
    return b;
}
__device__ __forceinline__ void xcd_barrier_complete(unsigned* bar, unsigned x, unsigned& nloc, unsigned& nx) {
    const unsigned G = gridDim.x * gridDim.y * gridDim.z;
    unsigned sum, cnt, mine, sp = 0u;
    for (;;) {
        sum = 0u; cnt = 0u; mine = 0u;
#pragma unroll
        for (unsigned j = 0; j < 16; ++j) { const unsigned c = xb_ld(&bar[XB_XCNT(j)]); sum += c; cnt += (c > 0u) ? 1u : 0u; mine = (j == x) ? c : mine; }
        if (sum == G) break;
        __builtin_amdgcn_s_sleep(1);
        if ((++sp & 255u) == 0u) { if (xb_ld(&bar[XB_TMO])) break; if (sp > XB_SPIN_CAP) { atomicAdd(&bar[XB_TMO], 1u); break; } }
    }
    nloc = mine > 0u ? mine : 1u; nx = cnt > 0u ? cnt : 1u;
}
__device__ __forceinline__ void xcd_barrier(const XcdBarrier& b, int wave_s) {
    asm volatile("s_waitcnt vmcnt(0)" ::: "memory");
    __syncthreads();
    if (wave_s == 0 && lane_id() == 0) {
        unsigned* bar = b.bar;
        __builtin_amdgcn_s_waitcnt(0);
        unsigned nloc = b.st[0], nx = b.st[1];
        if (nloc == 0u) { xcd_barrier_complete(bar, b.x, nloc, nx); b.st[0] = nloc; b.st[1] = nx; }
        const unsigned old = xb_add(&bar[XB_XSUB(b.x)], 1u);
        const unsigned gen = old / nloc;
        if (old + 1u == (gen + 1u) * nloc) {
            __builtin_amdgcn_fence(__ATOMIC_RELEASE, "agent");
            asm volatile("s_waitcnt vmcnt(0)" ::: "memory");
            const unsigned og = xb_add(&bar[XB_TOP], 1u);
            const unsigned tg = og / nx;
            if (og + 1u == (tg + 1u) * nx) xb_add(&bar[XB_TOPGEN], 1u);
            else XB_SPIN(xb_ld(&bar[XB_TOPGEN]) == tg, bar);
            __builtin_amdgcn_fence(__ATOMIC_ACQUIRE, "agent");
            xb_add(&bar[XB_XGEN(b.x)], 1u);
            asm volatile("s_waitcnt vmcnt(0)" ::: "memory");
        } else {
            XB_SPIN(xb_ld(&bar[XB_XGEN(b.x)]) == gen, bar);
            __builtin_amdgcn_fence(__ATOMIC_ACQUIRE, "agent");
            asm volatile("s_waitcnt vmcnt(0)" ::: "memory");
        }
    }
    __syncthreads();
}
constexpr int SG_PA = 144, SG_ABYTES = 256 * SG_PA, SG_PBK = 544, SG_STAGE = 2 * SG_ABYTES;
static_assert(64 * SG_PBK <= SG_ABYTES && 2 * SG_STAGE <= LDS_SCRATCH, "sgemm LDS");

__device__ __forceinline__ s16x4 ds_tr(unsigned addr) {
    return __builtin_bit_cast(s16x4, __builtin_amdgcn_ds_read_tr16_b64_v4i16((LAS v4i16_t*)(uintptr_t)addr));
}

template <int MT, int BKIND, class P>
__device__ __forceinline__ void sgemm_unit(LAS unsigned char* lds, const int tid_in, const P& p) {
    int tid = tid_in; asm volatile("" : "+v"(tid));
#ifdef MK_SG_ENTRY_SYNC
    __syncthreads();
#endif
    constexpr int MB = MT / 32, NA = MT / 64;
    const int lane = tid & 63, wid = tid >> 6, wr = wid >> 2, wc = wid & 3, fr = lane & 15, fq = lane >> 4;
    f32x4 acc[MB][4];
#pragma unroll
    for (int a = 0; a < MB; ++a)
#pragma unroll
        for (int b = 0; b < 4; ++b) acc[a][b] = (f32x4){0.f, 0.f, 0.f, 0.f};
    int nk = p.K >> 6;
    asm volatile("" : "+s"(nk));
    const int srow = tid >> 3, sch = tid & 7;
    const int krow = tid >> 5, kch = tid & 31;
    const char* abase = (const char*)p.abase(); const char* bbase = (const char*)p.bbase();
    unsigned oa[NA], ob[4];
#pragma unroll
    for (int i = 0; i < NA; ++i) oa[i] = (p.aoff(srow + 64 * i) + sch * 8) * 2u;
    if constexpr (BKIND == 0) {
#pragma unroll
        for (int i = 0; i < 4; ++i) ob[i] = (p.boff(srow + 64 * i) + sch * 8) * 2u;
    }
    u32x4 ra[NA], rb[4];
    const unsigned lbase = (unsigned)(uintptr_t)lds;
    const unsigned wa_off = (unsigned)(srow * SG_PA + sch * 16);
    const unsigned wb_off = BKIND == 0 ? (unsigned)(srow * SG_PA + sch * 16) : (unsigned)(krow * SG_PBK + kch * 16);
#define SG_GLOAD(kt) do { \
        _Pragma("unroll") for (int i = 0; i < NA; ++i) ra[i] = *(const u32x4*)(abase + (size_t)(oa[i] + (unsigned)(kt) * 128u)); \
        if constexpr (BKIND == 0) { _Pragma("unroll") for (int i = 0; i < 4; ++i) rb[i] = *(const u32x4*)(bbase + (size_t)(ob[i] + (unsigned)(kt) * 128u)); } \
        else { _Pragma("unroll") for (int i = 0; i < 4; ++i) rb[i] = *(const u32x4*)(bbase + (size_t)((p.boff((kt) * 64 + krow + 16 * i) + kch * 8) * 2u)); } } while (0)
#define SG_LWRITE(st) do { const unsigned sb_ = lbase + (st) * SG_STAGE; \
        _Pragma("unroll") for (int i = 0; i < NA; ++i) *(LAS u32x4*)(uintptr_t)(sb_ + wa_off + i * 64 * SG_PA) = ra[i]; \
        _Pragma("unroll") for (int i = 0; i < 4; ++i) *(LAS u32x4*)(uintptr_t)(sb_ + SG_ABYTES + wb_off + i * (BKIND == 0 ? 64 * SG_PA : 16 * SG_PBK)) = rb[i]; } while (0)
    const unsigned fa_off = (unsigned)((wr * (MT / 2) + fr) * SG_PA + fq * 16);
    const unsigned fb_off = BKIND == 0 ? (unsigned)((wc * 64 + fr) * SG_PA + fq * 16)
                                       : (unsigned)((8 * fq + (fr >> 2)) * SG_PBK + (wc * 64 + 4 * (fr & 3)) * 2);
    SG_GLOAD(0);
    SG_LWRITE(0);
    __syncthreads();
#pragma nounroll
    for (int kt = 0; kt < nk; ++kt) {
        const int st = kt & 1;
        if (kt + 1 < nk) SG_GLOAD(kt + 1);
        const unsigned sa = lbase + st * SG_STAGE, sb = sa + SG_ABYTES;
#pragma unroll
        for (int ks = 0; ks < 2; ++ks) {
            bf16x8 bfr[4];
            if constexpr (BKIND == 0) {
#pragma unroll
                for (int nb = 0; nb < 4; ++nb) bfr[nb] = *(const LAS bf16x8*)(uintptr_t)(sb + fb_off + nb * 16 * SG_PA + ks * 64);
            } else {
#pragma unroll
                for (int nb = 0; nb < 4; ++nb) {
                    const s16x4 lo = ds_tr(sb + fb_off + ks * 32 * SG_PBK + nb * 32), hi = ds_tr(sb + fb_off + (ks * 32 + 4) * SG_PBK + nb * 32);
                    bfr[nb] = (bf16x8){lo[0], lo[1], lo[2], lo[3], hi[0], hi[1], hi[2], hi[3]};
                }
            }
#pragma unroll
            for (int mg = 0; mg < MB; mg += 4) {
                bf16x8 af[4];
#pragma unroll
                for (int mb = 0; mb < 4; ++mb) af[mb] = *(const LAS bf16x8*)(uintptr_t)(sa + fa_off + (mg + mb) * 16 * SG_PA + ks * 64);
#pragma unroll
                for (int mb = 0; mb < 4; ++mb)
#pragma unroll
                    for (int nb = 0; nb < 4; ++nb) acc[mg + mb][nb] = __builtin_amdgcn_mfma_f32_16x16x32_bf16(bfr[nb], af[mb], acc[mg + mb][nb], 0, 0, 0);
                if (MB > 4) __builtin_amdgcn_sched_barrier(0);
            }
            if (MB > 4) __builtin_amdgcn_sched_barrier(0);
        }
        if (kt + 1 < nk) SG_LWRITE(st ^ 1);
        __syncthreads();
    }
#undef SG_GLOAD
#undef SG_LWRITE
    p.epi(acc, wr, wc, fr, fq);
}

#ifndef SG_EPI_FIRST
#define SG_EPI_FIRST 1
#endif
template <int MT, int BKIND, class Gen>
__device__ __forceinline__ void sgemm_stream(LAS unsigned char* lds, const int tid_in, const Gen& gen, const int u0, const int uN, const int ustep) {
    if (u0 >= uN) return;
    int tid = tid_in; asm volatile("" : "+v"(tid));
    constexpr int MB = MT / 32, NA = MT / 64;
    const int lane = tid & 63, wid = tid >> 6, wr = wid >> 2, wc = wid & 3, fr = lane & 15, fq = lane >> 4;
    const int srow = tid >> 3, sch = tid & 7, krow = tid >> 5, kch = tid & 31;
    u32x4 ra[NA], rb[4];
    const unsigned lbase = (unsigned)(uintptr_t)lds;
    const unsigned wa_off = (unsigned)(srow * SG_PA + sch * 16);
    const unsigned wb_off = BKIND == 0 ? (unsigned)(srow * SG_PA + sch * 16) : (unsigned)(krow * SG_PBK + kch * 16);
    const unsigned fa_off = (unsigned)((wr * (MT / 2) + fr) * SG_PA + fq * 16);
    const unsigned fb_off = BKIND == 0 ? (unsigned)((wc * 64 + fr) * SG_PA + fq * 16)
                                       : (unsigned)((8 * fq + (fr >> 2)) * SG_PBK + (wc * 64 + 4 * (fr & 3)) * 2);
#define SGS_GLOAD(P_, kt) do { const char* ab_ = (const char*)(P_).abase(); const char* bb_ = (const char*)(P_).bbase(); \
        _Pragma("unroll") for (int i = 0; i < NA; ++i) ra[i] = *(const u32x4*)(ab_ + (size_t)(((P_).aoff(srow + 64 * i) + sch * 8) * 2u + (unsigned)(kt) * 128u)); \
        if constexpr (BKIND == 0) { _Pragma("unroll") for (int i = 0; i < 4; ++i) rb[i] = *(const u32x4*)(bb_ + (size_t)(((P_).boff(srow + 64 * i) + sch * 8) * 2u + (unsigned)(kt) * 128u)); } \
        else { _Pragma("unroll") for (int i = 0; i < 4; ++i) rb[i] = *(const u32x4*)(bb_ + (size_t)(((P_).boff((kt) * 64 + krow + 16 * i) + kch * 8) * 2u)); } } while (0)
#define SGS_LWRITE(st) do { const unsigned sb_ = lbase + (st) * SG_STAGE; \
        _Pragma("unroll") for (int i = 0; i < NA; ++i) *(LAS u32x4*)(uintptr_t)(sb_ + wa_off + i * 64 * SG_PA) = ra[i]; \
        _Pragma("unroll") for (int i = 0; i < 4; ++i) *(LAS u32x4*)(uintptr_t)(sb_ + SG_ABYTES + wb_off + i * (BKIND == 0 ? 64 * SG_PA : 16 * SG_PBK)) = rb[i]; } while (0)
    auto cur = gen(u0);
    int g = 0;
    SGS_GLOAD(cur, 0); SGS_LWRITE(0); __syncthreads();
    for (int u = u0; u < uN; u += ustep) {
        const int un = u + ustep; const bool hn = un < uN;
        auto nxt = gen(hn ? un : u);
        f32x4 acc[MB][4];
#pragma unroll
        for (int a = 0; a < MB; ++a)
#pragma unroll
            for (int b = 0; b < 4; ++b) acc[a][b] = (f32x4){0.f, 0.f, 0.f, 0.f};
        int nk = cur.K >> 6; asm volatile("" : "+s"(nk));
#pragma nounroll
        for (int kt = 0; kt < nk; ++kt) {
            const int st = g & 1;
            if (kt + 1 < nk) SGS_GLOAD(cur, kt + 1); else if (hn) SGS_GLOAD(nxt, 0);
            const unsigned sa = lbase + st * SG_STAGE, sb = sa + SG_ABYTES;
#pragma unroll
            for (int ks = 0; ks < 2; ++ks) {
                bf16x8 bfr[4];
                if constexpr (BKIND == 0) {
#pragma unroll
                    for (int nb = 0; nb < 4; ++nb) bfr[nb] = *(const LAS bf16x8*)(uintptr_t)(sb + fb_off + nb * 16 * SG_PA + ks * 64);
                } else {
#pragma unroll
                    for (int nb = 0; nb < 4; ++nb) {
                        const s16x4 lo = ds_tr(sb + fb_off + ks * 32 * SG_PBK + nb * 32), hi = ds_tr(sb + fb_off + (ks * 32 + 4) * SG_PBK + nb * 32);
                        bfr[nb] = (bf16x8){lo[0], lo[1], lo[2], lo[3], hi[0], hi[1], hi[2], hi[3]};
                    }
                }
#pragma unroll
                for (int mg = 0; mg < MB; mg += 4) {
                    bf16x8 af[4];
#pragma unroll
                    for (int mb = 0; mb < 4; ++mb) af[mb] = *(const LAS bf16x8*)(uintptr_t)(sa + fa_off + (mg + mb) * 16 * SG_PA + ks * 64);
#pragma unroll
                    for (int mb = 0; mb < 4; ++mb)
#pragma unroll
                        for (int nb = 0; nb < 4; ++nb) acc[mg + mb][nb] = __builtin_amdgcn_mfma_f32_16x16x32_bf16(bfr[nb], af[mb], acc[mg + mb][nb], 0, 0, 0);
                    if (MB > 4) __builtin_amdgcn_sched_barrier(0);
                }
                if (MB > 4) __builtin_amdgcn_sched_barrier(0);
            }
            if constexpr (SG_EPI_FIRST && MT == 128) {
                if (kt + 1 < nk) { SGS_LWRITE(st ^ 1); __syncthreads(); ++g; }
            } else {
                if (kt + 1 < nk || hn) SGS_LWRITE(st ^ 1);
                __syncthreads(); ++g;
            }
        }
        cur.epi(acc, wr, wc, fr, fq);
        if constexpr (SG_EPI_FIRST && MT == 128) { if (hn) SGS_LWRITE((g & 1) ^ 1); __syncthreads(); ++g; }
        cur = nxt;
    }
#undef SGS_GLOAD
#undef SGS_LWRITE
}
namespace tg {
constexpr int BK = 64, HALF = 128, HTB = HALF * BK * 2, STAGE_BYTES = 8 * HTB;
static_assert(STAGE_BYTES + 16384 <= LDS_SCRATCH, "tgemm LDS");
__device__ __forceinline__ int lds_byte(int r, int c) { const int st = (r >> 4) * 2 + (c >> 5), rr = r & 15, cc = c & 31, ob = rr * 64 + cc * 2; return st * 1024 + (ob ^ (((ob >> 9) & 1) << 5)); }
__device__ __forceinline__ void stage_rc(int b, int& R, int& C) { const int st = b / 1024, sb = b % 1024, swz = sb ^ (((sb >> 9) & 1) << 5); R = (st >> 1) * 16 + swz / 64; C = (st & 1) * 32 + (swz % 64) / 2; }

struct TUnit { const char* a; const char* b; int i0, i1, i2, i3; };

template <bool GATHER, class Sched, class Epi>
__device__ __forceinline__ void tgemm_phase(LAS unsigned char* lds, const int tid_in, const int lda, const int ldb, const int K, const Sched& S, const Epi& E) {
    int tid = tid_in; asm volatile("" : "+v"(tid));
    const int wid = __builtin_amdgcn_readfirstlane(tid >> 6), lane = tid & 63, wr = wid >> 2, wc = wid & 3, fr = lane & 15, fq = lane >> 4;
    const int nt = K / BK;
    unsigned vB[2]; { int R0, C0, R1, C1; stage_rc(tid * 16, R0, C0); stage_rc(tid * 16 + 8192, R1, C1); vB[0] = (unsigned)(R0 * ldb + C0) * 2u; vB[1] = (unsigned)(R1 * ldb + C1) * 2u; }
    const unsigned hstepB = (unsigned)HALF * (unsigned)ldb * 2u;
    unsigned vA[2][2];
    LAS u32x2* const park = (LAS u32x2*)(lds + STAGE_BYTES) + tid * 4;
    const size_t kstep = (size_t)(BK * 2);
    const unsigned ldsw = (unsigned)wid * 1024u;
    const int aoff = lds_byte(wr * 64 + fr, fq * 8), boff = lds_byte(wc * 32 + fr, fq * 8);
#define TG_SA(b, h) (((b) * 2 + (h)) * HTB)
#define TG_SB(b, h) ((4 + (b) * 2 + (h)) * HTB)
#define TG_STAGE2(bufoff, gbase, o0, o1) do { \
        __builtin_amdgcn_global_load_lds((const unsigned*)((const char*)(gbase) + (o0)), (LAS unsigned*)(lds + (bufoff) + ldsw), 16, 0, 0); \
        __builtin_amdgcn_global_load_lds((const unsigned*)((const char*)(gbase) + (o1)), (LAS unsigned*)(lds + (bufoff) + ldsw + 8192), 16, 0, 0); } while (0)
#define TG_STAGE_B(bufoff, gbase, h) TG_STAGE2(bufoff, (gbase) + (size_t)(h) * hstepB, vB[0], vB[1])
#define TG_STAGE_A(bufoff, gbase, h, nx) do { if constexpr (GATHER) { const u32x2 q_ = park[((nx) ? 2 : 0) + (h)]; TG_STAGE2(bufoff, gbase, q_.x, q_.y); } else TG_STAGE2(bufoff, gbase, vA[h][0], vA[h][1]); } while (0)
#define TG_LDA(dst, b, h) do { _Pragma("unroll") for (int m = 0; m < 4; ++m) _Pragma("unroll") for (int k = 0; k < 2; ++k) dst[m][k] = *(const LAS bf16x8*)(lds + TG_SA(b, h) + aoff + m * 2048 + k * 1024); } while (0)
#define TG_LDB(dst, b, h) do { _Pragma("unroll") for (int n = 0; n < 2; ++n) _Pragma("unroll") for (int k = 0; k < 2; ++k) dst[n][k] = *(const LAS bf16x8*)(lds + TG_SB(b, h) + boff + n * 2048 + k * 1024); } while (0)
#define TG_MMA(ai, bj, At, Bt) do { __builtin_amdgcn_s_setprio(1); _Pragma("unroll") for (int m = 0; m < 4; ++m) _Pragma("unroll") for (int n = 0; n < 2; ++n) _Pragma("unroll") for (int k = 0; k < 2; ++k) \
        acc[ai][bj][m][n] = __builtin_amdgcn_mfma_f32_16x16x32_bf16(Bt[n][k], At[m][k], acc[ai][bj][m][n], 0, 0, 0); __builtin_amdgcn_s_setprio(0); } while (0)
#define TG_WAIT_V(n) asm volatile("s_waitcnt vmcnt(" #n ")" ::: "memory")
#define TG_WAIT_L(n) asm volatile("s_waitcnt lgkmcnt(" #n ")" ::: "memory")
#define TG_BAR __builtin_amdgcn_s_barrier()
#define TG_SCHED __builtin_amdgcn_sched_barrier(0)
#define TG_SETOFF(dst, u) do { int tz_ = tid_in; asm volatile("" : "+v"(tz_)); int r0_, c0_, r1_, c1_; stage_rc(tz_ * 16, r0_, c0_); stage_rc(tz_ * 16 + 8192, r1_, c1_); \
        _Pragma("unroll") for (int h = 0; h < 2; ++h) { \
        if constexpr (GATHER) { dst[h][0] = (unsigned)(S.arow(u, h * HALF + r0_) * lda + c0_) * 2u; dst[h][1] = (unsigned)(S.arow(u, h * HALF + r1_) * lda + c1_) * 2u; } \
        else { dst[h][0] = (unsigned)((h * HALF + r0_) * lda + c0_) * 2u; dst[h][1] = (unsigned)((h * HALF + r1_) * lda + c1_) * 2u; } } } while (0)
    TUnit cur, nxt; int ui = 0;
    if (!S.next(0, cur)) return;
    f32x4 acc[2][2][4][2];
#pragma unroll
    for (int a = 0; a < 2; ++a)
#pragma unroll
        for (int b = 0; b < 2; ++b)
#pragma unroll
            for (int m = 0; m < 4; ++m)
#pragma unroll
                for (int n = 0; n < 2; ++n) acc[a][b][m][n] = (f32x4){0.f, 0.f, 0.f, 0.f};
    bf16x8 At[4][2], B0[2][2], B1[2][2];
    const char* cA = cur.a; const char* cB = cur.b;
    TG_SETOFF(vA, cur);
    if constexpr (GATHER) { park[0] = (u32x2){vA[0][0], vA[0][1]}; park[1] = (u32x2){vA[1][0], vA[1][1]}; }
    TG_STAGE_B(TG_SB(0, 0), cB, 0); TG_STAGE_B(TG_SB(0, 1), cB, 1); TG_STAGE_A(TG_SA(0, 0), cA, 0, false); TG_STAGE_A(TG_SA(0, 1), cA, 1, false);
    if (wr == 1) TG_BAR;
    TG_WAIT_V(2); TG_BAR;
    TG_STAGE_B(TG_SB(1, 0), cB + kstep, 0); TG_STAGE_A(TG_SA(1, 0), cA + kstep, 0, false); TG_STAGE_B(TG_SB(1, 1), cB + kstep, 1);
    TG_WAIT_V(6); TG_BAR;
    for (;;) {
        const bool has_next = S.next(ui + 1, nxt);
        const char* nA = has_next ? nxt.a : cA; const char* nB = has_next ? nxt.b : cB;
        if constexpr (GATHER) { if (has_next) { unsigned q[2][2]; TG_SETOFF(q, nxt); park[2] = (u32x2){q[0][0], q[0][1]}; park[3] = (u32x2){q[1][0], q[1][1]}; } else { park[2] = park[0]; park[3] = park[1]; } }
        for (int t = 0; t < nt; t += 2) {
            const bool last = (t == nt - 2);
            const char* a1 = cA + (size_t)(t + 1) * kstep;
            const char* a2 = last ? nA : cA + (size_t)(t + 2) * kstep; const char* b2 = last ? nB : cB + (size_t)(t + 2) * kstep;
            const char* a3 = a2 + kstep; const char* b3 = b2 + kstep;
            TG_LDB(B0, 0, 0); TG_LDB(B1, 0, 1); TG_SCHED; TG_LDA(At, 0, 0); TG_STAGE_A(TG_SA(1, 1), a1, 1, false);
            TG_WAIT_V(8); TG_WAIT_L(0); TG_BAR; TG_MMA(0, 0, At, B0); TG_MMA(0, 1, At, B1); TG_BAR; TG_SCHED;
            TG_LDA(At, 0, 1); TG_STAGE_B(TG_SB(0, 0), b2, 0); TG_STAGE_B(TG_SB(0, 1), b2, 1); TG_STAGE_A(TG_SA(0, 0), a2, 0, last);
            TG_WAIT_V(8); TG_WAIT_L(0); TG_BAR; TG_MMA(1, 0, At, B0); TG_MMA(1, 1, At, B1); TG_BAR; TG_SCHED;
            TG_LDB(B0, 1, 0); TG_LDB(B1, 1, 1); TG_SCHED; TG_LDA(At, 1, 0); TG_STAGE_A(TG_SA(0, 1), a2, 1, last);
            TG_WAIT_V(8); TG_WAIT_L(0); TG_BAR; TG_MMA(0, 0, At, B0); TG_MMA(0, 1, At, B1); TG_BAR; TG_SCHED;
            TG_LDA(At, 1, 1); TG_STAGE_B(TG_SB(1, 0), b3, 0); TG_STAGE_B(TG_SB(1, 1), b3, 1); TG_STAGE_A(TG_SA(1, 0), a3, 0, last);
            TG_WAIT_V(8); TG_WAIT_L(0); TG_BAR; TG_MMA(1, 0, At, B0); TG_MMA(1, 1, At, B1); TG_BAR; TG_SCHED;
        }
        if (wr == 0) TG_BAR;
        E(acc, cur, wr, wc, fr, fq);
        if (!has_next) break;
#pragma unroll
        for (int a = 0; a < 2; ++a)
#pragma unroll
            for (int b = 0; b < 2; ++b)
#pragma unroll
                for (int m = 0; m < 4; ++m)
#pragma unroll
                    for (int n = 0; n < 2; ++n) acc[a][b][m][n] = (f32x4){0.f, 0.f, 0.f, 0.f};
        cur = nxt; cA = nA; cB = nB; ++ui;
        if constexpr (GATHER) { park[0] = park[2]; park[1] = park[3]; }
        if (wr == 1) TG_BAR;
    }
    TG_WAIT_V(0);
    TG_BAR;
#undef TG_SA
#undef TG_SB
#undef TG_STAGE2
#undef TG_STAGE_B
#undef TG_STAGE_A
#undef TG_LDA
#undef TG_LDB
#undef TG_MMA
#undef TG_WAIT_V
#undef TG_WAIT_L
#undef TG_BAR
#undef TG_SCHED
#undef TG_SETOFF
}
}
struct Args { const float* in[34]; float* out; unsigned char* ws; int ph_lo, ph_hi, flip, pad; };
struct Frame {
    LAS unsigned char* lds;
    unsigned char* ws;
    int tid, lane, wave, vcu, G, gw, NGW, flip;
};
enum { I_X = 0, I_C, I_CTX, I_CCTX, I_MODW, I_MODB, I_LNG, I_LNB, I_WQKV, I_WO, I_LAM, I_SUBLN, I_POOLW, I_POOLS, I_FW, I_FB,
       I_HWIN, I_HBIN, I_HCW, I_HCB, I_HF1, I_HFB1, I_HF2, I_HFB2, I_HF3, I_HFREQ, I_HSKIP, I_HWO, I_HBO, I_RW, I_RB, I_WG, I_WU, I_WD };

#ifndef CONV_NT
#define CONV_NT 0
#endif
template <bool NT> __device__ __forceinline__ void transpose_load64(f32x4 (&v)[16], const float* W, int ldw, int k0, int n0, int lane) {
    const int kq = lane >> 4, c4 = (lane & 15) * 4;
#pragma unroll
    for (int i = 0; i < 16; ++i) { const f32x4* p = (const f32x4*)(W + (size_t)(k0 + 4 * i + kq) * ldw + n0 + c4); if constexpr (NT) v[i] = __builtin_nontemporal_load(p); else v[i] = *p; }
}
__device__ __forceinline__ void transpose_finish64(const f32x4 (&v)[16], int k0, bf16* WT, int ldo, int out_row0, int out_row1, LAS float* scr, int lane);
__device__ __forceinline__ void transpose_item64(const float* W, int ldw, int k0, int n0, bf16* WT, int ldo, int out_row0, int out_row1, LAS float* scr, int lane) {
    f32x4 v[16];
    transpose_load64<false>(v, W, ldw, k0, n0, lane);
    transpose_finish64(v, k0, WT, ldo, out_row0, out_row1, scr, lane);
}
__device__ __forceinline__ void transpose_finish64(const f32x4 (&v)[16], int k0, bf16* WT, int ldo, int out_row0, int out_row1, LAS float* scr, int lane) {
    const int kq = lane >> 4, c4 = (lane & 15) * 4;
#pragma unroll
    for (int i = 0; i < 16; ++i) { const int kk = 4 * i + kq; scr[(c4 + 0) * 65 + kk] = v[i].x; scr[(c4 + 1) * 65 + kk] = v[i].y; scr[(c4 + 2) * 65 + kk] = v[i].z; scr[(c4 + 3) * 65 + kk] = v[i].w; }
    LDS_WAIT(); asm volatile("" ::: "memory");
    const int c = lane & 7;
#pragma unroll
    for (int j = 0; j < 8; ++j) { const int n = (lane >> 3) + 8 * j; const LAS float* s_ = scr + n * 65 + 8 * c;
        u32x4 o; o.x = pk2(s_[0], s_[1]); o.y = pk2(s_[2], s_[3]); o.z = pk2(s_[4], s_[5]); o.w = pk2(s_[6], s_[7]);
        const int orow = n < 32 ? out_row0 + n : out_row1 + (n - 32);
        *(u32x4*)(WT + (size_t)orow * ldo + k0 + 8 * c) = o; }
    LDS_WAIT(); asm volatile("" ::: "memory");
}
__device__ __forceinline__ void transpose_matrix(const Frame& F, const float* W, int K, int N, bf16* WT) {
    LAS float* scr = (LAS float*)(F.lds + F.wave * 16640);
    const int nblk = N / 64, items = (K / 64) * nblk;
    for (int it = F.gw; it < items; it += F.NGW) { const int kb = it / nblk, nb = it % nblk; transpose_item64(W, N, kb * 64, nb * 64, WT, K, nb * 64, nb * 64 + 32, scr, F.lane); }
}
struct CvtCtx { const float* wg; const float* wu; const float* wd; bf16* WGU; bf16* WDt; LAS float* scr; int layer, w0, nw, lane; };
__device__ __forceinline__ void cvt_load(const CvtCtx& c, int it, f32x4 (&v)[16]) {
    constexpr int PER = 256;
    const int e = it / (c.nw * PER), r = it % (c.nw * PER), which = c.w0 + r / PER, q = r % PER, kb = q / 16, n0 = (q % 16) * 64;
    const float* base = which == 0 ? c.wg : (which == 1 ? c.wu : c.wd);
    transpose_load64<CONV_NT != 0>(v, base + ((size_t)c.layer * 16 + e) * 1024 * 1024, 1024, kb * 64, n0, c.lane);
}
__device__ __forceinline__ void cvt_finish(const CvtCtx& c, int it, const f32x4 (&v)[16]) {
    constexpr int PER = 256;
    const int e = it / (c.nw * PER), r = it % (c.nw * PER), which = c.w0 + r / PER, q = r % PER, kb = q / 16, n0 = (q % 16) * 64;
    if (which < 2) { const int rb = (n0 >> 7) * 256 + (n0 & 127) + which * 128; transpose_finish64(v, kb * 64, c.WGU + (size_t)e * 2048 * 1024, 1024, rb, rb + 32, c.scr, c.lane); }
    else transpose_finish64(v, kb * 64, c.WDt + (size_t)e * 1024 * 1024, 1024, n0, n0 + 32, c.scr, c.lane);
}
__device__ __forceinline__ void convert_moe_part(const Frame& F, const float* wg, const float* wu, const float* wd, int layer, int part, int pi, int np) {
    CvtCtx c{wg, wu, wd, (bf16*)(F.ws + WS_WGU), (bf16*)(F.ws + WS_WD), (LAS float*)(F.lds + F.wave * 16640), layer, part == 1 ? 2 : 0, part == 2 ? 3 : (part == 0 ? 2 : 1), F.lane};
    const int items = 16 * c.nw * 256, step = np * NWAVES;
    int it = pi * NWAVES + F.wave;
    if (it >= items) return;
    f32x4 va[16], vb[16];
    cvt_load(c, it, va);
    for (;;) {
        const int i1 = it + step;
        if (i1 < items) cvt_load(c, i1, vb);
        cvt_finish(c, it, va);
        if (i1 >= items) break;
        const int i2 = i1 + step;
        if (i2 < items) cvt_load(c, i2, va);
        cvt_finish(c, i1, vb);
        if (i2 >= items) break;
        it = i2;
    }
}
__device__ __forceinline__ void convert_moe_layer(const Frame& F, const float* wg, const float* wu, const float* wd, int layer) { convert_moe_part(F, wg, wu, wd, layer, 2, F.vcu, F.G); }
__device__ __forceinline__ void mod_gemv(const Frame& F, const float* c, const float* cctx, const float* mw, const float* mb) {
    LAS float* sv = (LAS float*)(F.lds + 73728);
    LAS float* red = (LAS float*)(F.lds + 73728 + 20480);
    float* MODV = (float*)(F.ws + WS_MODV);
    for (int i = F.tid; i < 5 * 1024; i += NTHR) { const int v = i >> 10, k = i & 1023; const float x = v < 4 ? c[v * 1024 + k] : cctx[k]; sv[i] = fsilu(x); }
    __syncthreads();
    constexpr int CW = 96, NCH = 6144 / CW;
    for (int it = F.vcu; it < 4 * NCH; it += F.G) {
        const int layer = it / NCH, cc = it % NCH, rs = F.lane / 24, cl = F.lane - rs * 24; const bool act = F.lane < 48;
        const float* Wp = mw + (size_t)layer * 1024 * 6144 + cc * CW + cl * 4;
        f32x4 a[5];
#pragma unroll
        for (int v = 0; v < 5; ++v) a[v] = (f32x4){0.f, 0.f, 0.f, 0.f};
        const int k0 = F.wave * 128 + rs;
        for (int kb = 0; kb < 128; kb += 32) {
            f32x4 w[16];
#pragma unroll
            for (int j = 0; j < 16; ++j) w[j] = act ? *(const f32x4*)(Wp + (size_t)(k0 + kb + 2 * j) * 6144) : (f32x4){0.f, 0.f, 0.f, 0.f};
#pragma unroll
            for (int j = 0; j < 16; ++j)
#pragma unroll
                for (int v = 0; v < 5; ++v) a[v] += w[j] * sv[v * 1024 + (act ? k0 + kb + 2 * j : 0)];
        }
        if (act) {
#pragma unroll
            for (int v = 0; v < 5; ++v) *(LAS f32x4*)(red + ((F.wave * 2 + rs) * 5 + v) * CW + cl * 4) = a[v];
        }
        __syncthreads();
        for (int o = F.tid; o < 5 * CW; o += NTHR) { const int v = o / CW, n = o - v * CW; float s = mb[layer * 6144 + cc * CW + n];
#pragma unroll
            for (int w = 0; w < 16; ++w) s += red[(w * 5 + v) * CW + n];
            MODV[((size_t)layer * 5 + v) * 6144 + cc * CW + n] = s; }
        __syncthreads();
    }
}
__device__ __forceinline__ int row_f(int R) { return (R >> 5) * 16 + (R & 15); }
__device__ __forceinline__ int row_part(int R) { return (R >> 4) & 1; }
__device__ __forceinline__ void tables(const Frame& F) {
    const int gt = F.vcu * NTHR + F.tid, NGT = F.G * NTHR;
    float* rope = (float*)(F.ws + WS_ROPE);
    for (int i = gt; i < 192 * 16; i += NGT) {
        const int pos = i >> 4, fi = i & 15; const float inv = __expf(-(float)fi * (1.0f / 16.0f) * 9.210340371976184f);
        const int p = pos < 128 ? pos : pos - 128; const float rev = (float)p * inv * 0.15915494309189535f;
        float* base = rope + (pos < 128 ? 0 : 4096);
        base[p * 16 + fi] = fcos_rev(rev); base[(pos < 128 ? 2048 : 1024) + p * 16 + fi] = fsin_rev(rev);
    }
    bf16* f1 = (bf16*)(F.ws + DFT_F1);
    for (int i = gt; i < 128 * 64; i += NGT) { const int R = i >> 6, l1 = i & 63, f = row_f(R), pt = row_part(R); const float rev = (float)((f * l1) & 63) * (1.f / 64.f);
        f1[i] = (bf16)(pk2(pt ? -fsin_rev(rev) : fcos_rev(rev), 0.f) & 0xffff); }
    bf16* c256 = (bf16*)(F.ws + DFT_C256); bf16* h2b = (bf16*)(F.ws + DFT_H2B);
    for (int i = gt; i < 256 * 256; i += NGT) { const int R = i >> 8, k = i & 255, f = row_f(R), pt = row_part(R), l = k & 127, kp = k >> 7;
        const float rev = (float)((f * l) & 127) * (1.f / 128.f), cs = fcos_rev(rev), sn = fsin_rev(rev);
        const float v1 = pt == 0 ? (kp == 0 ? cs : sn) : (kp == 0 ? -sn : cs);
        const float v2 = pt == 0 ? (kp == 0 ? cs : -sn) : (kp == 0 ? sn : cs);
        c256[i] = (bf16)(pk2(v1, 0.f) & 0xffff); h2b[i] = (bf16)(pk2(v2, 0.f) & 0xffff); }
    bf16* k1 = (bf16*)(F.ws + DFT_K1); bf16* h1 = (bf16*)(F.ws + DFT_H1);
    for (int i = gt; i < 256 * 128; i += NGT) { const int R = i >> 7, k = i & 127, f = row_f(R), pt = row_part(R);
        { const float rev = (float)((f * k) & 127) * (1.f / 128.f); k1[i] = (bf16)(pk2(pt ? -fsin_rev(rev) : fcos_rev(rev), 0.f) & 0xffff); }
        { const int s1 = k & 63, kp = k >> 6; const float rev = (float)((f * s1) & 127) * (1.f / 128.f), cs = fcos_rev(rev), sn = fsin_rev(rev);
          const float v = pt == 0 ? (kp == 0 ? cs : sn) : (kp == 0 ? -sn : cs); h1[i] = (bf16)(pk2(v, 0.f) & 0xffff); } }
    bf16* h3 = (bf16*)(F.ws + DFT_H3);
    for (int i = gt; i < 128 * 256; i += NGT) { const int R = i >> 8, k = i & 255, t1 = row_f(R), pt = row_part(R), f1i = k & 127, kp = k >> 7;
        const float rev = (float)((t1 * f1i) & 127) * (1.f / 128.f), cs = fcos_rev(rev), sn = fsin_rev(rev);
        const float v = pt == 0 ? (kp == 0 ? cs : -sn) : (kp == 0 ? sn : cs); h3[i] = (bf16)(pk2(v, 0.f) & 0xffff); }
    bf16* trig = (bf16*)(F.ws + WS_TRIG); const float fsc = 1.0f / sqrtf(8192.0f * 256.0f);
    for (int i = gt; i < 2 * 256 * 256; i += NGT) { const int tg_ = i >> 16, k = (i >> 8) & 255, c = i & 255; const float rev = (float)((k * c) & 255) * (1.f / 256.f);
        trig[i] = (bf16)(pk2(fsc * (tg_ ? fsin_rev(rev) : fcos_rev(rev)), 0.f) & 0xffff); }
    f32x2* twf = (f32x2*)(F.ws + WS_TWF);
    for (int i = gt; i < 64 * 128; i += NGT) { const int a = i >> 7, b = i & 127; const float rev = (float)((a * b) & 8191) * (1.f / 8192.f); twf[i] = (f32x2){fcos_rev(rev), fsin_rev(rev)}; }
    f32x2* twh = (f32x2*)(F.ws + WS_TWH);
    for (int i = gt; i < 128 * 128; i += NGT) { const int a = i >> 7, b = i & 127; const float rev = (float)((a * b) & 16383) * (1.f / 16384.f); twh[i] = (f32x2){fcos_rev(rev), fsin_rev(rev)}; }
}
__device__ __forceinline__ void router_tables(const Frame& F, const float* rw) {
    bf16* RWT = (bf16*)(F.ws + WS_RWT); const int gt = F.vcu * NTHR + F.tid, NGT = F.G * NTHR;
    for (int idx = gt; idx < 1024 * 16; idx += NGT) { const int c = idx >> 4, e = idx & 15; const float w = rw[idx];
        const unsigned hi = pk2(w, 0.f) & 0xffffu; const float lo = w - __uint_as_float(hi << 16);
        RWT[e * 1024 + c] = (bf16)hi; RWT[16 * 1024 + e * 1024 + c] = (bf16)(pk2(lo, 0.f) & 0xffffu); }
}
__device__ __forceinline__ void fourier_w_copy(const Frame& F, const float* w) {
    bf16* WFB = (bf16*)(F.ws + WS_WFB); const int gt = F.vcu * NTHR + F.tid, NGT = F.G * NTHR;
    for (int i = gt; i < 1024 * 1024 / 8; i += NGT) { const f32x4 a = *(const f32x4*)(w + (size_t)i * 8), b2 = *(const f32x4*)(w + (size_t)i * 8 + 4);
        *(u32x4*)(WFB + (size_t)i * 8) = (u32x4){pk2(a.x, a.y), pk2(a.z, a.w), pk2(b2.x, b2.y), pk2(b2.z, b2.w)}; }
}
__device__ __forceinline__ void hyena_a2(const Frame& F, const float* f1, const float* fb1, const float* f2, const float* fb2, const float* freq) {
    float* A2 = (float*)(F.ws + WS_A2);
    LAS float* sc = (LAS float*)(F.lds + 143360 + F.wave * 512);
    const int j = F.lane; const float fr = freq[j];
    for (int t = F.gw; t < SEQ; t += F.NGW) {
        float zv = 0.f;
        if (j == 0) zv = (float)t * (1.f / 8192.f);
        else if (j < 33) { const int b = (j - 1) & 15; const float band = 1e-4f + (float)b * ((15.0f - 1e-4f) / 15.0f); const float rev = (float)t * band * (1.f / 8192.f);
            const float rr = rev - floorf(rev); zv = j < 17 ? fcos_rev(rr) : fsin_rev(rr); }
        sc[j] = zv; LDS_WAIT(); asm volatile("" ::: "memory");
        float s = fb1[j];
        for (int i = 0; i < 33; ++i) s += sc[i] * f1[i * 64 + j];
        const float a1 = __sinf(fr * s);
        LDS_WAIT(); asm volatile("" ::: "memory");
        sc[64 + j] = a1; LDS_WAIT(); asm volatile("" ::: "memory");
        float s2 = fb2[j];
        for (int i = 0; i < 64; ++i) s2 += sc[64 + i] * f2[i * 64 + j];
        { const float a2v = __sinf(fr * s2); A2[(size_t)t * 64 + j] = a2v; ((bf16*)(F.ws + WS_A2B))[(size_t)t * 64 + j] = (bf16)(pk2(a2v, 0.f) & 0xffff); }
        LDS_WAIT(); asm volatile("" ::: "memory");
    }
}
__device__ __forceinline__ void ld16f(const float* p, float (&v)[16], int lane) {
    const f32x4 a = *(const f32x4*)(p + lane * 8), b = *(const f32x4*)(p + lane * 8 + 4), c = *(const f32x4*)(p + 512 + lane * 8), d = *(const f32x4*)(p + 512 + lane * 8 + 4);
    v[0] = a.x; v[1] = a.y; v[2] = a.z; v[3] = a.w; v[4] = b.x; v[5] = b.y; v[6] = b.z; v[7] = b.w;
    v[8] = c.x; v[9] = c.y; v[10] = c.z; v[11] = c.w; v[12] = d.x; v[13] = d.y; v[14] = d.z; v[15] = d.w;
}
__device__ __forceinline__ void ld16b(const bf16* p, float (&v)[16], int lane) {
    const u32x4 a = *(const u32x4*)(p + lane * 8), c = *(const u32x4*)(p + 512 + lane * 8);
    v[0] = bflo(a.x); v[1] = bfhi(a.x); v[2] = bflo(a.y); v[3] = bfhi(a.y); v[4] = bflo(a.z); v[5] = bfhi(a.z); v[6] = bflo(a.w); v[7] = bfhi(a.w);
    v[8] = bflo(c.x); v[9] = bfhi(c.x); v[10] = bflo(c.y); v[11] = bfhi(c.y); v[12] = bflo(c.z); v[13] = bfhi(c.z); v[14] = bflo(c.w); v[15] = bfhi(c.w);
}
__device__ __forceinline__ void ldraw(const bf16* p, u32x4& a, u32x4& c, int lane) { a = *(const u32x4*)(p + lane * 8); c = *(const u32x4*)(p + 512 + lane * 8); }
__device__ __forceinline__ void unpack16(const u32x4 a, const u32x4 c, float (&v)[16]) {
    v[0] = bflo(a.x); v[1] = bfhi(a.x); v[2] = bflo(a.y); v[3] = bfhi(a.y); v[4] = bflo(a.z); v[5] = bfhi(a.z); v[6] = bflo(a.w); v[7] = bfhi(a.w);
    v[8] = bflo(c.x); v[9] = bfhi(c.x); v[10] = bflo(c.y); v[11] = bfhi(c.y); v[12] = bflo(c.z); v[13] = bfhi(c.z); v[14] = bflo(c.w); v[15] = bfhi(c.w);
}
__device__ __forceinline__ void st16b(bf16* p, const float (&v)[16], int lane) {
    u32x4 a, c; a.x = pk2(v[0], v[1]); a.y = pk2(v[2], v[3]); a.z = pk2(v[4], v[5]); a.w = pk2(v[6], v[7]);
    c.x = pk2(v[8], v[9]); c.y = pk2(v[10], v[11]); c.z = pk2(v[12], v[13]); c.w = pk2(v[14], v[15]);
    *(u32x4*)(p + lane * 8) = a; *(u32x4*)(p + 512 + lane * 8) = c;
}
__device__ __forceinline__ void st16f(float* p, const float (&v)[16], int lane) {
    *(f32x4*)(p + lane * 8) = (f32x4){v[0], v[1], v[2], v[3]}; *(f32x4*)(p + lane * 8 + 4) = (f32x4){v[4], v[5], v[6], v[7]};
    *(f32x4*)(p + 512 + lane * 8) = (f32x4){v[8], v[9], v[10], v[11]}; *(f32x4*)(p + 512 + lane * 8 + 4) = (f32x4){v[12], v[13], v[14], v[15]};
}
__device__ __forceinline__ void modulate0(const Frame& F, const float* x, const float* ctx) {
    const float* MODV = (const float*)(F.ws + WS_MODV); bf16* HA = (bf16*)(F.ws + WS_HA); bf16* XR = (bf16*)(F.ws + WS_XR);
    int m = F.gw; if (m >= MROWS) return;
    float xn[16], sh[16], sc[16]; int vprev = -1;
    ld16f(m < T ? x + (size_t)m * D : ctx + (size_t)(m - T) * D, xn, F.lane);
    for (; m < MROWS; m += F.NGW) {
        float xv[16];
#pragma unroll
        for (int i = 0; i < 16; ++i) xv[i] = xn[i];
        const int mn = m + F.NGW;
        if (mn < MROWS) ld16f(mn < T ? x + (size_t)mn * D : ctx + (size_t)(mn - T) * D, xn, F.lane);
        const int v = m < T ? m / SEQ : 4;
        if (v != vprev) { const float* mv = MODV + (size_t)v * 6144; ld16f(mv, sh, F.lane); ld16f(mv + 1024, sc, F.lane); vprev = v; }
        if (m < T) st16b(XR + (size_t)m * D, xv, F.lane);
#pragma unroll
        for (int i = 0; i < 16; ++i) xv[i] = xv[i] * (1.f + sc[i]) + sh[i];
        st16b(HA + (size_t)m * D, xv, F.lane);
    }
}
__device__ __forceinline__ void ln16(float (&v)[16], const float (&gam)[16], const float (&bet)[16]) {
    float s = 0.f;
#pragma unroll
    for (int i = 0; i < 16; ++i) s += v[i];
    const float mean = wave_sum(s) * (1.f / D); float q = 0.f;
#pragma unroll
    for (int i = 0; i < 16; ++i) { v[i] -= mean; q += v[i] * v[i]; }
    const float rstd = 1.0f / sqrtf(wave_sum(q) * (1.f / D) + LN_EPS);
#pragma unroll
    for (int i = 0; i < 16; ++i) v[i] = v[i] * rstd * gam[i] + bet[i];
}
__device__ __forceinline__ void ln1_route(const Frame& F, int layer, const float* lng, const float* lnb, const float* rb) {
    const float* MODV = (const float*)(F.ws + WS_MODV); bf16* HA = (bf16*)(F.ws + WS_HA); bf16* XR = (bf16*)(F.ws + WS_XR); const bf16* Y = (const bf16*)(F.ws + WS_Y);
    int* TOKE = (int*)(F.ws + WS_TOKE); float* TOKW = (float*)(F.ws + WS_TOKW); int* LIST = (int*)(F.ws + WS_LIST);
    unsigned* CNT = (unsigned*)(F.ws + WS_CTL) + CW_CNT + layer * 16 * 64;
    LAS float* slog = (LAS float*)F.lds;
    LAS int* s_e = (LAS int*)(F.lds + 66560);
    LAS int* s_r = (LAS int*)(F.lds + 66560 + 2048);
    LAS int* s_hist = (LAS int*)(F.lds + 66560 + 4096);
    const int TPB = T / F.G, t0 = (F.flip ? (F.G - 1 - F.vcu) : F.vcu) * TPB;
    if (F.tid < 32) s_hist[F.tid] = 0;
    __syncthreads();
    const int bt = t0 / SEQ; const float* mv = MODV + ((size_t)layer * 5 + bt) * 6144;
    float cy[16], gam[16], bet[16], sc2[16], sh2[16];
    ld16f(mv + 2048, cy, F.lane); ld16f(lng + (size_t)(layer * 2 + 0) * D, gam, F.lane); ld16f(lnb + (size_t)(layer * 2 + 0) * D, bet, F.lane);
    ld16f(mv + 4096, sc2, F.lane); ld16f(mv + 3072, sh2, F.lane);
#pragma unroll
    for (int i = 0; i < 16; ++i) { cy[i] += 1.f; sc2[i] += 1.f; }
    u32x4 pxa, pxc, pya, pyc;
    ldraw(XR + (size_t)(t0 + F.wave) * D, pxa, pxc, F.lane); ldraw(Y + (size_t)(t0 + F.wave) * D, pya, pyc, F.lane);
    for (int r = F.wave; r < TPB; r += NWAVES) {
        const int t = t0 + r; float v[16], y[16];
        unpack16(pxa, pxc, v); unpack16(pya, pyc, y);
        if (r + NWAVES < TPB) { ldraw(XR + (size_t)(t + NWAVES) * D, pxa, pxc, F.lane); ldraw(Y + (size_t)(t + NWAVES) * D, pya, pyc, F.lane); }
#pragma unroll
        for (int i = 0; i < 16; ++i) v[i] = ALPHA * v[i] + cy[i] * y[i];
        ln16(v, gam, bet);
        st16b(XR + (size_t)t * D, v, F.lane);
#pragma unroll
        for (int i = 0; i < 16; ++i) v[i] = v[i] * sc2[i] + sh2[i];
        st16b(HA + (size_t)t * D, v, F.lane);
    }
    asm volatile("s_waitcnt vmcnt(0)" ::: "memory");
    {
        const int fr = F.lane & 15, fq = F.lane >> 4;
        const bf16* ap = HA + (size_t)(t0 + F.wave + NWAVES * fr) * D + fq * 8;
        const bf16* bh = (const bf16*)(F.ws + WS_RWT) + fr * 1024 + fq * 8; const bf16* bl = bh + 16 * 1024;
        f32x4 acc = {0.f, 0.f, 0.f, 0.f};
#pragma unroll 8
        for (int ks = 0; ks < 32; ++ks) {
            const bf16x8 a = *(const bf16x8*)(ap + ks * 32), h = *(const bf16x8*)(bh + ks * 32), l = *(const bf16x8*)(bl + ks * 32);
            acc = __builtin_amdgcn_mfma_f32_16x16x32_bf16(a, h, acc, 0, 0, 0);
            acc = __builtin_amdgcn_mfma_f32_16x16x32_bf16(a, l, acc, 0, 0, 0);
        }
        LAS float* sl = slog + F.wave * 256; const float bias = rb[fr];
        sl[(4 * fq + 0) * 16 + fr] = acc.x + bias; sl[(4 * fq + 1) * 16 + fr] = acc.y + bias; sl[(4 * fq + 2) * 16 + fr] = acc.z + bias; sl[(4 * fq + 3) * 16 + fr] = acc.w + bias;
        LDS_WAIT(); asm volatile("" ::: "memory");
        if (F.lane < 16) {
            const int j = F.lane, r = F.wave + NWAVES * j, t = t0 + r;
            float lg[16];
            { const f32x4 q0_ = *(const LAS f32x4*)(sl + j * 16), q1_ = *(const LAS f32x4*)(sl + j * 16 + 4), q2_ = *(const LAS f32x4*)(sl + j * 16 + 8), q3_ = *(const LAS f32x4*)(sl + j * 16 + 12);
              lg[0] = q0_.x; lg[1] = q0_.y; lg[2] = q0_.z; lg[3] = q0_.w; lg[4] = q1_.x; lg[5] = q1_.y; lg[6] = q1_.z; lg[7] = q1_.w;
              lg[8] = q2_.x; lg[9] = q2_.y; lg[10] = q2_.z; lg[11] = q2_.w; lg[12] = q3_.x; lg[13] = q3_.y; lg[14] = q3_.z; lg[15] = q3_.w; }
            float mx = lg[0];
#pragma unroll
            for (int e = 1; e < 16; ++e) mx = fmaxf(mx, lg[e]);
            float pe[16];
#pragma unroll
            for (int e = 0; e < 16; ++e) pe[e] = __expf(lg[e] - mx);
            float best = -1.f; int bg = 0; float q0 = 0.f, q1 = 0.f, q2 = 0.f, q3 = 0.f;
#pragma unroll
            for (int g = 0; g < 4; ++g) {
                const float a = pe[4 * g], b = pe[4 * g + 1], c = pe[4 * g + 2], d = pe[4 * g + 3];
                const float m1 = fmaxf(fmaxf(a, b), fmaxf(c, d));
                const float m2 = fmaxf(fmaxf(fminf(a, b), fminf(c, d)), fminf(fmaxf(a, b), fmaxf(c, d)));
                const float gs = m1 + m2; const bool better = gs > best;
                best = better ? gs : best; bg = better ? g : bg; q0 = better ? a : q0; q1 = better ? b : q1; q2 = better ? c : q2; q3 = better ? d : q3;
            }
            int i0 = 0; float v0 = q0;
            if (q1 > v0) { v0 = q1; i0 = 1; } if (q2 > v0) { v0 = q2; i0 = 2; } if (q3 > v0) { v0 = q3; i0 = 3; }
            int i1 = -1; float v1 = -1.f;
            if (i0 != 0 && q0 > v1) { v1 = q0; i1 = 0; } if (i0 != 1 && q1 > v1) { v1 = q1; i1 = 1; }
            if (i0 != 2 && q2 > v1) { v1 = q2; i1 = 2; } if (i0 != 3 && q3 > v1) { v1 = q3; i1 = 3; }
            const float inv = 1.0f / (v0 + v1);
            const int e0 = bg * 4 + i0, e1 = bg * 4 + i1;
            TOKE[2 * t] = e0; TOKE[2 * t + 1] = e1; TOKW[2 * t] = v0 * inv; TOKW[2 * t + 1] = v1 * inv;
            s_e[2 * r] = e0; s_e[2 * r + 1] = e1;
            s_r[2 * r] = atomicAdd((int*)&s_hist[e0], 1); s_r[2 * r + 1] = atomicAdd((int*)&s_hist[e1], 1);
        }
    }
    __syncthreads();
    if (F.tid < 16) s_hist[16 + F.tid] = (int)atomicAdd(CNT + F.tid * 64, (unsigned)s_hist[F.tid]);
    __syncthreads();
    for (int i = F.tid; i < 2 * TPB; i += NTHR) { const int e = s_e[i]; const int rk = F.flip ? (s_hist[e] - 1 - s_r[i]) : s_r[i]; LIST[e * T + s_hist[16 + e] + rk] = (t0 + (i >> 1)) * 2 + (i & 1); }
    __syncthreads();
}
__device__ __forceinline__ void ln2_phase(const Frame& F, int layer, const float* lng, const float* lnb, float* out) {
    const float* MODV = (const float*)(F.ws + WS_MODV); bf16* HA = (bf16*)(F.ws + WS_HA); bf16* XR = (bf16*)(F.ws + WS_XR); const bf16* Y2 = (const bf16*)(F.ws + WS_Y2);
    const int TPB = T / F.G, t0 = F.vcu * TPB, bt = t0 / SEQ;
    const float* mv = MODV + ((size_t)layer * 5 + bt) * 6144; const float* mvn = MODV + ((size_t)(layer + 1 < NLAYER ? layer + 1 : layer) * 5 + bt) * 6144;
    float cy[16], gam[16], bet[16], sc1[16], sh1[16];
    ld16f(mv + 5120, cy, F.lane); ld16f(lng + (size_t)(layer * 2 + 1) * D, gam, F.lane); ld16f(lnb + (size_t)(layer * 2 + 1) * D, bet, F.lane);
    ld16f(mvn + 1024, sc1, F.lane); ld16f(mvn, sh1, F.lane);
#pragma unroll
    for (int i = 0; i < 16; ++i) { cy[i] += 1.f; sc1[i] += 1.f; }
    u32x4 pxa, pxc, paa, pac, pba, pbc;
    ldraw(XR + (size_t)(t0 + F.wave) * D, pxa, pxc, F.lane); ldraw(Y2 + (size_t)(2 * (t0 + F.wave)) * D, paa, pac, F.lane); ldraw(Y2 + (size_t)(2 * (t0 + F.wave) + 1) * D, pba, pbc, F.lane);
    for (int r = F.wave; r < TPB; r += NWAVES) {
        const int t = t0 + r; float v[16], ya[16], yb[16];
        unpack16(pxa, pxc, v); unpack16(paa, pac, ya); unpack16(pba, pbc, yb);
        if (r + NWAVES < TPB) { const int tn = t + NWAVES; ldraw(XR + (size_t)tn * D, pxa, pxc, F.lane); ldraw(Y2 + (size_t)(2 * tn) * D, paa, pac, F.lane); ldraw(Y2 + (size_t)(2 * tn + 1) * D, pba, pbc, F.lane); }
#pragma unroll
        for (int i = 0; i < 16; ++i) v[i] = ALPHA * v[i] + cy[i] * (ya[i] + yb[i]);
        ln16(v, gam, bet);
#ifdef MK_DBG4
        if (layer == NLAYER - 1) {
            unsigned hi_ = 0u, ho_ = 0u;
            { float a_[16], b_[16], c_[16]; ld16b(XR + (size_t)t * D, a_, F.lane); ld16b(Y2 + (size_t)(2 * t) * D, b_, F.lane); ld16b(Y2 + (size_t)(2 * t + 1) * D, c_, F.lane);
#pragma unroll
              for (int i = 0; i < 16; ++i) hi_ = hi_ * 0x9E3779B1u + (__float_as_uint(a_[i]) ^ (__float_as_uint(b_[i]) * 3u) ^ (__float_as_uint(c_[i]) * 7u)) * (2u * i + 1u); }
#pragma unroll
            for (int i = 0; i < 16; ++i) ho_ = ho_ * 0x9E3779B1u + __float_as_uint(v[i]) * (2u * i + 1u);
#pragma unroll
            for (int o = 1; o < 64; o <<= 1) { hi_ += __shfl_xor(hi_, o) * 31u; ho_ += __shfl_xor(ho_, o) * 31u; }
            unsigned* HH = (unsigned*)(F.ws + (F.flip ? 11 : 10) * MiB);
            if (F.lane == 0) { HH[2 * t] = hi_; HH[2 * t + 1] = ho_; }
        }
#endif
        if (layer == NLAYER - 1) {
#ifdef MK_DBG_STOP
            st16b(XR + (size_t)t * D, v, F.lane);
#endif
            st16f(out + (size_t)t * D, v, F.lane);
        } else {
            st16b(XR + (size_t)t * D, v, F.lane);
#pragma unroll
            for (int i = 0; i < 16; ++i) v[i] = v[i] * sc1[i] + sh1[i];
            st16b(HA + (size_t)t * D, v, F.lane);
        }
    }
#ifdef MK_READBACK
    if (layer == NLAYER - 1) {
        asm volatile("s_waitcnt vmcnt(0)" ::: "memory");
        const int r_last = F.wave + ((TPB - 1 - F.wave) / NWAVES) * NWAVES;
        const unsigned long long* p0 = (const unsigned long long*)(out + (size_t)(t0 + r_last) * D + F.lane * 8); const unsigned long long* p1 = p0 + 256;
        unsigned long long x = 0;
#pragma unroll
        for (int i = 0; i < 4; ++i) { x ^= __hip_atomic_load(p0 + i, __ATOMIC_RELAXED, __HIP_MEMORY_SCOPE_SYSTEM); x ^= __hip_atomic_load(p1 + i, __ATOMIC_RELAXED, __HIP_MEMORY_SCOPE_SYSTEM); }
        asm volatile("s_waitcnt vmcnt(0)" :: "v"(x) : "memory");
    }
#endif
}
__device__ __forceinline__ void unpack8(const u32x4 a, float (&f)[8]) { f[0] = bflo(a.x); f[1] = bfhi(a.x); f[2] = bflo(a.y); f[3] = bfhi(a.y); f[4] = bflo(a.z); f[5] = bfhi(a.z); f[6] = bflo(a.w); f[7] = bfhi(a.w); }
__device__ __forceinline__ void pool_pre(const Frame& F) {
    const bf16* HA = (const bf16*)(F.ws + WS_HA); bf16* PO = (bf16*)(F.ws + WS_POOLED);
    const int hw0 = F.lane < 32 ? 1 : 2, hw1 = F.lane < 32 ? 4 : 8;
    const u32x4 z4 = {0u, 0u, 0u, 0u};
    for (int blk = F.gw; blk < T / 16; blk += F.NGW) {
        const int tb = blk * 16, lb = tb % SEQ; const bf16* base = HA + (size_t)(tb - lb) * D;
        float s0[8], s1[8]; int n0 = 0, n1 = 0;
#pragma unroll
        for (int i = 0; i < 8; ++i) { s0[i] = 0.f; s1[i] = 0.f; }
#pragma unroll
        for (int dt = -8; dt < 8; ++dt) {
            const int ll = lb + dt; const bool inb = ll >= 0 && ll < SEQ;
            if (inb && dt >= -hw0 && dt < hw0) { float f[8]; unpack8(*(const u32x4*)(base + (size_t)ll * D + F.lane * 8), f); n0++;
#pragma unroll
                for (int i = 0; i < 8; ++i) s0[i] += f[i]; }
            if (inb && dt >= -hw1 && dt < hw1) { float f[8]; unpack8(*(const u32x4*)(base + (size_t)ll * D + 512 + F.lane * 8), f); n1++;
#pragma unroll
                for (int i = 0; i < 8; ++i) s1[i] += f[i]; }
        }
#define PP_LOAD(l_) do { const int e0_ = (l_) + hw0, v0_ = (l_) - hw0, e1_ = (l_) + hw1, v1_ = (l_) - hw1; \
            c0 = *(const u32x4*)(base + (size_t)(l_) * D + F.lane * 8); c1 = *(const u32x4*)(base + (size_t)(l_) * D + 512 + F.lane * 8); \
            a0 = e0_ < SEQ ? *(const u32x4*)(base + (size_t)e0_ * D + F.lane * 8) : z4; b0 = v0_ >= 0 ? *(const u32x4*)(base + (size_t)v0_ * D + F.lane * 8) : z4; \
            a1 = e1_ < SEQ ? *(const u32x4*)(base + (size_t)e1_ * D + 512 + F.lane * 8) : z4; b1 = v1_ >= 0 ? *(const u32x4*)(base + (size_t)v1_ * D + 512 + F.lane * 8) : z4; } while (0)
        u32x4 c0, c1, a0, b0, a1, b1;
        PP_LOAD(lb);
        for (int r = 0; r < 16; ++r) {
            const int l = lb + r;
            const int e0 = l + hw0, v0 = l - hw0, e1 = l + hw1, v1 = l - hw1;
            float fc0[8], fc1[8], fa0[8], fb0[8], fa1[8], fb1[8], o[16];
            unpack8(c0, fc0); unpack8(c1, fc1); unpack8(a0, fa0); unpack8(b0, fb0); unpack8(a1, fa1); unpack8(b1, fb1);
            if (r + 1 < 16) PP_LOAD(l + 1);
            const float r0 = 1.0f / (float)n0, r1 = 1.0f / (float)n1;
#pragma unroll
            for (int i = 0; i < 8; ++i) { o[i] = s0[i] * r0 - fc0[i]; o[8 + i] = s1[i] * r1 - fc1[i]; }
            st16b(PO + (size_t)(tb + r) * D, o, F.lane);
#pragma unroll
            for (int i = 0; i < 8; ++i) { s0[i] += fa0[i] - fb0[i]; s1[i] += fa1[i] - fb1[i]; }
            n0 += (e0 < SEQ ? 1 : 0) - (v0 >= 0 ? 1 : 0);
            n1 += (e1 < SEQ ? 1 : 0) - (v1 >= 0 ? 1 : 0);
        }
#undef PP_LOAD
    }
}
__device__ __forceinline__ void hyena_conv(const Frame& F, const float* cw, const float* cb) {
    const bf16* Z = (const bf16*)(F.ws + WS_Z); bf16* VP = (bf16*)(F.ws + WS_VP); bf16* X0 = (bf16*)(F.ws + WS_X0);
    for (int task = F.gw; task < (T / 32) * 2; task += F.NGW) {
        const int chunk = task >> 1, half = task & 1, t0 = chunk * 32, l0 = t0 % SEQ, cbase = half * 512 + F.lane * 8;
        float w[3][3][8], bia[3][8];
#pragma unroll
        for (int s = 0; s < 3; ++s) {
#pragma unroll
            for (int tp = 0; tp < 3; ++tp) { const f32x4 a = *(const f32x4*)(cw + tp * 3072 + s * 1024 + cbase), b = *(const f32x4*)(cw + tp * 3072 + s * 1024 + cbase + 4);
                w[s][tp][0] = a.x; w[s][tp][1] = a.y; w[s][tp][2] = a.z; w[s][tp][3] = a.w; w[s][tp][4] = b.x; w[s][tp][5] = b.y; w[s][tp][6] = b.z; w[s][tp][7] = b.w; }
            const f32x4 a = *(const f32x4*)(cb + s * 1024 + cbase), b = *(const f32x4*)(cb + s * 1024 + cbase + 4);
            bia[s][0] = a.x; bia[s][1] = a.y; bia[s][2] = a.z; bia[s][3] = a.w; bia[s][4] = b.x; bia[s][5] = b.y; bia[s][6] = b.z; bia[s][7] = b.w;
        }
        u32x4 prv[3], cur[3], nxt[3], fut[3];
#pragma unroll
        for (int s = 0; s < 3; ++s) {
            prv[s] = l0 > 0 ? *(const u32x4*)(Z + (size_t)(t0 - 1) * 3072 + s * 1024 + cbase) : (u32x4){0u, 0u, 0u, 0u};
            cur[s] = *(const u32x4*)(Z + (size_t)t0 * 3072 + s * 1024 + cbase);
            nxt[s] = (l0 + 1) < SEQ ? *(const u32x4*)(Z + (size_t)(t0 + 1) * 3072 + s * 1024 + cbase) : (u32x4){0u, 0u, 0u, 0u};
        }
        for (int r = 0; r < 32; ++r) {
            const int t = t0 + r; const bool hasf = (l0 + r + 2) < SEQ;
#pragma unroll
            for (int s = 0; s < 3; ++s) fut[s] = hasf ? *(const u32x4*)(Z + (size_t)(t + 2) * 3072 + s * 1024 + cbase) : (u32x4){0u, 0u, 0u, 0u};
            float o[3][8];
#pragma unroll
            for (int s = 0; s < 3; ++s) {
                const unsigned pw[4] = {prv[s].x, prv[s].y, prv[s].z, prv[s].w}, cwd[4] = {cur[s].x, cur[s].y, cur[s].z, cur[s].w}, nw[4] = {nxt[s].x, nxt[s].y, nxt[s].z, nxt[s].w};
#pragma unroll
                for (int i = 0; i < 4; ++i) {
                    o[s][2 * i] = bflo(pw[i]) * w[s][0][2 * i] + bflo(cwd[i]) * w[s][1][2 * i] + bflo(nw[i]) * w[s][2][2 * i] + bia[s][2 * i];
                    o[s][2 * i + 1] = bfhi(pw[i]) * w[s][0][2 * i + 1] + bfhi(cwd[i]) * w[s][1][2 * i + 1] + bfhi(nw[i]) * w[s][2][2 * i + 1] + bia[s][2 * i + 1];
                }
            }
            u32x4 ov, ox;
            ov.x = pk2(o[2][0] * o[1][0], o[2][1] * o[1][1]); ov.y = pk2(o[2][2] * o[1][2], o[2][3] * o[1][3]);
            ov.z = pk2(o[2][4] * o[1][4], o[2][5] * o[1][5]); ov.w = pk2(o[2][6] * o[1][6], o[2][7] * o[1][7]);
            ox.x = pk2(o[0][0], o[0][1]); ox.y = pk2(o[0][2], o[0][3]); ox.z = pk2(o[0][4], o[0][5]); ox.w = pk2(o[0][6], o[0][7]);
            *(u32x4*)(VP + (size_t)t * D + cbase) = ov; *(u32x4*)(X0 + (size_t)t * D + cbase) = ox;
#pragma unroll
            for (int s = 0; s < 3; ++s) { prv[s] = cur[s]; cur[s] = nxt[s]; nxt[s] = fut[s]; }
        }
    }
}
__device__ __forceinline__ void hyena_kfull(const Frame& F, const float* f3) {
    const float* A2 = (const float*)(F.ws + WS_A2); bf16* KF = (bf16*)(F.ws + WS_KFULL);
    const float dlo = -3.0701134573253943f, dhi = -15.350567286626972f;
    for (int n = F.gw; n < 2 * SEQ; n += F.NGW) {
        float o[16];
        if (n == SEQ) {
#pragma unroll
            for (int i = 0; i < 16; ++i) o[i] = 0.f;
        } else {
            const int t = n < SEQ ? n : 2 * SEQ - n, coff = n < SEQ ? 0 : 1024;
            const float a = A2[(size_t)t * 64 + F.lane];
#pragma unroll
            for (int i = 0; i < 16; ++i) o[i] = 0.f;
            for (int j = 0; j < 64; ++j) {
                const float aj = __shfl(a, j); float fv[16];
                ld16f(f3 + (size_t)j * 2048 + coff, fv, F.lane);
#pragma unroll
                for (int i = 0; i < 16; ++i) o[i] += aj * fv[i];
            }
            const float tt = (float)t * (1.f / 8192.f);
#pragma unroll
            for (int i = 0; i < 16; ++i) { const int d = (i < 8 ? 0 : 512) + F.lane * 8 + (i & 7); const float delta = -(dlo + (dhi - dlo) * (float)d * (1.f / 1023.f)); o[i] *= __expf(-tt * delta); }
        }
        st16b(KF + (size_t)n * D, o, F.lane);
    }
}
namespace att {
constexpr int QBLK = 32, KVBLK = 64;
constexpr float SCALE = 0.125f, THR = 8.f;
constexpr int SHM_V = KVBLK * 128 * 2, SHM_K = KVBLK * 64 * 2;
constexpr int NBUF = 3;
constexpr int OFF_V = 0, OFF_K = NBUF * SHM_V, OFF_WS = OFF_K + NBUF * SHM_K, OFF_O0 = OFF_WS + NWAVES * 64 * 4;
constexpr int LDS_NEED = OFF_O0 + NWAVES * 8192;
static_assert(LDS_NEED <= LDS_SCRATCH, "attention LDS");
#define KSWZ64(row, colB) ((row) * 128 + ((colB) ^ (((row) & 7) << 4)))
#define SBAR() __builtin_amdgcn_sched_barrier(0)
__device__ __forceinline__ int crow(int r, int hi) { return (r & 3) + 8 * (r >> 2) + 4 * hi; }
__device__ __forceinline__ unsigned cvtpk(float lo, float hi) { unsigned r; asm volatile("v_cvt_pk_bf16_f32 %0, %1, %2" : "=v"(r) : "v"(lo), "v"(hi)); return r; }

__device__ __forceinline__ void partialSM(f32x16& p0, f32x16& p1, float& m_reg, float& mn, float& alpha) {
    constexpr float C = SCALE * 1.4426950408889634f;
    float pmax = p0[0];
#pragma unroll
    for (int r = 1; r < 16; ++r) pmax = fmaxf(pmax, p0[r]);
#pragma unroll
    for (int r = 0; r < 16; ++r) pmax = fmaxf(pmax, p1[r]);
    { auto rr = __builtin_amdgcn_permlane32_swap(__float_as_uint(pmax), __float_as_uint(pmax), false, false);
      pmax = fmaxf(__uint_as_float(rr[0]), __uint_as_float(rr[1])); }
    if (__builtin_expect(__all(pmax - m_reg <= THR / SCALE), 1)) { mn = m_reg; alpha = 1.f; }
    else { mn = fmaxf(m_reg, pmax); alpha = __builtin_amdgcn_exp2f((m_reg - mn) * C); m_reg = mn; }
    const float mnC = -mn * C;
#pragma unroll
    for (int r = 0; r < 16; ++r) p0[r] = fmaf(p0[r], C, mnC);
#pragma unroll
    for (int r = 0; r < 16; ++r) p1[r] = fmaf(p1[r], C, mnC);
#pragma unroll
    for (int r = 0; r < 16; ++r) p0[r] = __builtin_amdgcn_exp2f(p0[r]);
}
__device__ __forceinline__ void finishSM(f32x16& p0, f32x16& p1, float alpha, float& l_reg, bf16x8& pa0, bf16x8& pa1, bf16x8& pa2, bf16x8& pa3) {
#pragma unroll
    for (int r = 0; r < 16; ++r) p1[r] = __builtin_amdgcn_exp2f(p1[r]);
    float ps = 0;
#pragma unroll
    for (int r = 0; r < 16; ++r) ps += p0[r];
#pragma unroll
    for (int r = 0; r < 16; ++r) ps += p1[r];
    { auto rr = __builtin_amdgcn_permlane32_swap(__float_as_uint(ps), __float_as_uint(ps), false, false);
      ps = __uint_as_float(rr[0]) + __uint_as_float(rr[1]); }
    l_reg = l_reg * alpha + ps;
#define PK4(P, BASE, OUT) do { unsigned a0 = cvtpk(P[BASE + 0], P[BASE + 1]), a1 = cvtpk(P[BASE + 2], P[BASE + 3]);   \
    unsigned b0 = cvtpk(P[BASE + 4], P[BASE + 5]), b1 = cvtpk(P[BASE + 6], P[BASE + 7]);                              \
    auto r0 = __builtin_amdgcn_permlane32_swap(a0, b0, false, false); auto r1 = __builtin_amdgcn_permlane32_swap(a1, b1, false, false); \
    u32x4 w = {r0[0], r1[0], r0[1], r1[1]}; OUT = *reinterpret_cast<bf16x8*>(&w); } while (0)
    PK4(p0, 0, pa0); PK4(p0, 8, pa1); PK4(p1, 0, pa2); PK4(p1, 8, pa3);
#undef PK4
}
__device__ __forceinline__ void qkt(f32x16& p0, f32x16& p1, const LAS unsigned char* Ks, const bf16x8* qr, int r32, int hi) {
    p0 = f32x16{}; p1 = f32x16{};
#pragma unroll
    for (int d0 = 0; d0 < 4; ++d0) { const int cb = (d0 * 16 + hi * 8) * 2;
        const bf16x8 b0 = *(const LAS bf16x8*)(Ks + KSWZ64(r32, cb));
        const bf16x8 b1 = *(const LAS bf16x8*)(Ks + KSWZ64(32 + r32, cb));
        p0 = __builtin_amdgcn_mfma_f32_32x32x16_bf16(b0, qr[d0], p0, 0, 0, 0);
        p1 = __builtin_amdgcn_mfma_f32_32x32x16_bf16(b1, qr[d0], p1, 0, 0, 0); }
}
__device__ __forceinline__ int v_st(int k, int c) { const int kk = (k & ~0xC) | ((k & 4) << 1) | ((k & 8) >> 1); return ((kk >> 3) * 4 + (c >> 5)) * 512 + ((kk & 7) * 32 + (c & 31)) * 2; }
__device__ __forceinline__ int v_rd_base(int lane) { return ((lane & 3) << 3) | (((lane >> 2) & 3) << 6) | (((lane >> 4) & 1) << 5) | (((lane >> 5) & 1) << 8); }
constexpr int v_rd_off(int d0, int ks, int half) { return d0 * 512 + ks * 4096 + half * 2048; }
template <int OFF> __device__ __forceinline__ s16x4 tr_read(int vb) {
    s16x4 r; asm volatile("ds_read_b64_tr_b16 %0, %1 offset:%2" : "=&v"(r) : "v"(vb), "i"(OFF) : "memory"); return r;
}
template <int D0> __device__ __forceinline__ void pv_one(f32x16& od, int vb, bf16x8 pa0, bf16x8 pa1, bf16x8 pa2, bf16x8 pa3) {
    const s16x4 l0 = tr_read<v_rd_off(D0, 0, 0)>(vb), h0 = tr_read<v_rd_off(D0, 0, 1)>(vb), l1 = tr_read<v_rd_off(D0, 1, 0)>(vb), h1 = tr_read<v_rd_off(D0, 1, 1)>(vb);
    const s16x4 l2 = tr_read<v_rd_off(D0, 2, 0)>(vb), h2 = tr_read<v_rd_off(D0, 2, 1)>(vb), l3 = tr_read<v_rd_off(D0, 3, 0)>(vb), h3 = tr_read<v_rd_off(D0, 3, 1)>(vb);
    asm volatile("s_waitcnt lgkmcnt(0)" ::: "memory"); SBAR();
#define PK(L, H) (bf16x8){L[0], L[1], L[2], L[3], H[0], H[1], H[2], H[3]}
    od = __builtin_amdgcn_mfma_f32_32x32x16_bf16(pa0, PK(l0, h0), od, 0, 0, 0);
    od = __builtin_amdgcn_mfma_f32_32x32x16_bf16(pa1, PK(l1, h1), od, 0, 0, 0);
    od = __builtin_amdgcn_mfma_f32_32x32x16_bf16(pa2, PK(l2, h2), od, 0, 0, 0);
    od = __builtin_amdgcn_mfma_f32_32x32x16_bf16(pa3, PK(l3, h3), od, 0, 0, 0);
#undef PK
}
#ifndef ATT_PV_BY_K
#define ATT_PV_BY_K 1
#endif
#ifndef ATT_PV_TIED
#define ATT_PV_TIED 0
#endif
template <int KS> __device__ __forceinline__ void pv_ks(f32x16* o, int vb, bf16x8 pa) {
    const s16x4 l0 = tr_read<v_rd_off(0, KS, 0)>(vb), h0 = tr_read<v_rd_off(0, KS, 1)>(vb), l1 = tr_read<v_rd_off(1, KS, 0)>(vb), h1 = tr_read<v_rd_off(1, KS, 1)>(vb);
    const s16x4 l2 = tr_read<v_rd_off(2, KS, 0)>(vb), h2 = tr_read<v_rd_off(2, KS, 1)>(vb), l3 = tr_read<v_rd_off(3, KS, 0)>(vb), h3 = tr_read<v_rd_off(3, KS, 1)>(vb);
#if ATT_PV_TIED
    s16x4 L0 = l0, H0 = h0, L1 = l1, H1 = h1, L2 = l2, H2 = h2, L3 = l3, H3 = h3;
    asm volatile("s_waitcnt lgkmcnt(0)" : "+v"(L0), "+v"(H0), "+v"(L1), "+v"(H1), "+v"(L2), "+v"(H2), "+v"(L3), "+v"(H3) :: "memory");
#define PK(L, H) (bf16x8){L[0], L[1], L[2], L[3], H[0], H[1], H[2], H[3]}
    o[0] = __builtin_amdgcn_mfma_f32_32x32x16_bf16(pa, PK(L0, H0), o[0], 0, 0, 0);
    o[1] = __builtin_amdgcn_mfma_f32_32x32x16_bf16(pa, PK(L1, H1), o[1], 0, 0, 0);
    o[2] = __builtin_amdgcn_mfma_f32_32x32x16_bf16(pa, PK(L2, H2), o[2], 0, 0, 0);
    o[3] = __builtin_amdgcn_mfma_f32_32x32x16_bf16(pa, PK(L3, H3), o[3], 0, 0, 0);
#undef PK
    return;
#endif
    asm volatile("s_waitcnt lgkmcnt(0)" ::: "memory"); SBAR();
#define PK(L, H) (bf16x8){L[0], L[1], L[2], L[3], H[0], H[1], H[2], H[3]}
    o[0] = __builtin_amdgcn_mfma_f32_32x32x16_bf16(pa, PK(l0, h0), o[0], 0, 0, 0);
    o[1] = __builtin_amdgcn_mfma_f32_32x32x16_bf16(pa, PK(l1, h1), o[1], 0, 0, 0);
    o[2] = __builtin_amdgcn_mfma_f32_32x32x16_bf16(pa, PK(l2, h2), o[2], 0, 0, 0);
    o[3] = __builtin_amdgcn_mfma_f32_32x32x16_bf16(pa, PK(l3, h3), o[3], 0, 0, 0);
#undef PK
}
#ifndef ATT_PV_PREF
#define ATT_PV_PREF 0
#endif
template <int KS> __device__ __forceinline__ void v_read_ks(s16x4 (&v)[8], int vb) {
    v[0] = tr_read<v_rd_off(0, KS, 0)>(vb); v[1] = tr_read<v_rd_off(0, KS, 1)>(vb); v[2] = tr_read<v_rd_off(1, KS, 0)>(vb); v[3] = tr_read<v_rd_off(1, KS, 1)>(vb);
    v[4] = tr_read<v_rd_off(2, KS, 0)>(vb); v[5] = tr_read<v_rd_off(2, KS, 1)>(vb); v[6] = tr_read<v_rd_off(3, KS, 0)>(vb); v[7] = tr_read<v_rd_off(3, KS, 1)>(vb);
}
__device__ __forceinline__ void pv_mma4(f32x16* o, const s16x4 (&v)[8], bf16x8 pa) {
#define PK(L, H) (bf16x8){L[0], L[1], L[2], L[3], H[0], H[1], H[2], H[3]}
    o[0] = __builtin_amdgcn_mfma_f32_32x32x16_bf16(pa, PK(v[0], v[1]), o[0], 0, 0, 0);
    o[1] = __builtin_amdgcn_mfma_f32_32x32x16_bf16(pa, PK(v[2], v[3]), o[1], 0, 0, 0);
    o[2] = __builtin_amdgcn_mfma_f32_32x32x16_bf16(pa, PK(v[4], v[5]), o[2], 0, 0, 0);
    o[3] = __builtin_amdgcn_mfma_f32_32x32x16_bf16(pa, PK(v[6], v[7]), o[3], 0, 0, 0);
#undef PK
}
__device__ __forceinline__ void pv_d0(f32x16* o, int vb, bf16x8 pa0, bf16x8 pa1, bf16x8 pa2, bf16x8 pa3) {
#if ATT_PV_PREF
    s16x4 va[8], vc[8];
    v_read_ks<0>(va, vb); v_read_ks<1>(vc, vb);
    asm volatile("s_waitcnt lgkmcnt(8)" ::: "memory"); SBAR(); pv_mma4(o, va, pa0); SBAR();
    v_read_ks<2>(va, vb); asm volatile("s_waitcnt lgkmcnt(8)" ::: "memory"); SBAR(); pv_mma4(o, vc, pa1); SBAR();
    v_read_ks<3>(vc, vb); asm volatile("s_waitcnt lgkmcnt(8)" ::: "memory"); SBAR(); pv_mma4(o, va, pa2); SBAR();
    asm volatile("s_waitcnt lgkmcnt(0)" ::: "memory"); SBAR(); pv_mma4(o, vc, pa3);
    return;
#endif
#if ATT_PV_BY_K
    pv_ks<0>(o, vb, pa0); pv_ks<1>(o, vb, pa1); pv_ks<2>(o, vb, pa2); pv_ks<3>(o, vb, pa3);
#else
    pv_one<0>(o[0], vb, pa0, pa1, pa2, pa3); pv_one<1>(o[1], vb, pa0, pa1, pa2, pa3); pv_one<2>(o[2], vb, pa0, pa1, pa2, pa3); pv_one<3>(o[3], vb, pa0, pa1, pa2, pa3);
#endif
}

#ifndef ATT_PROBE
#define ATT_PROBE 0
#endif
#if ATT_PROBE == 4
#define ATT_XBAR() __syncthreads()
#else
#define ATT_XBAR() do { } while (0)
#endif
#if ATT_PROBE == 1
#define ATT_PROBE_VALU(P) do { _Pragma("unroll") for (int r_ = 0; r_ < 16; ++r_) { float t0_, t1_; asm volatile("v_exp_f32 %0, %2\n\tv_exp_f32 %1, %2" : "=&v"(t0_), "=&v"(t1_) : "v"(P[r_])); } } while (0)
#else
#define ATT_PROBE_VALU(P) do { } while (0)
#endif
#if ATT_PROBE == 2
#define ATT_PROBE_LDS(vb) do { s16x4 d_[8]; v_read8p<0>(d_, (vb)); v_read8p<1>(d_, (vb)); asm volatile("s_waitcnt lgkmcnt(0)" ::: "memory"); } while (0)
#else
#define ATT_PROBE_LDS(vb) do { } while (0)
#endif
#if ATT_PROBE == 3
#define ATT_PROBE_VALU3 1
#endif
template <int D0> __device__ __forceinline__ void v_read8p(s16x4 (&v)[8], int vb) {
    v[0] = tr_read<v_rd_off(D0, 0, 0)>(vb); v[1] = tr_read<v_rd_off(D0, 0, 1)>(vb); v[2] = tr_read<v_rd_off(D0, 1, 0)>(vb); v[3] = tr_read<v_rd_off(D0, 1, 1)>(vb);
    v[4] = tr_read<v_rd_off(D0, 2, 0)>(vb); v[5] = tr_read<v_rd_off(D0, 2, 1)>(vb); v[6] = tr_read<v_rd_off(D0, 3, 0)>(vb); v[7] = tr_read<v_rd_off(D0, 3, 1)>(vb);
}
template <int PASS>
__device__ __forceinline__ void attn_pass(const bf16* __restrict__ Qb, const bf16* __restrict__ Kh, const bf16* __restrict__ Vh, bf16* __restrict__ Ob,
                                          float lam, const float* __restrict__ subln, float post, LAS unsigned char* lds, const int tid_in) {
    constexpr int LDK = 1024, seq = LK;
    int tid = tid_in; asm volatile("" : "+v"(tid));
    const int wid = tid >> 6, lane = tid & 63, r32 = lane & 31, hi = lane >> 5;
    LAS unsigned char* V_lds = lds + OFF_V; LAS unsigned char* K_lds = lds + OFF_K;
    LAS float* wsl = (LAS float*)(lds + OFF_WS) + wid * 64; LAS float* li_l = wsl; LAS float* al_l = wsl + 32;
    LAS unsigned* park = (LAS unsigned*)(lds + OFF_O0 + wid * 8192);
    float m_reg = -1e30f, l_reg = 0; f32x16 o[4] = {}; bf16x8 qr[4];
    const bf16* Qw = Qb + (size_t)(wid * QBLK + r32) * 1024 + hi * 8;
#pragma unroll
    for (int d0 = 0; d0 < 4; ++d0) qr[d0] = *(const bf16x8*)(Qw + d0 * 16);
    const int sr = tid >> 4, sc = (tid & 15) * 8, vst0 = v_st(sr, sc), vst1 = v_st(32 + sr, sc);
    const int kr = tid >> 3, kc = (tid & 7) * 8, kst = KSWZ64(kr, kc * 2);
    const int vb0 = (int)(uintptr_t)V_lds + v_rd_base(lane);
    struct { bf16x8 vs0, vs1, ks0; } sr_[1];
#define SLOAD(i, k0) do { sr_[i].vs0 = *(const bf16x8*)(&Vh[(size_t)((k0) + sr) * LDK + sc]); sr_[i].vs1 = *(const bf16x8*)(&Vh[(size_t)((k0) + 32 + sr) * LDK + sc]); \
    sr_[i].ks0 = *(const bf16x8*)(&Kh[(size_t)((k0) + kr) * LDK + kc]); } while (0)
#define SWRITE(b, i) do { *(LAS bf16x8*)(V_lds + (b) * SHM_V + vst0) = sr_[i].vs0; *(LAS bf16x8*)(V_lds + (b) * SHM_V + vst1) = sr_[i].vs1; \
    *(LAS bf16x8*)(K_lds + (b) * SHM_K + kst) = sr_[i].ks0; } while (0)
#define SWAIT() asm volatile("s_waitcnt vmcnt(0)" ::: "memory")
#define RESC(a) do { if (__any((a) < 1.f)) { if (hi == 0) al_l[r32] = (a); asm volatile("s_waitcnt lgkmcnt(0)" ::: "memory"); \
    _Pragma("unroll") for (int d = 0; d < 4; ++d) _Pragma("unroll") for (int r = 0; r < 16; ++r) o[d][r] *= al_l[crow(r, hi)]; } } while (0)
    f32x16 pA0, pA1, pB0, pB1; float mnA, mnB, alA, alB; bf16x8 pa0, pa1, pa2, pa3; constexpr int NT = seq / KVBLK;
    SLOAD(0, 0); asm volatile("s_waitcnt vmcnt(0)" ::: "memory"); SWRITE(0, 0); __syncthreads();
    qkt(pA0, pA1, K_lds, qr, r32, hi); partialSM(pA0, pA1, m_reg, mnA, alA);
    SLOAD(0, KVBLK);
    SWAIT(); SWRITE(1, 0); __syncthreads();
    int bc = 1;
#define ATT_STEP(PC0, PC1, MNC, ALC, PP0, PP1, ALP, KNEXT) do { const int bp_ = bc == 0 ? 2 : bc - 1, bn_ = bc == 2 ? 0 : bc + 1; \
        SBAR(); qkt(PC0, PC1, K_lds + bc * SHM_K, qr, r32, hi); \
        finishSM(PP0, PP1, ALP, l_reg, pa0, pa1, pa2, pa3); ATT_PROBE_VALU(PP0); SBAR(); \
        SLOAD(0, (KNEXT)); SBAR(); ATT_PROBE_LDS(vb0 + bp_ * SHM_V); \
        pv_d0(o, vb0 + bp_ * SHM_V, pa0, pa1, pa2, pa3); partialSM(PC0, PC1, m_reg, MNC, ALC); \
        SWAIT(); SWRITE(bn_, 0); \
        RESC(ALC); __syncthreads(); ATT_XBAR(); bc = bn_; } while (0)
    for (int j = 1; j + 1 < NT; j += 2) {
        ATT_STEP(pB0, pB1, mnB, alB, pA0, pA1, alA, (j + 1) * KVBLK);
        ATT_STEP(pA0, pA1, mnA, alA, pB0, pB1, alB, (j + 2) * KVBLK);
    }
#undef ATT_STEP
    {
        const int bp_ = bc == 0 ? 2 : bc - 1;
        SBAR(); qkt(pB0, pB1, K_lds + bc * SHM_K, qr, r32, hi);
        finishSM(pA0, pA1, alA, l_reg, pa0, pa1, pa2, pa3); SBAR();
        pv_d0(o, vb0 + bp_ * SHM_V, pa0, pa1, pa2, pa3); partialSM(pB0, pB1, m_reg, mnB, alB);
        RESC(alB);
        finishSM(pB0, pB1, alB, l_reg, pa0, pa1, pa2, pa3); SBAR();
        pv_d0(o, vb0 + bc * SHM_V, pa0, pa1, pa2, pa3);
    }
    if (hi == 0) li_l[r32] = l_reg; asm volatile("s_waitcnt lgkmcnt(0)" ::: "memory");
    float rli[16];
#pragma unroll
    for (int r = 0; r < 16; ++r) rli[r] = __builtin_amdgcn_rcpf(li_l[crow(r, hi)]);
    if constexpr (PASS == 0) {
#pragma unroll
        for (int d0 = 0; d0 < 4; ++d0)
#pragma unroll
            for (int r = 0; r < 16; r += 2) park[(d0 * 8 + (r >> 1)) * 64 + lane] = cvtpk(o[d0][r] * rli[r], o[d0][r + 1] * rli[r + 1]);
    } else {
        float ss[16];
#pragma unroll
        for (int r = 0; r < 16; r += 2) {
            float s0 = 0.f, s1 = 0.f;
#pragma unroll
            for (int d0 = 0; d0 < 4; ++d0) { const unsigned w = park[(d0 * 8 + (r >> 1)) * 64 + lane];
                const float a = bflo(w) - lam * (o[d0][r] * rli[r]), b = bfhi(w) - lam * (o[d0][r + 1] * rli[r + 1]);
                o[d0][r] = a; o[d0][r + 1] = b; s0 += a * a; s1 += b * b; }
            ss[r] = s0; ss[r + 1] = s1;
        }
#pragma unroll
        for (int r = 0; r < 16; ++r) {
            float s = ss[r];
            s += __shfl_xor(s, 1); s += __shfl_xor(s, 2); s += __shfl_xor(s, 4); s += __shfl_xor(s, 8); s += __shfl_xor(s, 16);
            ss[r] = post * (1.0f / sqrtf(s * (1.f / 128.f) + LN_EPS));
        }
        float sl[4];
#pragma unroll
        for (int d0 = 0; d0 < 4; ++d0) sl[d0] = subln[d0 * 32 + r32];
        bf16* Ow = Ob + (size_t)(wid * QBLK) * 1024;
#pragma unroll
        for (int r = 0; r < 16; ++r) { const int orow = crow(r, hi);
#pragma unroll
            for (int d0 = 0; d0 < 4; ++d0) Ow[(size_t)orow * 1024 + d0 * 32 + r32] = (bf16)(cvtpk(o[d0][r] * ss[r] * sl[d0], 0.f) & 0xffff); }
    }
    __syncthreads();
#undef SLOAD
#undef SWRITE
#undef SWAIT
#undef RESC
}

template <int OFF> __device__ __forceinline__ bf16x8 k_read(int a) { bf16x8 r; asm volatile("ds_read_b128 %0, %1 offset:%2" : "=&v"(r) : "v"(a), "i"(OFF) : "memory"); return r; }
#define LGKM(n) asm volatile("s_waitcnt lgkmcnt(" #n ")" ::: "memory")
#define PPBAR() do { asm volatile("s_waitcnt lgkmcnt(0)" ::: "memory"); __builtin_amdgcn_s_barrier(); asm volatile("" ::: "memory"); } while (0)
template <int D0> __device__ __forceinline__ void v_read8(s16x4 (&v)[8], int vb) {
    v[0] = tr_read<v_rd_off(D0, 0, 0)>(vb); v[1] = tr_read<v_rd_off(D0, 0, 1)>(vb); v[2] = tr_read<v_rd_off(D0, 1, 0)>(vb); v[3] = tr_read<v_rd_off(D0, 1, 1)>(vb);
    v[4] = tr_read<v_rd_off(D0, 2, 0)>(vb); v[5] = tr_read<v_rd_off(D0, 2, 1)>(vb); v[6] = tr_read<v_rd_off(D0, 3, 0)>(vb); v[7] = tr_read<v_rd_off(D0, 3, 1)>(vb);
}
__device__ __forceinline__ void pv4(f32x16& od, const s16x4 (&v)[8], bf16x8 pa0, bf16x8 pa1, bf16x8 pa2, bf16x8 pa3) {
#define PK(L, H) (bf16x8){L[0], L[1], L[2], L[3], H[0], H[1], H[2], H[3]}
    od = __builtin_amdgcn_mfma_f32_32x32x16_bf16(pa0, PK(v[0], v[1]), od, 0, 0, 0);
    od = __builtin_amdgcn_mfma_f32_32x32x16_bf16(pa1, PK(v[2], v[3]), od, 0, 0, 0);
    od = __builtin_amdgcn_mfma_f32_32x32x16_bf16(pa2, PK(v[4], v[5]), od, 0, 0, 0);
    od = __builtin_amdgcn_mfma_f32_32x32x16_bf16(pa3, PK(v[6], v[7]), od, 0, 0, 0);
#undef PK
}
template <int PASS>
__device__ __forceinline__ void attn_pass_pp(const bf16* __restrict__ Qb, const bf16* __restrict__ Kh, const bf16* __restrict__ Vh, bf16* __restrict__ Ob,
                                             float lam, const float* __restrict__ subln, float post, LAS unsigned char* lds, const int tid_in) {
    constexpr int LDK = 1024, seq = LK, NT = seq / KVBLK;
    int tid = tid_in; asm volatile("" : "+v"(tid));
    const int wid = tid >> 6, lane = tid & 63, r32 = lane & 31, hi = lane >> 5;
    const int simd = (int)__builtin_amdgcn_s_getreg((1 << 11) | (4 << 6) | 4);
    LAS int* sm = (LAS int*)(lds + LDS_MISC + 1024);
    if (lane == 0) sm[wid] = simd;
    __syncthreads();
    int rank = 0;
#pragma unroll
    for (int w = 0; w < NWAVES; ++w) rank += (w < wid && sm[w] == simd) ? 1 : 0;
#ifdef ATT_ROLE
    const int grp = __builtin_amdgcn_readfirstlane(ATT_ROLE(wid));
#else
    const int grp = __builtin_amdgcn_readfirstlane(rank & 1);
#endif
    LAS unsigned char* V_lds = lds + OFF_V; LAS unsigned char* K_lds = lds + OFF_K;
    LAS float* wsl = (LAS float*)(lds + OFF_WS) + wid * 64; LAS float* li_l = wsl; LAS float* al_l = wsl + 32;
    LAS unsigned* park = (LAS unsigned*)(lds + OFF_O0 + wid * 8192);
    float m_reg = -1e30f, l_reg = 0; f32x16 o[4] = {}; bf16x8 qr[4];
    const bf16* Qw = Qb + (size_t)(wid * QBLK + r32) * 1024 + hi * 8;
#pragma unroll
    for (int d0 = 0; d0 < 4; ++d0) qr[d0] = *(const bf16x8*)(Qw + d0 * 16);
    const int sr = tid >> 4, sc = (tid & 15) * 8, vst0 = v_st(sr, sc), vst1 = v_st(32 + sr, sc);
    const int kr = tid >> 3, kc = (tid & 7) * 8, kst = KSWZ64(kr, kc * 2);
    const int vb0 = (int)(uintptr_t)V_lds + v_rd_base(lane);
    int kad[4];
#pragma unroll
    for (int d0 = 0; d0 < 4; ++d0) kad[d0] = (int)(uintptr_t)K_lds + KSWZ64(r32, (d0 * 16 + hi * 8) * 2);
    struct { bf16x8 vs0, vs1, ks0; } sr_[1];
#define SLOAD(i, k0) do { sr_[i].vs0 = *(const bf16x8*)(&Vh[(size_t)((k0) + sr) * LDK + sc]); sr_[i].vs1 = *(const bf16x8*)(&Vh[(size_t)((k0) + 32 + sr) * LDK + sc]); \
    sr_[i].ks0 = *(const bf16x8*)(&Kh[(size_t)((k0) + kr) * LDK + kc]); } while (0)
#define SWRITE(b, i) do { *(LAS bf16x8*)(V_lds + (b) * SHM_V + vst0) = sr_[i].vs0; *(LAS bf16x8*)(V_lds + (b) * SHM_V + vst1) = sr_[i].vs1; \
    *(LAS bf16x8*)(K_lds + (b) * SHM_K + kst) = sr_[i].ks0; } while (0)
#define SWAIT() asm volatile("s_waitcnt vmcnt(0)" ::: "memory")
#define RESC(a) do { if (__any((a) < 1.f)) { if (hi == 0) al_l[r32] = (a); asm volatile("s_waitcnt lgkmcnt(0)" ::: "memory"); \
    _Pragma("unroll") for (int d = 0; d < 4; ++d) _Pragma("unroll") for (int r = 0; r < 16; ++r) o[d][r] *= al_l[crow(r, hi)]; } } while (0)
    f32x16 p0, p1; float mn, al; bf16x8 pa0, pa1, pa2, pa3;
#define QKT_ISSUE(kb_) const int kof_ = (kb_) * SHM_K; \
        const bf16x8 ka0 = k_read<0>(kad[0] + kof_), kb0 = k_read<4096>(kad[0] + kof_), ka1 = k_read<0>(kad[1] + kof_), kb1 = k_read<4096>(kad[1] + kof_); \
        const bf16x8 ka2 = k_read<0>(kad[2] + kof_), kb2 = k_read<4096>(kad[2] + kof_), ka3 = k_read<0>(kad[3] + kof_), kb3 = k_read<4096>(kad[3] + kof_)
#define QKT_MMA() do { p0 = f32x16{}; p1 = f32x16{}; \
        p0 = __builtin_amdgcn_mfma_f32_32x32x16_bf16(ka0, qr[0], p0, 0, 0, 0); p1 = __builtin_amdgcn_mfma_f32_32x32x16_bf16(kb0, qr[0], p1, 0, 0, 0); \
        p0 = __builtin_amdgcn_mfma_f32_32x32x16_bf16(ka1, qr[1], p0, 0, 0, 0); p1 = __builtin_amdgcn_mfma_f32_32x32x16_bf16(kb1, qr[1], p1, 0, 0, 0); \
        p0 = __builtin_amdgcn_mfma_f32_32x32x16_bf16(ka2, qr[2], p0, 0, 0, 0); p1 = __builtin_amdgcn_mfma_f32_32x32x16_bf16(kb2, qr[2], p1, 0, 0, 0); \
        p0 = __builtin_amdgcn_mfma_f32_32x32x16_bf16(ka3, qr[3], p0, 0, 0, 0); p1 = __builtin_amdgcn_mfma_f32_32x32x16_bf16(kb3, qr[3], p1, 0, 0, 0); } while (0)
    SLOAD(0, 0); SWAIT(); SWRITE(0, 0); SLOAD(0, KVBLK); __syncthreads();
    if (grp == 1) PPBAR();
    {
        SWAIT(); SWRITE(1, 0); SLOAD(0, 2 * KVBLK);
        QKT_ISSUE(0); LGKM(0); SBAR(); __builtin_amdgcn_s_setprio(1); QKT_MMA(); __builtin_amdgcn_s_setprio(0); SBAR();
    }
    PPBAR();
    int bj = 0;
    for (int j = 0; j + 1 < NT; ++j) {
        partialSM(p0, p1, m_reg, mn, al); RESC(al); finishSM(p0, p1, al, l_reg, pa0, pa1, pa2, pa3);
        PPBAR();
        const int bj1 = bj == 2 ? 0 : bj + 1, bj2 = bj1 == 2 ? 0 : bj1 + 1;
        {
            SWAIT(); SWRITE(bj2, 0);
            { const int tn = j + 3 < NT ? j + 3 : NT - 1; SLOAD(0, tn * KVBLK); }
            SBAR();
            QKT_ISSUE(bj1);
            const int vb = vb0 + bj * SHM_V;
            s16x4 va[8], vc[8];
            v_read8<0>(va, vb);
            LGKM(8); SBAR(); __builtin_amdgcn_s_setprio(1);
            QKT_MMA(); SBAR();
            v_read8<1>(vc, vb); LGKM(8); SBAR(); pv4(o[0], va, pa0, pa1, pa2, pa3); SBAR();
            v_read8<2>(va, vb); LGKM(8); SBAR(); pv4(o[1], vc, pa0, pa1, pa2, pa3); SBAR();
            v_read8<3>(vc, vb); LGKM(8); SBAR(); pv4(o[2], va, pa0, pa1, pa2, pa3); SBAR();
            LGKM(0); SBAR(); pv4(o[3], vc, pa0, pa1, pa2, pa3); __builtin_amdgcn_s_setprio(0); SBAR();
        }
        PPBAR();
        bj = bj1;
    }
    partialSM(p0, p1, m_reg, mn, al); RESC(al); finishSM(p0, p1, al, l_reg, pa0, pa1, pa2, pa3);
    PPBAR();
    {
        const int vb = vb0 + bj * SHM_V; s16x4 va[8], vc[8];
        v_read8<0>(va, vb); v_read8<1>(vc, vb); LGKM(8); SBAR(); pv4(o[0], va, pa0, pa1, pa2, pa3); SBAR();
        v_read8<2>(va, vb); LGKM(8); SBAR(); pv4(o[1], vc, pa0, pa1, pa2, pa3); SBAR();
        v_read8<3>(vc, vb); LGKM(8); SBAR(); pv4(o[2], va, pa0, pa1, pa2, pa3); SBAR();
        LGKM(0); SBAR(); pv4(o[3], vc, pa0, pa1, pa2, pa3); SBAR();
    }
    SWAIT();
    if (grp == 0) PPBAR();
#undef QKT_ISSUE
#undef QKT_MMA
    if (hi == 0) li_l[r32] = l_reg; asm volatile("s_waitcnt lgkmcnt(0)" ::: "memory");
    float rli[16];
#pragma unroll
    for (int r = 0; r < 16; ++r) rli[r] = __builtin_amdgcn_rcpf(li_l[crow(r, hi)]);
    if constexpr (PASS == 0) {
#pragma unroll
        for (int d0 = 0; d0 < 4; ++d0)
#pragma unroll
            for (int r = 0; r < 16; r += 2) park[(d0 * 8 + (r >> 1)) * 64 + lane] = cvtpk(o[d0][r] * rli[r], o[d0][r + 1] * rli[r + 1]);
    } else {
        float ss[16];
#pragma unroll
        for (int r = 0; r < 16; r += 2) {
            float s0 = 0.f, s1 = 0.f;
#pragma unroll
            for (int d0 = 0; d0 < 4; ++d0) { const unsigned w = park[(d0 * 8 + (r >> 1)) * 64 + lane];
                const float a = bflo(w) - lam * (o[d0][r] * rli[r]), b = bfhi(w) - lam * (o[d0][r + 1] * rli[r + 1]);
                o[d0][r] = a; o[d0][r + 1] = b; s0 += a * a; s1 += b * b; }
            ss[r] = s0; ss[r + 1] = s1;
        }
#pragma unroll
        for (int r = 0; r < 16; ++r) {
            float s = ss[r];
            s += __shfl_xor(s, 1); s += __shfl_xor(s, 2); s += __shfl_xor(s, 4); s += __shfl_xor(s, 8); s += __shfl_xor(s, 16);
            ss[r] = post * (1.0f / sqrtf(s * (1.f / 128.f) + LN_EPS));
        }
        float sl[4];
#pragma unroll
        for (int d0 = 0; d0 < 4; ++d0) sl[d0] = subln[d0 * 32 + r32];
        bf16* Ow = Ob + (size_t)(wid * QBLK) * 1024;
#pragma unroll
        for (int r = 0; r < 16; ++r) { const int orow = crow(r, hi);
#pragma unroll
            for (int d0 = 0; d0 < 4; ++d0) Ow[(size_t)orow * 1024 + d0 * 32 + r32] = (bf16)(cvtpk(o[d0][r] * ss[r] * sl[d0], 0.f) & 0xffff); }
    }
    __syncthreads();
#undef SLOAD
#undef SWRITE
#undef SWAIT
#undef RESC
}
template <int PASS>
__device__ __forceinline__ void attn_pass_il(const bf16* __restrict__ Qb, const bf16* __restrict__ Kh, const bf16* __restrict__ Vh, bf16* __restrict__ Ob,
                                          float lam, const float* __restrict__ subln, float post, LAS unsigned char* lds, const int tid_in) {
    constexpr int LDK = 1024, seq = LK;
    int tid = tid_in; asm volatile("" : "+v"(tid));
    const int wid = tid >> 6, lane = tid & 63, r32 = lane & 31, hi = lane >> 5;
    LAS unsigned char* V_lds = lds + OFF_V; LAS unsigned char* K_lds = lds + OFF_K;
    LAS float* wsl = (LAS float*)(lds + OFF_WS) + wid * 64; LAS float* li_l = wsl; LAS float* al_l = wsl + 32;
    LAS unsigned* park = (LAS unsigned*)(lds + OFF_O0 + wid * 8192);
    float m_reg = -1e30f, l_reg = 0; f32x16 o[4] = {}; bf16x8 qr[4];
    const bf16* Qw = Qb + (size_t)(wid * QBLK + r32) * 1024 + hi * 8;
#pragma unroll
    for (int d0 = 0; d0 < 4; ++d0) qr[d0] = *(const bf16x8*)(Qw + d0 * 16);
    const int sr = tid >> 4, sc = (tid & 15) * 8, vst0 = v_st(sr, sc), vst1 = v_st(32 + sr, sc);
    const int kr = tid >> 3, kc = (tid & 7) * 8, kst = KSWZ64(kr, kc * 2);
    const int vb0 = (int)(uintptr_t)V_lds + v_rd_base(lane);
    struct { bf16x8 vs0, vs1, ks0; } sr_[1];
#define SLOAD(i, k0) do { sr_[i].vs0 = *(const bf16x8*)(&Vh[(size_t)((k0) + sr) * LDK + sc]); sr_[i].vs1 = *(const bf16x8*)(&Vh[(size_t)((k0) + 32 + sr) * LDK + sc]); \
    sr_[i].ks0 = *(const bf16x8*)(&Kh[(size_t)((k0) + kr) * LDK + kc]); } while (0)
#define SWRITE(b, i) do { *(LAS bf16x8*)(V_lds + (b) * SHM_V + vst0) = sr_[i].vs0; *(LAS bf16x8*)(V_lds + (b) * SHM_V + vst1) = sr_[i].vs1; \
    *(LAS bf16x8*)(K_lds + (b) * SHM_K + kst) = sr_[i].ks0; } while (0)
#define SWAIT() asm volatile("s_waitcnt vmcnt(0)" ::: "memory")
#define RESC(a) do { if (__any((a) < 1.f)) { if (hi == 0) al_l[r32] = (a); asm volatile("s_waitcnt lgkmcnt(0)" ::: "memory"); \
    _Pragma("unroll") for (int d = 0; d < 4; ++d) _Pragma("unroll") for (int r = 0; r < 16; ++r) o[d][r] *= al_l[crow(r, hi)]; } } while (0)
    f32x16 pA0, pA1, pB0, pB1; float mnA, mnB, alA, alB; bf16x8 pa0, pa1, pa2, pa3; constexpr int NT = seq / KVBLK;
    SLOAD(0, 0); asm volatile("s_waitcnt vmcnt(0)" ::: "memory"); SWRITE(0, 0); __syncthreads();
    qkt(pA0, pA1, K_lds, qr, r32, hi); partialSM(pA0, pA1, m_reg, mnA, alA);
    SLOAD(0, KVBLK);
    SWAIT(); SWRITE(1, 0); __syncthreads();
    int bc = 1;
#define ATT_STEP(PC0, PC1, MNC, ALC, PP0, PP1, ALP, KNEXT) do { const int bp_ = bc == 0 ? 2 : bc - 1, bn_ = bc == 2 ? 0 : bc + 1; \
        SBAR(); qkt(PC0, PC1, K_lds + bc * SHM_K, qr, r32, hi); \
        finishSM(PP0, PP1, ALP, l_reg, pa0, pa1, pa2, pa3); SBAR(); \
        SLOAD(0, (KNEXT)); SBAR(); \
          \
        { const int vb_ = vb0 + bp_ * SHM_V; s16x4 va[8], vc[8]; float pm_, mnC_; constexpr float C_ = SCALE * 1.4426950408889634f; \
          v_read8<0>(va, vb_); v_read8<1>(vc, vb_); \
          LGKM(8); SBAR(); pv4(o[0], va, pa0, pa1, pa2, pa3); SBAR(); \
          pm_ = PC0[0]; _Pragma("unroll") for (int r = 1; r < 16; ++r) pm_ = fmaxf(pm_, PC0[r]); SBAR(); \
          v_read8<2>(va, vb_); LGKM(8); SBAR(); pv4(o[1], vc, pa0, pa1, pa2, pa3); SBAR(); \
          _Pragma("unroll") for (int r = 0; r < 16; ++r) pm_ = fmaxf(pm_, PC1[r]); \
          { auto rr = __builtin_amdgcn_permlane32_swap(__float_as_uint(pm_), __float_as_uint(pm_), false, false); pm_ = fmaxf(__uint_as_float(rr[0]), __uint_as_float(rr[1])); } \
          if (__builtin_expect(__all(pm_ - m_reg <= THR / SCALE), 1)) { MNC = m_reg; ALC = 1.f; } \
          else { MNC = fmaxf(m_reg, pm_); ALC = __builtin_amdgcn_exp2f((m_reg - MNC) * C_); m_reg = MNC; } \
          mnC_ = -MNC * C_; SBAR(); \
          v_read8<3>(vc, vb_); LGKM(8); SBAR(); pv4(o[2], va, pa0, pa1, pa2, pa3); SBAR(); \
          _Pragma("unroll") for (int r = 0; r < 16; ++r) PC0[r] = fmaf(PC0[r], C_, mnC_); \
          _Pragma("unroll") for (int r = 0; r < 16; ++r) PC1[r] = fmaf(PC1[r], C_, mnC_); SBAR(); \
          LGKM(0); SBAR(); pv4(o[3], vc, pa0, pa1, pa2, pa3); SBAR(); \
          _Pragma("unroll") for (int r = 0; r < 16; ++r) PC0[r] = __builtin_amdgcn_exp2f(PC0[r]); SBAR(); } \
        SWAIT(); SWRITE(bn_, 0); \
        RESC(ALC); __syncthreads(); bc = bn_; } while (0)
    for (int j = 1; j + 1 < NT; j += 2) {
        ATT_STEP(pB0, pB1, mnB, alB, pA0, pA1, alA, (j + 1) * KVBLK);
        ATT_STEP(pA0, pA1, mnA, alA, pB0, pB1, alB, (j + 2) * KVBLK);
    }
#undef ATT_STEP
    {
        const int bp_ = bc == 0 ? 2 : bc - 1;
        SBAR(); qkt(pB0, pB1, K_lds + bc * SHM_K, qr, r32, hi);
        finishSM(pA0, pA1, alA, l_reg, pa0, pa1, pa2, pa3); SBAR();
        pv_d0(o, vb0 + bp_ * SHM_V, pa0, pa1, pa2, pa3); partialSM(pB0, pB1, m_reg, mnB, alB);
        RESC(alB);
        finishSM(pB0, pB1, alB, l_reg, pa0, pa1, pa2, pa3); SBAR();
        pv_d0(o, vb0 + bc * SHM_V, pa0, pa1, pa2, pa3);
    }
    if (hi == 0) li_l[r32] = l_reg; asm volatile("s_waitcnt lgkmcnt(0)" ::: "memory");
    float rli[16];
#pragma unroll
    for (int r = 0; r < 16; ++r) rli[r] = __builtin_amdgcn_rcpf(li_l[crow(r, hi)]);
    if constexpr (PASS == 0) {
#pragma unroll
        for (int d0 = 0; d0 < 4; ++d0)
#pragma unroll
            for (int r = 0; r < 16; r += 2) park[(d0 * 8 + (r >> 1)) * 64 + lane] = cvtpk(o[d0][r] * rli[r], o[d0][r + 1] * rli[r + 1]);
    } else {
        float ss[16];
#pragma unroll
        for (int r = 0; r < 16; r += 2) {
            float s0 = 0.f, s1 = 0.f;
#pragma unroll
            for (int d0 = 0; d0 < 4; ++d0) { const unsigned w = park[(d0 * 8 + (r >> 1)) * 64 + lane];
                const float a = bflo(w) - lam * (o[d0][r] * rli[r]), b = bfhi(w) - lam * (o[d0][r + 1] * rli[r + 1]);
                o[d0][r] = a; o[d0][r + 1] = b; s0 += a * a; s1 += b * b; }
            ss[r] = s0; ss[r + 1] = s1;
        }
#pragma unroll
        for (int r = 0; r < 16; ++r) {
            float s = ss[r];
            s += __shfl_xor(s, 1); s += __shfl_xor(s, 2); s += __shfl_xor(s, 4); s += __shfl_xor(s, 8); s += __shfl_xor(s, 16);
            ss[r] = post * (1.0f / sqrtf(s * (1.f / 128.f) + LN_EPS));
        }
        float sl[4];
#pragma unroll
        for (int d0 = 0; d0 < 4; ++d0) sl[d0] = subln[d0 * 32 + r32];
        bf16* Ow = Ob + (size_t)(wid * QBLK) * 1024;
#pragma unroll
        for (int r = 0; r < 16; ++r) { const int orow = crow(r, hi);
#pragma unroll
            for (int d0 = 0; d0 < 4; ++d0) Ow[(size_t)orow * 1024 + d0 * 32 + r32] = (bf16)(cvtpk(o[d0][r] * ss[r] * sl[d0], 0.f) & 0xffff); }
    }
    __syncthreads();
#undef SLOAD
#undef SWRITE
#undef SWAIT
#undef RESC
}

#undef LGKM
#undef PPBAR
}
__device__ __forceinline__ void st4(bf16* p, f32x4 v) { *(u32x2*)p = (u32x2){pk2(v.x, v.y), pk2(v.z, v.w)}; }

template <int lda, int ldb, int ldc, int KK>
struct PlainP {
    const bf16* a0; const bf16* b0; bf16* out; const float* bias; const float* scale;
    static constexpr int K = KK;
    __device__ __forceinline__ const bf16* abase() const { return a0; }
    __device__ __forceinline__ const bf16* bbase() const { return b0; }
    __device__ __forceinline__ unsigned aoff(int r) const { return (unsigned)(r * lda); }
    __device__ __forceinline__ unsigned boff(int r) const { return (unsigned)(r * ldb); }
    __device__ __forceinline__ void epi(f32x4 (&acc)[8][4], int wr, int wc, int fr, int fq) const {
#pragma unroll
        for (int nb = 0; nb < 4; ++nb) {
            const int col = wc * 64 + nb * 16 + 4 * fq;
            const f32x4 bv = bias ? *(const f32x4*)(bias + col) : (f32x4){0.f, 0.f, 0.f, 0.f};
            const f32x4 sv = scale ? *(const f32x4*)(scale + col) : (f32x4){1.f, 1.f, 1.f, 1.f};
#pragma unroll
            for (int mb = 0; mb < 8; ++mb) st4(out + (size_t)(wr * 128 + mb * 16 + fr) * ldc + col, (acc[mb][nb] + bv) * sv);
        }
    }
};
struct QkvP {
    const bf16* a0; const bf16* b0; int pm, pn; bf16 *Q, *Kb, *Vb; const float* rope;
    static constexpr int K = 1024;
    __device__ __forceinline__ const bf16* abase() const { return a0; }
    __device__ __forceinline__ const bf16* bbase() const { return b0; }
    __device__ __forceinline__ unsigned aoff(int r) const { return (unsigned)(r * 1024); }
    __device__ __forceinline__ unsigned boff(int r) const { return (unsigned)(r * 1024); }
    __device__ __forceinline__ void epi(f32x4 (&acc)[8][4], int wr, int wc, int fr, int fq) const {
        const int part = pn >> 2, cbase = (pn & 3) * 256 + wc * 64 + 4 * fq;
#pragma unroll
        for (int mb = 0; mb < 8; ++mb) {
            const int m = pm * 256 + wr * 128 + mb * 16 + fr; const bool latent = m < T;
            int kvrow, l = 0;
            if (latent) { const int b = m / SEQ; l = m % SEQ; kvrow = b * LK + l; } else { const int mm = m - T; kvrow = (mm / CTXL) * LK + SEQ + (mm % CTXL); }
            f32x4 v0 = acc[mb][0], v1 = acc[mb][1], v2 = acc[mb][2], v3 = acc[mb][3];
            if (part < 2 && latent) {
                const int rp = l >> 6, cp = l & 63;
                const f32x4 cr = *(const f32x4*)(rope + rp * 16 + 4 * fq), sr = *(const f32x4*)(rope + 2048 + rp * 16 + 4 * fq);
                const f32x4 cc = *(const f32x4*)(rope + 4096 + cp * 16 + 4 * fq), sc = *(const f32x4*)(rope + 5120 + cp * 16 + 4 * fq);
                const f32x4 a = v0, b = v1, c = v2, d = v3;
                v0 = a * cr - b * sr; v1 = b * cr + a * sr; v2 = c * cc - d * sc; v3 = d * cc + c * sc;
            }
            bf16* dst = (part == 0 ? Q + (size_t)m * 1024 : (part == 1 ? Kb : Vb) + (size_t)kvrow * 1024) + cbase;
            if (part > 0 || latent) { st4(dst, v0); st4(dst + 16, v1); st4(dst + 32, v2); st4(dst + 48, v3); }
        }
    }
};
struct GuP {
    const bf16* HA; const int* list; int cnt, rt; const bf16* b0; bf16* out;
    static constexpr int K = 1024;
    __device__ __forceinline__ const bf16* abase() const { return HA; }
    __device__ __forceinline__ const bf16* bbase() const { return b0; }
    __device__ __forceinline__ unsigned aoff(int r) const { const int idx = rt * 256 + r; const int tok = idx < cnt ? (list[idx] >> 1) : 0; return (unsigned)(tok * 1024); }
    __device__ __forceinline__ unsigned boff(int r) const { return (unsigned)(r * 1024); }
    __device__ __forceinline__ void epi(f32x4 (&acc)[8][4], int wr, int wc, int fr, int fq) const {
#pragma unroll
        for (int mb = 0; mb < 8; ++mb)
#pragma unroll
            for (int nb = 0; nb < 2; ++nb) {
                const f32x4 g = acc[mb][nb], u = acc[mb][nb + 2];
                const f32x4 h = {fsilu(g.x) * u.x, fsilu(g.y) * u.y, fsilu(g.z) * u.z, fsilu(g.w) * u.w};
                st4(out + (size_t)(wr * 128 + mb * 16 + fr) * 1024 + wc * 32 + nb * 16 + 4 * fq, h);
            }
    }
};
struct DnP {
    const bf16* a0; const bf16* b0; const int* list; const float* tokw; int cnt, rt; bf16* Y2; int col0;
    static constexpr int K = 1024;
    __device__ __forceinline__ const bf16* abase() const { return a0; }
    __device__ __forceinline__ const bf16* bbase() const { return b0; }
    __device__ __forceinline__ unsigned aoff(int r) const { return (unsigned)(r * 1024); }
    __device__ __forceinline__ unsigned boff(int r) const { return (unsigned)(r * 1024); }
    __device__ __forceinline__ void epi(f32x4 (&acc)[8][4], int wr, int wc, int fr, int fq) const {
#pragma unroll
        for (int mb = 0; mb < 8; ++mb) {
            const int idx = rt * 256 + wr * 128 + mb * 16 + fr;
            if (idx < cnt) { const int slot = list[idx]; const float w = tokw[slot];
#pragma unroll
                for (int nb = 0; nb < 4; ++nb) st4(Y2 + (size_t)slot * 1024 + col0 + wc * 64 + nb * 16 + 4 * fq, acc[mb][nb] * w); }
        }
    }
};
struct FwP {
    const bf16* A; const bf16* B; bf16* FW; int kbase, colk, ct;
    static constexpr int K = 256;
    __device__ __forceinline__ const bf16* abase() const { return A; }
    __device__ __forceinline__ const bf16* bbase() const { return B; }
    __device__ __forceinline__ unsigned aoff(int r) const { return (unsigned)(r * 256); }
    __device__ __forceinline__ unsigned boff(int k) const { return (unsigned)(k * 1024); }
    __device__ __forceinline__ void epi(f32x4 (&acc)[4][4], int wr, int wc, int fr, int fq) const {
#pragma unroll
        for (int mb = 0; mb < 4; ++mb) { const int kidx = kbase + wr * 64 + mb * 16 + fr;
#pragma unroll
            for (int nb = 0; nb < 4; ++nb) { const int n = ct * 256 + wc * 64 + nb * 16 + 4 * fq; bf16* o = FW + (size_t)n * 2048 + colk + kidx; const f32x4 v = acc[mb][nb];
                o[0] = (bf16)(pk2(v.x, 0.f) & 0xffff); o[2048] = (bf16)(pk2(v.y, 0.f) & 0xffff); o[4096] = (bf16)(pk2(v.z, 0.f) & 0xffff); o[6144] = (bf16)(pk2(v.w, 0.f) & 0xffff); } }
    }
};
struct KfP {
    const bf16* A2b; const bf16* F3T; bf16* KF; int rt, ct;
    static constexpr int K = 64;
    __device__ __forceinline__ const bf16* abase() const { return A2b; }
    __device__ __forceinline__ const bf16* bbase() const { return F3T; }
    __device__ __forceinline__ unsigned aoff(int r) const { const int n = rt * 256 + r; const int t = n < SEQ ? n : (n == SEQ ? 0 : 2 * SEQ - n); return (unsigned)(t * 64); }
    __device__ __forceinline__ unsigned boff(int r) const { return (unsigned)(((rt >= 32 ? 1024 : 0) + ct * 256 + r) * 64); }
    __device__ __forceinline__ void epi(f32x4 (&acc)[8][4], int wr, int wc, int fr, int fq) const {
        const float dlo = -3.0701134573253943f, dhi = -15.350567286626972f;
#pragma unroll
        for (int nb = 0; nb < 4; ++nb) {
            const int d = ct * 256 + wc * 64 + nb * 16 + 4 * fq;
            f32x4 dl; dl.x = -(dlo + (dhi - dlo) * (float)(d + 0) * (1.f / 1023.f)); dl.y = -(dlo + (dhi - dlo) * (float)(d + 1) * (1.f / 1023.f));
            dl.z = -(dlo + (dhi - dlo) * (float)(d + 2) * (1.f / 1023.f)); dl.w = -(dlo + (dhi - dlo) * (float)(d + 3) * (1.f / 1023.f));
#pragma unroll
            for (int mb = 0; mb < 8; ++mb) {
                const int n = rt * 256 + wr * 128 + mb * 16 + fr; const int t = n < SEQ ? n : 2 * SEQ - n; const float tt = -(float)t * (1.f / 8192.f);
                f32x4 v = acc[mb][nb]; v.x *= __expf(tt * dl.x); v.y *= __expf(tt * dl.y); v.z *= __expf(tt * dl.z); v.w *= __expf(tt * dl.w);
                if (n == SEQ) v = (f32x4){0.f, 0.f, 0.f, 0.f};
                st4(KF + (size_t)n * 1024 + d, v);
            }
        }
    }
};
#ifndef DFT_WIDE_STORE
#define DFT_WIDE_STORE 1
#endif
enum { E_TW = 0, E_TWC = 1, E_PLANES = 2, E_KHAT = 3, E_MULK = 4, E_HY = 5 };
template <int MT, int EK>
struct DftP {
    const bf16* A; int K; const bf16* bs0; unsigned seg1; int ksplit; unsigned kstride;
    bf16* out0; bf16* out1; size_t rstride;
    const f32x2* tw; int twi; int fbase;
    float* kh;
    const bf16* vp; const bf16* x0; const float* skip;
    __device__ __forceinline__ const bf16* abase() const { return A; }
    __device__ __forceinline__ const bf16* bbase() const { return bs0; }
    __device__ __forceinline__ unsigned aoff(int r) const { return (unsigned)(r * K); }
    __device__ __forceinline__ unsigned boff(int k) const { return k < ksplit ? (unsigned)k * kstride : seg1 + (unsigned)(k - ksplit) * kstride; }
    __device__ __forceinline__ void epi(f32x4 (&acc)[MT / 32][4], int wr, int wc, int fr, int fq) const {
#pragma unroll
        for (int mp = 0; mp < MT / 64; ++mp) {
            const int f = fbase + ((wr * (MT / 2) + mp * 32) >> 5) * 16 + fr;
#pragma unroll
            for (int nb = 0; nb < 4; ++nb) {
                const int col = wc * 64 + nb * 16 + 4 * fq;
                f32x4 re = acc[2 * mp][nb], im = acc[2 * mp + 1][nb];
                if constexpr (EK == E_TW || EK == E_TWC) {
                    const f32x2 t = tw[f * 128 + twi]; const float c = t.x, s = (EK == E_TW) ? t.y : -t.y;
                    const f32x4 r2 = re * c + im * s, i2 = im * c - re * s; re = r2; im = i2;
                }
                if constexpr (EK == E_MULK) {
                    const u32x4 kq = *(const u32x4*)(kh + ((size_t)f * 1024 + col));
                    const f32x4 kr = {bflo(kq.x), bflo(kq.y), bflo(kq.z), bflo(kq.w)}, ki = {bfhi(kq.x), bfhi(kq.y), bfhi(kq.z), bfhi(kq.w)};
                    const f32x4 r2 = re * kr - im * ki, i2 = re * ki + im * kr; re = r2; im = i2;
                }
                if constexpr (EK == E_KHAT) {
                    const float sc = 1.0f / 16384.0f;
                    *(u32x4*)(kh + ((size_t)f * 1024 + col)) = (u32x4){pk2(re.x * sc, im.x * sc), pk2(re.y * sc, im.y * sc), pk2(re.z * sc, im.z * sc), pk2(re.w * sc, im.w * sc)};
                } else if constexpr (EK == E_HY) {
#if DFT_WIDE_STORE
                    {
                        const auto q0 = __builtin_amdgcn_permlane16_swap(__float_as_uint(re.x), __float_as_uint(im.x), false, false), q1 = __builtin_amdgcn_permlane16_swap(__float_as_uint(re.y), __float_as_uint(im.y), false, false);
                        const auto q2 = __builtin_amdgcn_permlane16_swap(__float_as_uint(re.z), __float_as_uint(im.z), false, false), q3 = __builtin_amdgcn_permlane16_swap(__float_as_uint(re.w), __float_as_uint(im.w), false, false);
                        const f32x4 lo = {__uint_as_float(q0[0]), __uint_as_float(q1[0]), __uint_as_float(q2[0]), __uint_as_float(q3[0])}, hi = {__uint_as_float(q0[1]), __uint_as_float(q1[1]), __uint_as_float(q2[1]), __uint_as_float(q3[1])};
                        const int c8 = wc * 64 + nb * 16 + (fq >> 1) * 8;
                        const size_t ro8 = (size_t)(128 * f + twi) * 1024 + c8 + ((fq & 1) ? (size_t)SEQ * 1024 : (size_t)0);
                        const f32x4 sk0 = *(const f32x4*)(skip + c8), sk1 = *(const f32x4*)(skip + c8 + 4);
                        const u32x4 vv = *(const u32x4*)(vp + ro8), xx = *(const u32x4*)(x0 + ro8);
                        const f32x4 v0 = {bflo(vv.x), bfhi(vv.x), bflo(vv.y), bfhi(vv.y)}, v1 = {bflo(vv.z), bfhi(vv.z), bflo(vv.w), bfhi(vv.w)};
                        const f32x4 g0 = {bflo(xx.x), bfhi(xx.x), bflo(xx.y), bfhi(xx.y)}, g1 = {bflo(xx.z), bfhi(xx.z), bflo(xx.w), bfhi(xx.w)};
                        const f32x4 o0 = (lo + v0 * sk0) * g0, o1 = (hi + v1 * sk1) * g1;
                        *(u32x4*)(out0 + ro8) = (u32x4){pk2(o0.x, o0.y), pk2(o0.z, o0.w), pk2(o1.x, o1.y), pk2(o1.z, o1.w)};
                        continue;
                    }
#endif
                    const size_t ro = (size_t)(128 * f + twi) * 1024 + col, ro1 = ro + (size_t)SEQ * 1024;
                    const f32x4 sk = *(const f32x4*)(skip + col);
                    const u32x2 va = *(const u32x2*)(vp + ro), vb = *(const u32x2*)(vp + ro1), xa = *(const u32x2*)(x0 + ro), xb = *(const u32x2*)(x0 + ro1);
                    const f32x4 v0 = {bflo(va.x), bfhi(va.x), bflo(va.y), bfhi(va.y)}, v1 = {bflo(vb.x), bfhi(vb.x), bflo(vb.y), bfhi(vb.y)};
                    const f32x4 g0 = {bflo(xa.x), bfhi(xa.x), bflo(xa.y), bfhi(xa.y)}, g1 = {bflo(xb.x), bfhi(xb.x), bflo(xb.y), bfhi(xb.y)};
                    st4(out0 + ro, (re + v0 * sk) * g0); st4(out0 + ro1, (im + v1 * sk) * g1);
                } else {
#if DFT_WIDE_STORE
                    const auto s0 = __builtin_amdgcn_permlane16_swap(pk2(re.x, re.y), pk2(im.x, im.y), false, false);
                    const auto s1 = __builtin_amdgcn_permlane16_swap(pk2(re.z, re.w), pk2(im.z, im.w), false, false);
                    bf16* pl = (fq & 1) ? out1 : out0;
                    *(u32x4*)(pl + (size_t)f * rstride + wc * 64 + nb * 16 + (fq >> 1) * 8) = (u32x4){s0[0], s1[0], s0[1], s1[1]};
#else
                    st4(out0 + (size_t)f * rstride + col, re); st4(out1 + (size_t)f * rstride + col, im);
#endif
                }
            }
        }
    }
};
namespace tgx {
using tg::TUnit;
#ifndef TG_WIDE_STORE
#define TG_WIDE_STORE 1
#endif
template <int WIDE> __device__ __forceinline__ void st8x2(bf16* p0, const f32x4 v0, const f32x4 v1, int fq) {
    if constexpr (WIDE != 0) {
    const auto s0 = __builtin_amdgcn_permlane16_swap(pk2(v0.x, v0.y), pk2(v1.x, v1.y), false, false);
    const auto s1 = __builtin_amdgcn_permlane16_swap(pk2(v0.z, v0.w), pk2(v1.z, v1.w), false, false);
    *(u32x4*)(p0 - 4 * fq + (fq >> 1) * 8 + (fq & 1) * 16) = (u32x4){s0[0], s1[0], s0[1], s1[1]};
    } else { st4(p0, v0); st4(p0 + 16, v1); }
}
#ifndef TGW_PLAIN
#define TGW_PLAIN 1
#endif
#ifndef TGW_QKV
#define TGW_QKV 1
#endif
#ifndef TGW_GU
#define TGW_GU 1
#endif
#ifndef TGW_DN
#define TGW_DN 1
#endif
struct DenseSched {
    const char* A; const char* B; int nN, nU, G, vcu; size_t astep, bstep;
    __device__ __forceinline__ bool next(int i, TUnit& u) const {
        const int L = i * G + vcu; if (L >= nU) return false;
        const int pm = L / nN, pn = L - pm * nN; u.a = A + (size_t)pm * astep; u.b = B + (size_t)pn * bstep; u.i0 = pm; u.i1 = pn; u.i2 = 0; u.i3 = 0; return true; }
};
struct EpiPlain {
    bf16* out; int ldc; const float* bias;
    __device__ __forceinline__ void operator()(const f32x4 (&acc)[2][2][4][2], const TUnit& u, int wr, int wc, int fr, int fq) const {
        const int col0 = u.i1 * 256 + wc * 32 + 4 * fq;
        bf16* const base = out + (size_t)(u.i0 * 256 + wr * 64 + fr) * ldc + col0;
        if (bias) {
#pragma unroll
            for (int ai = 0; ai < 2; ++ai)
#pragma unroll
                for (int m = 0; m < 4; ++m) { bf16* rowp = base + (size_t)(ai * 128 + m * 16) * ldc;
#pragma unroll
                    for (int bj = 0; bj < 2; ++bj) st8x2<TGW_PLAIN>(rowp + bj * 128, acc[ai][bj][m][0] + *(const f32x4*)(bias + col0 + bj * 128), acc[ai][bj][m][1] + *(const f32x4*)(bias + col0 + bj * 128 + 16), fq); }
        } else {
#pragma unroll
            for (int ai = 0; ai < 2; ++ai)
#pragma unroll
                for (int m = 0; m < 4; ++m) { bf16* rowp = base + (size_t)(ai * 128 + m * 16) * ldc;
#pragma unroll
                    for (int bj = 0; bj < 2; ++bj) st8x2<TGW_PLAIN>(rowp + bj * 128, acc[ai][bj][m][0], acc[ai][bj][m][1], fq); }
        }
    }
};
struct EpiScale {
    bf16* out; int ldc; const float* scale;
    __device__ __forceinline__ void operator()(const f32x4 (&acc)[2][2][4][2], const TUnit& u, int wr, int wc, int fr, int fq) const {
        const int col0 = u.i1 * 256 + wc * 32 + 4 * fq;
#pragma unroll
        for (int ai = 0; ai < 2; ++ai)
#pragma unroll
            for (int m = 0; m < 4; ++m) { bf16* rowp = out + (size_t)(u.i0 * 256 + ai * 128 + wr * 64 + m * 16 + fr) * ldc + col0;
#pragma unroll
                for (int bj = 0; bj < 2; ++bj)
#pragma unroll
                    for (int n = 0; n < 2; ++n) st4(rowp + bj * 128 + n * 16, acc[ai][bj][m][n] * *(const f32x4*)(scale + col0 + bj * 128 + n * 16)); }
    }
};
struct PoolSched {
    const char* A; const char* B; int G, vcu;
    __device__ __forceinline__ bool next(int i, TUnit& u) const {
        const int L = i * G + vcu; if (L >= 512) return false;
        const int pm = L >> 2, g = L & 3; u.a = A + (size_t)pm * (256 * 1024 * 2) + g * 512; u.b = B + (size_t)g * (65536 * 2); u.i0 = pm; u.i1 = g; u.i2 = 0; u.i3 = 0; return true; }
};
struct QkvSched {
    const char* A; const char* B; int G, vcu;
    __device__ __forceinline__ bool next(int i, TUnit& u) const {
        const int L = i * G + vcu; if (L >= 1536 + 32) return false;
        int pm, pn; if (L < 1536) { pm = L / 12; pn = L - pm * 12; } else { const int L2 = L - 1536; pm = 128 + (L2 >> 3); pn = 4 + (L2 & 7); }
        u.a = A + (size_t)pm * (256 * 1024 * 2); u.b = B + (size_t)pn * (256 * 1024 * 2); u.i0 = pm; u.i1 = pn; u.i2 = 0; u.i3 = 0; return true; }
};
struct EpiQkv {
    bf16 *Q, *Kb, *Vb; const float* rope;
    __device__ __forceinline__ void operator()(const f32x4 (&acc)[2][2][4][2], const TUnit& u, int wr, int wc, int fr, int fq) const {
        const int pm = u.i0, pn = u.i1, part = pn >> 2, cb = (pn & 3) * 256 + wc * 32 + 4 * fq;
        const int ang = (wc & 1) ? 4096 : 0;
#pragma unroll
        for (int ai = 0; ai < 2; ++ai)
#pragma unroll
            for (int m = 0; m < 4; ++m) {
                const int mg = pm * 256 + ai * 128 + wr * 64 + m * 16 + fr; const bool latent = mg < T;
                int kvrow, l = 0;
                if (latent) { const int b = mg / SEQ; l = mg % SEQ; kvrow = b * LK + l; } else { const int mm = mg - T; kvrow = (mm / CTXL) * LK + SEQ + (mm % CTXL); }
                f32x4 cs = {1.f, 1.f, 1.f, 1.f}, sn = {0.f, 0.f, 0.f, 0.f};
                if (part < 2 && latent) { const int p = (wc & 1) ? (l & 63) : (l >> 6); cs = *(const f32x4*)(rope + ang + p * 16 + 4 * fq); sn = *(const f32x4*)(rope + ang + ((wc & 1) ? 1024 : 2048) + p * 16 + 4 * fq); }
                bf16* dst = (part == 0 ? Q + (size_t)mg * 1024 : (part == 1 ? Kb : Vb) + (size_t)kvrow * 1024) + cb;
#pragma unroll
                for (int bj = 0; bj < 2; ++bj) { const f32x4 a = acc[ai][bj][m][0], b = acc[ai][bj][m][1];
                    if (part > 0 || latent) st8x2<TGW_QKV>(dst + bj * 128, a * cs - b * sn, b * cs + a * sn, fq); }
            }
    }
};
struct GuSched {
    const char* HA; const char* W; const int* LIST; const LAS int* mt; int G, vcu, ntl;
    __device__ __forceinline__ bool next(int i, TUnit& u) const {
        const int L = i * G + vcu; if (L >= ntl * 8) return false;
        const int ti = L >> 3, pn = L & 7; int e = 0;
        for (int k = 1; k < 16; ++k) if (mt[16 + k] <= ti) e = k;
        u.a = HA; u.b = W + ((size_t)e * 2048 + pn * 256) * 2048; u.i0 = ti; u.i1 = pn; u.i2 = e; u.i3 = ti - mt[16 + e]; return true; }
    __device__ __forceinline__ int arow(const TUnit& u, int r) const { const int idx = u.i3 * 256 + r; return idx < mt[u.i2] ? (LIST[(size_t)u.i2 * T + idx] >> 1) : 0; }
};
struct EpiGu {
    bf16* HS;
    __device__ __forceinline__ void operator()(const f32x4 (&acc)[2][2][4][2], const TUnit& u, int wr, int wc, int fr, int fq) const {
        bf16* base = HS + (size_t)u.i0 * 256 * 1024 + u.i1 * 128 + wc * 32 + 4 * fq;
#pragma unroll
        for (int ai = 0; ai < 2; ++ai)
#pragma unroll
            for (int m = 0; m < 4; ++m) { f32x4 h[2];
#pragma unroll
                for (int n = 0; n < 2; ++n) { const f32x4 g = acc[ai][0][m][n], up = acc[ai][1][m][n];
                    h[n] = (f32x4){fsilu(g.x) * up.x, fsilu(g.y) * up.y, fsilu(g.z) * up.z, fsilu(g.w) * up.w}; }
                st8x2<TGW_GU>(base + (size_t)(ai * 128 + wr * 64 + m * 16 + fr) * 1024, h[0], h[1], fq); }
    }
};
struct DnSched {
    const char* HS; const char* W; const LAS int* mt; int G, vcu, ntl;
    __device__ __forceinline__ bool next(int i, TUnit& u) const {
        const int L = i * G + vcu; if (L >= ntl * 4) return false;
        const int ti = L >> 2, pn = L & 3; int e = 0;
        for (int k = 1; k < 16; ++k) if (mt[16 + k] <= ti) e = k;
        u.a = HS + (size_t)ti * (256 * 1024 * 2); u.b = W + ((size_t)e * 1024 + pn * 256) * 2048; u.i0 = ti; u.i1 = pn; u.i2 = e; u.i3 = ti - mt[16 + e]; return true; }
};
struct EpiDn {
    bf16* Y2; const int* LIST; const float* TOKW; const LAS int* mt;
    __device__ __forceinline__ void operator()(const f32x4 (&acc)[2][2][4][2], const TUnit& u, int wr, int wc, int fr, int fq) const {
        const int cnt = mt[u.i2], col0 = u.i1 * 256 + wc * 32 + 4 * fq;
        int slot[2][4]; float w[2][4];
#pragma unroll
        for (int ai = 0; ai < 2; ++ai)
#pragma unroll
            for (int m = 0; m < 4; ++m) { const int idx = u.i3 * 256 + ai * 128 + wr * 64 + m * 16 + fr; slot[ai][m] = LIST[(size_t)u.i2 * T + (idx < cnt ? idx : 0)]; }
#pragma unroll
        for (int ai = 0; ai < 2; ++ai)
#pragma unroll
            for (int m = 0; m < 4; ++m) w[ai][m] = TOKW[slot[ai][m]];
#pragma unroll
        for (int ai = 0; ai < 2; ++ai)
#pragma unroll
            for (int m = 0; m < 4; ++m) { const int idx = u.i3 * 256 + ai * 128 + wr * 64 + m * 16 + fr;
                if (idx < cnt) { bf16* rowp = Y2 + (size_t)slot[ai][m] * 1024 + col0;
#pragma unroll
                    for (int bj = 0; bj < 2; ++bj) st8x2<TGW_DN>(rowp + bj * 128, acc[ai][bj][m][0] * w[ai][m], acc[ai][bj][m][1] * w[ai][m], fq); } }
    }
};
}
#ifndef MK_ONLY
#define MK_ONLY -1
#endif
#ifndef ATT_PP
#define ATT_PP 0
#endif
#if ATT_PP == 1
#define ATT_FN attn_pass_pp
#elif ATT_PP == 2
#define ATT_FN attn_pass_il
#else
#define ATT_FN attn_pass
#endif
#define EN(k) (MK_ONLY < 0 || MK_ONLY == (k))
#ifndef F1_UNITS
#define F1_UNITS (NB * 128 * 4)
#endif
#ifndef F1_K
#define F1_K 64
#define F1_AMAT DFT_F1
#endif
#ifndef F1_EK
#define F1_EK E_TW
#endif
#ifndef MK_REP
#define MK_REP -1
#endif
#ifndef SETTLE_TICKS
#define SETTLE_TICKS 0
#endif
enum { PH_P0 = 0, PH_MOD, PH_QKV, PH_ATT, PH_AWO, PH_M0, PH_POOLPRE = PH_M0 + 4, PH_POOLG, PH_M1, PH_F1 = PH_M1 + 4, PH_F2, PH_F3, PH_M2,
       PH_H1 = PH_M2 + 4, PH_H2, PH_H3, PH_H4, PH_H5, PH_H6, PH_H7, PH_M3, NPH = PH_M3 + 4 };

__device__ __forceinline__ void dense_gemm(const Frame& F, const bf16* A, int lda, int Mrows, const bf16* Bt, int ldb, int N, int K, bf16* out, int ldc, const float* bias) {
    tgx::DenseSched S{(const char*)A, (const char*)Bt, N / 256, (Mrows / 256) * (N / 256), F.G, F.vcu, (size_t)256 * lda * 2, (size_t)256 * ldb * 2};
    tgx::EpiPlain E{out, ldc, bias};
    tg::tgemm_phase<false>(F.lds, F.tid, lda, ldb, K, S, E);
}
__device__ __forceinline__ Frame make_frame(LAS unsigned char* lds, unsigned char* ws, int wave_s) {
    Frame F; F.lds = lds; F.ws = ws;
    int t = wave_s * 64 + lane_id(); asm volatile("" : "+v"(t));
    int bx = blockIdx.x; asm volatile("" : "+s"(bx));
    F.tid = t; F.lane = t & 63; F.wave = __builtin_amdgcn_readfirstlane(t >> 6);
    F.G = gridDim.x; F.vcu = (F.G % 8 == 0) ? (bx % 8) * (F.G / 8) + bx / 8 : bx;
    F.gw = F.vcu * NWAVES + F.wave; F.NGW = F.G * NWAVES;
    return F;
}
__global__ void __launch_bounds__(NTHR, 2) mk_fwd(Args args) {
    extern __shared__ __attribute__((aligned(16))) unsigned char lds_raw[];
    LAS unsigned char* const lds0 = (LAS unsigned char*)lds_raw;
    volatile LAS unsigned* MISC = (volatile LAS unsigned*)(lds0 + LDS_MISC);
    const int wave_s = __builtin_amdgcn_readfirstlane((int)threadIdx.x >> 6);
    if (wave_s == 0) MISC[lane_id()] = 0u;
    __syncthreads();
    typedef const Args __attribute__((address_space(4))) CArgs;
#define MKF() CArgs* ka = (CArgs*)__builtin_amdgcn_kernarg_segment_ptr(); asm volatile("" : "+s"(ka)); unsigned char* const ws = ka->ws; Frame F_ = make_frame(lds0, ws, wave_s); F_.flip = ka->flip; const Frame F = F_; (void)ws
    const int lo = args.ph_lo, hi = args.ph_hi;
    const bool multi = (hi - lo) > 1;
    unsigned* ctl = (unsigned*)(args.ws + WS_CTL);
    XcdBarrier bar; bar.bar = ctl + CW_BAR; bar.x = 0; bar.st = MISC;
    if (multi) bar = xcd_barrier_post(ctl + CW_BAR, MISC, wave_s);
#define IN(k) (lo <= (k) && (k) < hi)
#define SEAM_FORCE() do { XcdBarrier b_ = bar; unsigned* bp_ = b_.bar; asm volatile("" : "+s"(bp_)); b_.bar = bp_; xcd_barrier(b_, wave_s); } while (0)
#define SEAM(k) do { if (IN(k) && IN((k) + 1)) { XcdBarrier b_ = bar; unsigned* bp_ = b_.bar; asm volatile("" : "+s"(bp_)); b_.bar = bp_; xcd_barrier(b_, wave_s); } } while (0)
#define TAIL_CONVERT(nunits, PART, LAYER) do { const int rem_ = (nunits) % F.G; int pi_ = F.vcu, np_ = F.G; if (rem_ != 0 && F.G - rem_ >= 64) { pi_ = F.vcu - rem_; np_ = F.G - rem_; } \
        if (pi_ >= 0) { __syncthreads(); convert_moe_part(F, ka->in[I_WG], ka->in[I_WU], ka->in[I_WD], (LAYER), (PART), pi_, np_); } } while (0)

    for (int rep_ = 0; rep_ < (MK_REP == (PH_P0) ? 2 : 1); ++rep_) if (EN(PH_P0) && IN(PH_P0)) { if (rep_) { SEAM_FORCE(); } MKF();
        for (int q_ = 0; q_ < (MK_REP == 901 ? 2 : 1); ++q_) { mod_gemv(F, ka->in[I_C], ka->in[I_CCTX], ka->in[I_MODW], ka->in[I_MODB]);
        __syncthreads(); }
        for (int q_ = 0; q_ < (MK_REP == 904 ? 2 : 1); ++q_) {
        {
            LAS float* scr = (LAS float*)(F.lds + F.wave * 16640);
            for (int it = F.gw; it < 2144; it += F.NGW) {
                const float* W; bf16* WT; int K, N, q;
                if (it < 768) { W = ka->in[I_WQKV]; WT = (bf16*)(ws + WS_WQKV); K = 1024; N = 3072; q = it; }
                else if (it < 1024) { W = ka->in[I_WO]; WT = (bf16*)(ws + WS_WO); K = 1024; N = 1024; q = it - 768; }
                else if (it < 1792) { W = ka->in[I_HWIN]; WT = (bf16*)(ws + WS_HWIN); K = 1024; N = 3072; q = it - 1024; }
                else if (it < 2048) { W = ka->in[I_HWO]; WT = (bf16*)(ws + WS_HWO); K = 1024; N = 1024; q = it - 1792; }
                else if (it < 2080) { W = ka->in[I_HF3]; WT = (bf16*)(ws + WS_F3T); K = 64; N = 2048; q = it - 2048; }
                else { const int g = (it - 2080) >> 4; W = ka->in[I_POOLW] + g * 65536; WT = (bf16*)(ws + WS_POOLW) + g * 65536; K = 256; N = 256; q = (it - 2080) & 15; }
                const int nblk = N >> 6, kb = q / nblk, nb = q - kb * nblk;
                transpose_item64(W, N, kb * 64, nb * 64, WT, K, nb * 64, nb * 64 + 32, scr, F.lane);
            }
        }
        __syncthreads(); }
        for (int q_ = 0; q_ < (MK_REP == 902 ? 2 : 1); ++q_) { tables(F); __syncthreads(); }
        for (int q_ = 0; q_ < (MK_REP == 905 ? 2 : 1); ++q_) { fourier_w_copy(F, ka->in[I_FW]);
        router_tables(F, ka->in[I_RW]); __syncthreads(); }
        for (int q_ = 0; q_ < (MK_REP == 903 ? 2 : 1); ++q_) { hyena_a2(F, ka->in[I_HF1], ka->in[I_HFB1], ka->in[I_HF2], ka->in[I_HFB2], ka->in[I_HFREQ]);
        __syncthreads(); }
    }
    SEAM(PH_P0);
#ifdef MK_XBAR
    for (int xb_ = 0; xb_ < MK_XBAR; ++xb_) { SEAM_FORCE(); }
#endif
    for (int rep_ = 0; rep_ < (MK_REP == (PH_MOD) ? 2 : 1); ++rep_) if (EN(PH_MOD) && IN(PH_MOD)) { if (rep_) { SEAM_FORCE(); } MKF(); modulate0(F, ka->in[I_X], ka->in[I_CTX]);
        { auto mk_ = [=](int un) {
            const int ct = un & 3, rh = (un >> 2) & 1, tg_ = (un >> 3) & 1, g = un >> 4;
            FwP p{(const bf16*)(ws + WS_TRIG) + (size_t)(tg_ * 256 + rh * 128) * 256, (const bf16*)(ws + WS_WFB) + (size_t)(g * 256) * 1024 + ct * 256, (bf16*)(ws + WS_FW), rh * 128, tg_ * 1024 + g * 256, ct};
            return p; };
          sgemm_stream<128, 1>(F.lds, F.tid, mk_, F.vcu, 64, F.G); }
    }
    SEAM(PH_MOD);

    for (int rep_ = 0; rep_ < (MK_REP == (PH_QKV) ? 2 : 1); ++rep_) if (EN(PH_QKV) && IN(PH_QKV)) { if (rep_) { SEAM_FORCE(); } MKF();
        tgx::QkvSched S{(const char*)(ws + WS_HA), (const char*)(ws + WS_WQKV), F.G, F.vcu};
        tgx::EpiQkv E{(bf16*)(ws + WS_Q), (bf16*)(ws + WS_K), (bf16*)(ws + WS_V), (const float*)(ws + WS_ROPE)};
        tg::tgemm_phase<false>(F.lds, F.tid, 1024, 1024, 1024, S, E);
        TAIL_CONVERT(1536 + 32, 0, 0);
    }
    SEAM(PH_QKV);
    for (int rep_ = 0; rep_ < (MK_REP == (PH_ATT) ? 2 : 1); ++rep_) if (EN(PH_ATT) && IN(PH_ATT)) { if (rep_) { SEAM_FORCE(); } MKF();
        const float* lamp = ka->in[I_LAM]; float d01 = 0.f, d23 = 0.f;
        for (int i = 0; i < 64; ++i) { d01 += lamp[i] * lamp[64 + i]; d23 += lamp[128 + i] * lamp[192 + i]; }
        const float lam_init = 0.2f, lam = __expf(d01) - __expf(d23) + lam_init;
        const bf16* Q = (const bf16*)(ws + WS_Q); const bf16* Kb = (const bf16*)(ws + WS_K); const bf16* Vb = (const bf16*)(ws + WS_V); bf16* AO = (bf16*)(ws + WS_AO);
        for (int u = F.vcu; u < NB * 8 * 32; u += F.G) {
            const int qb = u & 31, h = (u >> 5) & 7, b = u >> 8;
            const bf16* q0 = Q + (size_t)(b * SEQ + qb * 256) * 1024 + h * 128; const bf16* k0 = Kb + (size_t)b * LK * 1024 + h * 128; const bf16* v0 = Vb + (size_t)b * LK * 1024 + h * 128;
            bf16* o0 = AO + (size_t)(b * SEQ + qb * 256) * 1024 + h * 128;
            att::ATT_FN<0>(q0, k0, v0, o0, lam, ka->in[I_SUBLN], 1.f - lam_init, F.lds, F.tid);
            att::ATT_FN<1>(q0 + 64, k0 + 64, v0, o0, lam, ka->in[I_SUBLN], 1.f - lam_init, F.lds, F.tid);
        }
    }
    SEAM(PH_ATT);
    for (int rep_ = 0; rep_ < (MK_REP == (PH_AWO) ? 2 : 1); ++rep_) if (EN(PH_AWO) && IN(PH_AWO)) { if (rep_) { SEAM_FORCE(); } MKF(); dense_gemm(F, (const bf16*)(ws + WS_AO), 1024, T, (const bf16*)(ws + WS_WO), 1024, 1024, 1024, (bf16*)(ws + WS_Y), 1024, nullptr); }
    SEAM(PH_AWO);

    { constexpr int layer = 0;
        constexpr int pb = layer == 0 ? PH_M0 : layer == 1 ? PH_M1 : layer == 2 ? PH_M2 : PH_M3;
        for (int rep_ = 0; rep_ < (MK_REP == (100) ? 2 : 1); ++rep_) if (EN(100) && IN(pb)) { if (rep_) { SEAM_FORCE(); } MKF(); ln1_route(F, layer, ka->in[I_LNG], ka->in[I_LNB], ka->in[I_RB]); }
        SEAM(pb);
        LAS int* mt = (LAS int*)(lds0 + LDS_MISC + 256);
        if (IN(pb + 1) || IN(pb + 2)) { MKF();
            if (F.tid < 16) mt[F.tid] = (int)__hip_atomic_load(ctl + CW_CNT + (layer * 16 + F.tid) * 64, __ATOMIC_RELAXED, __HIP_MEMORY_SCOPE_AGENT);
            __syncthreads();
            if (F.tid == 0) { int s = 0; for (int e = 0; e < 16; ++e) { mt[16 + e] = s; s += (mt[e] + 255) >> 8; } mt[32] = s; }
            __syncthreads();
        }
        for (int rep_ = 0; rep_ < (MK_REP == (101) ? 2 : 1); ++rep_) if (EN(101) && IN(pb + 1)) { if (rep_) { SEAM_FORCE(); } MKF();
            tgx::GuSched S{(const char*)(ws + WS_HA), (const char*)(ws + WS_WGU), (const int*)(ws + WS_LIST), mt, F.G, F.vcu, mt[32]};
            tgx::EpiGu E{(bf16*)(ws + WS_HS)};
            tg::tgemm_phase<true>(F.lds, F.tid, 1024, 1024, 1024, S, E);
            TAIL_CONVERT(mt[32] * 8, 1, layer);
        }
        SEAM(pb + 1);
        for (int rep_ = 0; rep_ < (MK_REP == (102) ? 2 : 1); ++rep_) if (EN(102) && IN(pb + 2)) { if (rep_) { SEAM_FORCE(); } MKF();
            tgx::DnSched S{(const char*)(ws + WS_HS), (const char*)(ws + WS_WD), mt, F.G, F.vcu, mt[32]};
            tgx::EpiDn E{(bf16*)(ws + WS_Y2), (const int*)(ws + WS_LIST), (const float*)(ws + WS_TOKW), mt};
            tg::tgemm_phase<false>(F.lds, F.tid, 1024, 1024, 1024, S, E);
            if (layer + 1 < NLAYER) TAIL_CONVERT(mt[32] * 4, 0, layer + 1);
        }
        SEAM(pb + 2);
#ifdef MK_PRE_DELAY
        if (layer == NLAYER - 1 && IN(pb + 3)) { const unsigned long long t0_ = __builtin_amdgcn_s_memrealtime(); while (__builtin_amdgcn_s_memrealtime() - t0_ < (unsigned long long)MK_PRE_DELAY) __builtin_amdgcn_s_sleep(16); }
#endif
        for (int rep_ = 0; rep_ < ((MK_REP == 203 && layer == 3) ? 2 : 1); ++rep_) if (EN(103) && IN(pb + 3)) { if (rep_) { SEAM_FORCE(); } MKF();
            ln2_phase(F, layer, ka->in[I_LNG], ka->in[I_LNB], ka->out);
        }
        if (layer + 1 < NLAYER) SEAM(pb + 3);
    }
    { constexpr int layer = 1;
        if (layer == 1) {
            for (int rep_ = 0; rep_ < (MK_REP == (PH_POOLPRE) ? 2 : 1); ++rep_) if (EN(PH_POOLPRE) && IN(PH_POOLPRE)) { if (rep_) { SEAM_FORCE(); } MKF(); pool_pre(F); }
            SEAM(PH_POOLPRE);
            for (int rep_ = 0; rep_ < (MK_REP == (PH_POOLG) ? 2 : 1); ++rep_) if (EN(PH_POOLG) && IN(PH_POOLG)) { if (rep_) { SEAM_FORCE(); } MKF();
                tgx::PoolSched S{(const char*)(ws + WS_POOLED), (const char*)(ws + WS_POOLW), F.G, F.vcu};
                tgx::EpiScale E{(bf16*)(ws + WS_Y), 1024, ka->in[I_POOLS]};
                tg::tgemm_phase<false>(F.lds, F.tid, 1024, 256, 256, S, E);
            }
            SEAM(PH_POOLG);
        }
    }
    { constexpr int layer = 1;
        constexpr int pb = layer == 0 ? PH_M0 : layer == 1 ? PH_M1 : layer == 2 ? PH_M2 : PH_M3;
        for (int rep_ = 0; rep_ < (MK_REP == (100) ? 2 : 1); ++rep_) if (EN(100) && IN(pb)) { if (rep_) { SEAM_FORCE(); } MKF(); ln1_route(F, layer, ka->in[I_LNG], ka->in[I_LNB], ka->in[I_RB]); }
        SEAM(pb);
        LAS int* mt = (LAS int*)(lds0 + LDS_MISC + 256);
        if (IN(pb + 1) || IN(pb + 2)) { MKF();
            if (F.tid < 16) mt[F.tid] = (int)__hip_atomic_load(ctl + CW_CNT + (layer * 16 + F.tid) * 64, __ATOMIC_RELAXED, __HIP_MEMORY_SCOPE_AGENT);
            __syncthreads();
            if (F.tid == 0) { int s = 0; for (int e = 0; e < 16; ++e) { mt[16 + e] = s; s += (mt[e] + 255) >> 8; } mt[32] = s; }
            __syncthreads();
        }
        for (int rep_ = 0; rep_ < (MK_REP == (101) ? 2 : 1); ++rep_) if (EN(101) && IN(pb + 1)) { if (rep_) { SEAM_FORCE(); } MKF();
            tgx::GuSched S{(const char*)(ws + WS_HA), (const char*)(ws + WS_WGU), (const int*)(ws + WS_LIST), mt, F.G, F.vcu, mt[32]};
            tgx::EpiGu E{(bf16*)(ws + WS_HS)};
            tg::tgemm_phase<true>(F.lds, F.tid, 1024, 1024, 1024, S, E);
            TAIL_CONVERT(mt[32] * 8, 1, layer);
        }
        SEAM(pb + 1);
        for (int rep_ = 0; rep_ < (MK_REP == (102) ? 2 : 1); ++rep_) if (EN(102) && IN(pb + 2)) { if (rep_) { SEAM_FORCE(); } MKF();
            tgx::DnSched S{(const char*)(ws + WS_HS), (const char*)(ws + WS_WD), mt, F.G, F.vcu, mt[32]};
            tgx::EpiDn E{(bf16*)(ws + WS_Y2), (const int*)(ws + WS_LIST), (const float*)(ws + WS_TOKW), mt};
            tg::tgemm_phase<false>(F.lds, F.tid, 1024, 1024, 1024, S, E);
            if (layer + 1 < NLAYER) TAIL_CONVERT(mt[32] * 4, 0, layer + 1);
        }
        SEAM(pb + 2);
#ifdef MK_PRE_DELAY
        if (layer == NLAYER - 1 && IN(pb + 3)) { const unsigned long long t0_ = __builtin_amdgcn_s_memrealtime(); while (__builtin_amdgcn_s_memrealtime() - t0_ < (unsigned long long)MK_PRE_DELAY) __builtin_amdgcn_s_sleep(16); }
#endif
        for (int rep_ = 0; rep_ < ((MK_REP == 203 && layer == 3) ? 2 : 1); ++rep_) if (EN(103) && IN(pb + 3)) { if (rep_) { SEAM_FORCE(); } MKF();
            ln2_phase(F, layer, ka->in[I_LNG], ka->in[I_LNB], ka->out);
        }
        if (layer + 1 < NLAYER) SEAM(pb + 3);
    }
    { constexpr int layer = 2;
        if (layer == 2) {
            for (int rep_ = 0; rep_ < (MK_REP == (PH_F1) ? 2 : 1); ++rep_) if (EN(PH_F1) && IN(PH_F1)) { if (rep_) { SEAM_FORCE(); } MKF();
                { auto mk_ = [=](int u) {
                    const int nt = u & 3, l2 = (u >> 2) & 127, b = u >> 9, col0 = nt * 256;
                    DftP<128, F1_EK> p{};
                    p.A = (const bf16*)(ws + F1_AMAT); p.K = F1_K; p.bs0 = (const bf16*)(ws + WS_HA) + ((size_t)b * SEQ + l2) * 1024 + col0; p.seg1 = 0; p.ksplit = F1_K; p.kstride = 128 * 1024;
                    p.out0 = (bf16*)(ws + WS_FT) + ((size_t)(b * 64) * 128 + l2) * 1024 + col0; p.out1 = p.out0 + PLANE64 / 2; p.rstride = 128 * 1024;
                    p.tw = (const f32x2*)(ws + WS_TWF); p.twi = l2;
                    return p; };
                  sgemm_stream<128, 1>(F.lds, F.tid, mk_, F.vcu, F1_UNITS, F.G); }
            }
            SEAM(PH_F1);
            for (int rep_ = 0; rep_ < (MK_REP == (PH_F2) ? 2 : 1); ++rep_) if (EN(PH_F2) && IN(PH_F2)) { if (rep_) { SEAM_FORCE(); } MKF();
                { auto mk_ = [=](int u) {
                    const int nt = u & 3, k1 = (u >> 2) & 63, b = u >> 8, col0 = nt * 256;
                    DftP<256, E_PLANES> p{};
                    p.A = (const bf16*)(ws + DFT_C256); p.K = 256; p.fbase = 0; p.bs0 = (const bf16*)(ws + WS_FT) + ((size_t)(b * 64 + k1) * 128) * 1024 + col0; p.seg1 = (unsigned)(PLANE64 / 2); p.ksplit = 128; p.kstride = 1024;
                    p.out0 = (bf16*)(ws + WS_PQ) + ((size_t)b * SEQ + k1) * 2048 + col0; p.out1 = p.out0 + 1024; p.rstride = 64 * 2048;
                    return p; };
                  sgemm_stream<256, 1>(F.lds, F.tid, mk_, F.vcu, (NB * 64 * 4), F.G); }
            }
            SEAM(PH_F2);
            for (int rep_ = 0; rep_ < (MK_REP == (PH_F3) ? 2 : 1); ++rep_) if (EN(PH_F3) && IN(PH_F3)) { if (rep_) { SEAM_FORCE(); } MKF(); dense_gemm(F, (const bf16*)(ws + WS_PQ), 2048, T, (const bf16*)(ws + WS_FW), 2048, 1024, 2048, (bf16*)(ws + WS_Y), 1024, ka->in[I_FB]); }
            SEAM(PH_F3);
        }
    }
    { constexpr int layer = 2;
        constexpr int pb = layer == 0 ? PH_M0 : layer == 1 ? PH_M1 : layer == 2 ? PH_M2 : PH_M3;
        for (int rep_ = 0; rep_ < (MK_REP == (100) ? 2 : 1); ++rep_) if (EN(100) && IN(pb)) { if (rep_) { SEAM_FORCE(); } MKF(); ln1_route(F, layer, ka->in[I_LNG], ka->in[I_LNB], ka->in[I_RB]); }
        SEAM(pb);
        LAS int* mt = (LAS int*)(lds0 + LDS_MISC + 256);
        if (IN(pb + 1) || IN(pb + 2)) { MKF();
            if (F.tid < 16) mt[F.tid] = (int)__hip_atomic_load(ctl + CW_CNT + (layer * 16 + F.tid) * 64, __ATOMIC_RELAXED, __HIP_MEMORY_SCOPE_AGENT);
            __syncthreads();
            if (F.tid == 0) { int s = 0; for (int e = 0; e < 16; ++e) { mt[16 + e] = s; s += (mt[e] + 255) >> 8; } mt[32] = s; }
            __syncthreads();
        }
        for (int rep_ = 0; rep_ < (MK_REP == (101) ? 2 : 1); ++rep_) if (EN(101) && IN(pb + 1)) { if (rep_) { SEAM_FORCE(); } MKF();
            tgx::GuSched S{(const char*)(ws + WS_HA), (const char*)(ws + WS_WGU), (const int*)(ws + WS_LIST), mt, F.G, F.vcu, mt[32]};
            tgx::EpiGu E{(bf16*)(ws + WS_HS)};
            tg::tgemm_phase<true>(F.lds, F.tid, 1024, 1024, 1024, S, E);
            TAIL_CONVERT(mt[32] * 8, 1, layer);
        }
        SEAM(pb + 1);
        for (int rep_ = 0; rep_ < (MK_REP == (102) ? 2 : 1); ++rep_) if (EN(102) && IN(pb + 2)) { if (rep_) { SEAM_FORCE(); } MKF();
            tgx::DnSched S{(const char*)(ws + WS_HS), (const char*)(ws + WS_WD), mt, F.G, F.vcu, mt[32]};
            tgx::EpiDn E{(bf16*)(ws + WS_Y2), (const int*)(ws + WS_LIST), (const float*)(ws + WS_TOKW), mt};
            tg::tgemm_phase<false>(F.lds, F.tid, 1024, 1024, 1024, S, E);
            if (layer + 1 < NLAYER) TAIL_CONVERT(mt[32] * 4, 0, layer + 1);
        }
        SEAM(pb + 2);
#ifdef MK_PRE_DELAY
        if (layer == NLAYER - 1 && IN(pb + 3)) { const unsigned long long t0_ = __builtin_amdgcn_s_memrealtime(); while (__builtin_amdgcn_s_memrealtime() - t0_ < (unsigned long long)MK_PRE_DELAY) __builtin_amdgcn_s_sleep(16); }
#endif
        for (int rep_ = 0; rep_ < ((MK_REP == 203 && layer == 3) ? 2 : 1); ++rep_) if (EN(103) && IN(pb + 3)) { if (rep_) { SEAM_FORCE(); } MKF();
            ln2_phase(F, layer, ka->in[I_LNG], ka->in[I_LNB], ka->out);
        }
        if (layer + 1 < NLAYER) SEAM(pb + 3);
    }
    { constexpr int layer = 3;
        if (layer == 3) {
            for (int rep_ = 0; rep_ < (MK_REP == (PH_H1) ? 2 : 1); ++rep_) if (EN(PH_H1) && IN(PH_H1)) { if (rep_) { SEAM_FORCE(); } MKF();
                dense_gemm(F, (const bf16*)(ws + WS_HA), 1024, T, (const bf16*)(ws + WS_HWIN), 1024, 3072, 1024, (bf16*)(ws + WS_Z), 3072, ka->in[I_HBIN]);
                { auto mk_ = [=](int un) {
                    KfP p{(const bf16*)(ws + WS_A2B), (const bf16*)(ws + WS_F3T), (bf16*)(ws + WS_KFULL), un >> 2, un & 3};
                    return p; };
                  sgemm_stream<256, 0>(F.lds, F.tid, mk_, F.vcu, 64 * 4, F.G); }
            }
            SEAM(PH_H1);
            for (int rep_ = 0; rep_ < (MK_REP == (PH_H2) ? 2 : 1); ++rep_) if (EN(PH_H2) && IN(PH_H2)) { if (rep_) { SEAM_FORCE(); } MKF();
                hyena_conv(F, ka->in[I_HCW], ka->in[I_HCB]);
                { auto mk_ = [=](int u) {
                    const int nt = u & 3, n2 = u >> 2, col0 = nt * 256;
                    DftP<256, E_TW> p{};
                    p.A = (const bf16*)(ws + DFT_K1); p.K = 128; p.fbase = 0; p.bs0 = (const bf16*)(ws + WS_KFULL) + (size_t)n2 * 1024 + col0; p.seg1 = 0; p.ksplit = 128; p.kstride = 128 * 1024;
                    p.out0 = (bf16*)(ws + WS_KT) + (size_t)n2 * 1024 + col0; p.out1 = p.out0 + PLANE32 / 2; p.rstride = 128 * 1024;
                    p.tw = (const f32x2*)(ws + WS_TWH); p.twi = n2;
                    return p; };
                  sgemm_stream<256, 1>(F.lds, F.tid, mk_, F.vcu, (128 * 4), F.G); }
            }
            SEAM(PH_H2);
            for (int rep_ = 0; rep_ < (MK_REP == (PH_H3) ? 2 : 1); ++rep_) if (EN(PH_H3) && IN(PH_H3)) { if (rep_) { SEAM_FORCE(); } MKF();
                { auto mk_ = [=](int u) {
                    const int nt = u & 3, s2 = (u >> 2) & 127, pp = u >> 9, col0 = nt * 256;
                    DftP<256, E_TW> p{};
                    p.A = (const bf16*)(ws + DFT_H1); p.K = 128; p.fbase = 0; p.bs0 = (const bf16*)(ws + WS_VP) + ((size_t)(2 * pp) * SEQ + s2) * 1024 + col0; p.seg1 = (unsigned)(SEQ * 1024); p.ksplit = 64; p.kstride = 128 * 1024;
                    p.out0 = (bf16*)(ws + WS_HT) + ((size_t)(pp * 128) * 128 + s2) * 1024 + col0; p.out1 = p.out0 + PLANE64 / 2; p.rstride = 128 * 1024;
                    p.tw = (const f32x2*)(ws + WS_TWH); p.twi = s2;
                    return p; };
                  sgemm_stream<256, 1>(F.lds, F.tid, mk_, F.vcu, (2 * 128 * 4), F.G); }
                { auto mk_ = [=](int u) {
                    const int nt = u & 3, f1 = u >> 2, col0 = nt * 256;
                    DftP<256, E_KHAT> p{};
                    p.A = (const bf16*)(ws + DFT_C256); p.K = 256; p.fbase = 0; p.bs0 = (const bf16*)(ws + WS_KT) + (size_t)(f1 * 128) * 1024 + col0; p.seg1 = (unsigned)(PLANE32 / 2); p.ksplit = 128; p.kstride = 1024;
                    p.kh = (float*)(ws + WS_KH) + ((size_t)(f1 * 128) * 1024 + col0);
                    return p; };
                  sgemm_stream<256, 1>(F.lds, F.tid, mk_, F.vcu, (128 * 4), F.G); }
            }
            SEAM(PH_H3);
            for (int rep_ = 0; rep_ < (MK_REP == (PH_H4) ? 2 : 1); ++rep_) if (EN(PH_H4) && IN(PH_H4)) { if (rep_) { SEAM_FORCE(); } MKF();
                { auto mk_ = [=](int u) {
                    const int nt = u & 3, f1 = (u >> 2) & 127, pp = u >> 9, col0 = nt * 256;
                    DftP<256, E_MULK> p{};
                    p.A = (const bf16*)(ws + DFT_C256); p.K = 256; p.fbase = 0; p.bs0 = (const bf16*)(ws + WS_HT) + ((size_t)(pp * 128 + f1) * 128) * 1024 + col0; p.seg1 = (unsigned)(PLANE64 / 2); p.ksplit = 128; p.kstride = 1024;
                    p.out0 = (bf16*)(ws + WS_YH) + ((size_t)(pp * 128 + f1) * 128) * 1024 + col0; p.out1 = p.out0 + PLANE64 / 2; p.rstride = 1024;
                    p.kh = (float*)(ws + WS_KH) + ((size_t)(f1 * 128) * 1024 + col0);
                    return p; };
                  sgemm_stream<256, 1>(F.lds, F.tid, mk_, F.vcu, (2 * 128 * 4), F.G); }
            }
            SEAM(PH_H4);
            for (int rep_ = 0; rep_ < (MK_REP == (PH_H5) ? 2 : 1); ++rep_) if (EN(PH_H5) && IN(PH_H5)) { if (rep_) { SEAM_FORCE(); } MKF();
                { auto mk_ = [=](int u) {
                    const int nt = u & 3, f1 = (u >> 2) & 127, pp = u >> 9, col0 = nt * 256;
                    DftP<256, E_TWC> p{};
                    p.A = (const bf16*)(ws + DFT_H2B); p.K = 256; p.fbase = 0; p.bs0 = (const bf16*)(ws + WS_YH) + ((size_t)(pp * 128 + f1) * 128) * 1024 + col0; p.seg1 = (unsigned)(PLANE64 / 2); p.ksplit = 128; p.kstride = 1024;
                    p.out0 = (bf16*)(ws + WS_HG) + ((size_t)(pp * 128 + f1) * 128) * 1024 + col0; p.out1 = p.out0 + PLANE64 / 2; p.rstride = 1024;
                    p.tw = (const f32x2*)(ws + WS_TWH); p.twi = f1;
                    return p; };
                  sgemm_stream<256, 1>(F.lds, F.tid, mk_, F.vcu, (2 * 128 * 4), F.G); }
            }
            SEAM(PH_H5);
            for (int rep_ = 0; rep_ < (MK_REP == (PH_H6) ? 2 : 1); ++rep_) if (EN(PH_H6) && IN(PH_H6)) { if (rep_) { SEAM_FORCE(); } MKF();
                { auto mk_ = [=](int u) {
                    const int nt = u & 3, t2 = (u >> 2) & 127, pp = u >> 9, col0 = nt * 256;
                    DftP<128, E_HY> p{};
                    p.A = (const bf16*)(ws + DFT_H3); p.K = 256; p.bs0 = (const bf16*)(ws + WS_HG) + ((size_t)(pp * 128) * 128 + t2) * 1024 + col0; p.seg1 = (unsigned)(PLANE64 / 2); p.ksplit = 128; p.kstride = 128 * 1024;
                    p.out0 = (bf16*)(ws + WS_YX) + (size_t)(2 * pp) * SEQ * 1024 + col0; p.twi = t2;
                    p.vp = (const bf16*)(ws + WS_VP) + (size_t)(2 * pp) * SEQ * 1024 + col0; p.x0 = (const bf16*)(ws + WS_X0) + (size_t)(2 * pp) * SEQ * 1024 + col0; p.skip = ka->in[I_HSKIP] + col0;
                    return p; };
                  sgemm_stream<128, 1>(F.lds, F.tid, mk_, F.vcu, 2 * 128 * 4, F.G); }
            }
            SEAM(PH_H6);
            for (int rep_ = 0; rep_ < (MK_REP == (PH_H7) ? 2 : 1); ++rep_) if (EN(PH_H7) && IN(PH_H7)) { if (rep_) { SEAM_FORCE(); } MKF(); dense_gemm(F, (const bf16*)(ws + WS_YX), 1024, T, (const bf16*)(ws + WS_HWO), 1024, 1024, 1024, (bf16*)(ws + WS_Y), 1024, ka->in[I_HBO]); }
            SEAM(PH_H7);
        }
    }
    { constexpr int layer = 3;
        constexpr int pb = layer == 0 ? PH_M0 : layer == 1 ? PH_M1 : layer == 2 ? PH_M2 : PH_M3;
        for (int rep_ = 0; rep_ < (MK_REP == (100) ? 2 : 1); ++rep_) if (EN(100) && IN(pb)) { if (rep_) { SEAM_FORCE(); } MKF(); ln1_route(F, layer, ka->in[I_LNG], ka->in[I_LNB], ka->in[I_RB]); }
        SEAM(pb);
        LAS int* mt = (LAS int*)(lds0 + LDS_MISC + 256);
        if (IN(pb + 1) || IN(pb + 2)) { MKF();
            if (F.tid < 16) mt[F.tid] = (int)__hip_atomic_load(ctl + CW_CNT + (layer * 16 + F.tid) * 64, __ATOMIC_RELAXED, __HIP_MEMORY_SCOPE_AGENT);
            __syncthreads();
            if (F.tid == 0) { int s = 0; for (int e = 0; e < 16; ++e) { mt[16 + e] = s; s += (mt[e] + 255) >> 8; } mt[32] = s; }
            __syncthreads();
        }
        for (int rep_ = 0; rep_ < (MK_REP == (101) ? 2 : 1); ++rep_) if (EN(101) && IN(pb + 1)) { if (rep_) { SEAM_FORCE(); } MKF();
            tgx::GuSched S{(const char*)(ws + WS_HA), (const char*)(ws + WS_WGU), (const int*)(ws + WS_LIST), mt, F.G, F.vcu, mt[32]};
            tgx::EpiGu E{(bf16*)(ws + WS_HS)};
            tg::tgemm_phase<true>(F.lds, F.tid, 1024, 1024, 1024, S, E);
            TAIL_CONVERT(mt[32] * 8, 1, layer);
        }
        SEAM(pb + 1);
        for (int rep_ = 0; rep_ < (MK_REP == (102) ? 2 : 1); ++rep_) if (EN(102) && IN(pb + 2)) { if (rep_) { SEAM_FORCE(); } MKF();
            tgx::DnSched S{(const char*)(ws + WS_HS), (const char*)(ws + WS_WD), mt, F.G, F.vcu, mt[32]};
            tgx::EpiDn E{(bf16*)(ws + WS_Y2), (const int*)(ws + WS_LIST), (const float*)(ws + WS_TOKW), mt};
            tg::tgemm_phase<false>(F.lds, F.tid, 1024, 1024, 1024, S, E);
            if (layer + 1 < NLAYER) TAIL_CONVERT(mt[32] * 4, 0, layer + 1);
        }
        SEAM(pb + 2);
#ifdef MK_PRE_DELAY
        if (layer == NLAYER - 1 && IN(pb + 3)) { const unsigned long long t0_ = __builtin_amdgcn_s_memrealtime(); while (__builtin_amdgcn_s_memrealtime() - t0_ < (unsigned long long)MK_PRE_DELAY) __builtin_amdgcn_s_sleep(16); }
#endif
        for (int rep_ = 0; rep_ < ((MK_REP == 203 && layer == 3) ? 2 : 1); ++rep_) if (EN(103) && IN(pb + 3)) { if (rep_) { SEAM_FORCE(); } MKF();
            ln2_phase(F, layer, ka->in[I_LNG], ka->in[I_LNB], ka->out);
        }
        if (layer + 1 < NLAYER) SEAM(pb + 3);
    }
#ifdef MK_FINAL_BARRIER
    if (multi) { XcdBarrier b_ = bar; unsigned* bp_ = b_.bar; asm volatile("" : "+s"(bp_)); b_.bar = bp_; xcd_barrier(b_, wave_s); }
#endif
    asm volatile("s_waitcnt vmcnt(0)" ::: "memory");
    __builtin_amdgcn_fence(__ATOMIC_RELEASE, "");
    asm volatile("s_waitcnt vmcnt(0)" ::: "memory");
    if (SETTLE_TICKS > 0 && lo <= NPH - 1 && NPH - 1 < hi) {
        const unsigned long long t0_ = __builtin_amdgcn_s_memrealtime(); while (__builtin_amdgcn_s_memrealtime() - t0_ < (unsigned long long)SETTLE_TICKS) __builtin_amdgcn_s_sleep(16); }
#undef IN
#undef SEAM
}

#ifdef MK_DBG4
__global__ void __launch_bounds__(256) dbg_sweep(const unsigned* p, size_t n, unsigned* sink) {
    unsigned x = 0; for (size_t i = (size_t)blockIdx.x * 256 + threadIdx.x; i < n; i += (size_t)gridDim.x * 256) x ^= p[i];
    if (x == 0x12345678u) sink[0] = x;
}
__global__ void __launch_bounds__(256) dbg_cmp4(const unsigned* h0, const unsigned* h1, float* out) {
    const int row = blockIdx.x * 4 + (threadIdx.x >> 6), lane = threadIdx.x & 63;
    const float vi = h0[2 * row] != h1[2 * row] ? 100.f : 0.f, vo = h0[2 * row + 1] != h1[2 * row + 1] ? 100.f : 0.f;
    for (int i = lane; i < D; i += 64) out[(size_t)row * D + i] = i < 512 ? vi : vo;
}
#endif
#ifdef MK_DBG9
__global__ void __launch_bounds__(256) dbg_copy(const u32x4* src, u32x4* dst, size_t n16) {
    for (size_t i = (size_t)blockIdx.x * 256 + threadIdx.x; i < n16; i += (size_t)gridDim.x * 256) dst[i] = src[i];
}
__global__ void __launch_bounds__(256) dbg_cmp9(const unsigned* a, const unsigned* b, float* out, size_t npairs) {
    for (size_t i = (size_t)blockIdx.x * 256 + threadIdx.x; i < npairs; i += (size_t)gridDim.x * 256) { const float v = (a[i] != b[i]) ? 1.0e4f : 0.f; out[2 * i] = v; out[2 * i + 1] = v; }
}
#endif
#ifdef MK_DBG7
__global__ void __launch_bounds__(256) dbg_y2_hash(const unsigned* Y2, unsigned* h) {
    const int row = blockIdx.x * 4 + (threadIdx.x >> 6), lane = threadIdx.x & 63; unsigned x = 0;
    for (int i = lane; i < 512; i += 64) x = x * 0x9E3779B1u + Y2[(size_t)row * 512 + i] * (2u * i + 1u);
    for (int o = 1; o < 64; o <<= 1) x += __shfl_xor(x, o) * 31u;
    if (lane == 0) h[row] = x;
}
__global__ void __launch_bounds__(256) dbg_cmp7(const unsigned* h0, const unsigned* h1, float* out) {
    const int row = blockIdx.x * 4 + (threadIdx.x >> 6), lane = threadIdx.x & 63; const float v = (h0[2 * row] != h1[2 * row] || h0[2 * row + 1] != h1[2 * row + 1]) ? 100.f : 0.f;
    for (int i = lane; i < D; i += 64) out[(size_t)row * D + i] = v;
}
#endif
#ifdef MK_DBG6
__global__ void __launch_bounds__(256) dbg_hs_hash(const int* LIST, const unsigned* CNT, const unsigned* HS, unsigned* h) {
    const int e = blockIdx.y; int tstart = 0; for (int k = 0; k < e; ++k) tstart += ((int)CNT[k * 64] + 255) >> 8;
    const int cnt = (int)CNT[e * 64], lane = threadIdx.x & 63;
    for (int idx = blockIdx.x * 4 + (threadIdx.x >> 6); idx < cnt; idx += gridDim.x * 4) {
        const unsigned* row = HS + ((size_t)tstart * 256 + idx) * 512; unsigned x = 0;
        for (int i = lane; i < 512; i += 64) x = x * 0x9E3779B1u + row[i] * (2u * i + 1u);
        for (int o = 1; o < 64; o <<= 1) x += __shfl_xor(x, o) * 31u;
        if (lane == 0) h[LIST[(size_t)e * T + idx]] = x;
    }
}
__global__ void __launch_bounds__(256) dbg_cmp6(const unsigned* h0, const unsigned* h1, float* out) {
    const int row = blockIdx.x * 4 + (threadIdx.x >> 6), lane = threadIdx.x & 63; const float v = (h0[row] != h1[row] || h0[row + T] != h1[row + T]) ? 100.f : 0.f;
    for (int i = lane; i < D; i += 64) out[(size_t)row * D + i] = v;
}
#endif
#ifdef MK_DBG5
__global__ void __launch_bounds__(256) dbg_list_mark(const int* LIST, const unsigned* CNT, int* seen) {
    const int e = blockIdx.y; const int cnt = (int)CNT[e * 64];
    for (int i = blockIdx.x * 256 + threadIdx.x; i < cnt; i += gridDim.x * 256) { const int s = LIST[(size_t)e * T + i]; if (s >= 0 && s < 2 * T) atomicAdd(seen + s, 1); else atomicAdd(seen + 2 * T, 1); }
}
__global__ void __launch_bounds__(256) dbg_list_out(const int* seen, float* out) {
    const int row = blockIdx.x * 4 + (threadIdx.x >> 6), lane = threadIdx.x & 63;
    const float v = (seen[row] != 1 || seen[row + T] != 1 || (row == 0 && seen[2 * T] != 0)) ? 100.f : 0.f;
    for (int i = lane; i < D; i += 64) out[(size_t)row * D + i] = v;
}
#endif
#ifdef MK_DBG3
__global__ void __launch_bounds__(256) dbg_hash(const unsigned* out, unsigned* h) {
    const int row = blockIdx.x * 4 + (threadIdx.x >> 6), lane = threadIdx.x & 63; unsigned x = 0;
    for (int i = lane; i < D; i += 64) x = x * 0x9E3779B1u + out[(size_t)row * D + i] * (2u * i + 1u);
    for (int o = 1; o < 64; o <<= 1) x += __shfl_xor(x, o) * 31u;
    if (lane == 0) h[row] = x;
}
__global__ void __launch_bounds__(256) dbg_cmp3(const unsigned* h0, const unsigned* h1, float* out) {
    const int row = blockIdx.x * 4 + (threadIdx.x >> 6), lane = threadIdx.x & 63; const float v = h0[row] != h1[row] ? 100.f : 0.f;
    for (int i = lane; i < D; i += 64) out[(size_t)row * D + i] = v;
}
#endif
#if defined(MK_DBG2) || defined(MK_DBG8)
__global__ void __launch_bounds__(256) dbg_cmp(const unsigned* a, const unsigned* b, float* out, size_t npairs, size_t nout) {
    for (size_t i = (size_t)blockIdx.x * 256 + threadIdx.x; i < npairs; i += (size_t)gridDim.x * 256) out[nout / 2 + i] = (a[i] != b[i]) ? 1.0e4f : 0.f;
}
__global__ void __launch_bounds__(256) dbg_zero(float* out, size_t n) {
    for (size_t i = (size_t)blockIdx.x * 256 + threadIdx.x; i < n; i += (size_t)gridDim.x * 256) out[i] = 0.f;
}
#endif
#ifdef MK_DBG_STOP
__global__ void __launch_bounds__(256) dbg_dump(const unsigned short* src, float* out, size_t n) {
    for (size_t i = (size_t)blockIdx.x * 256 + threadIdx.x; i < n; i += (size_t)gridDim.x * 256) out[i] = __uint_as_float((unsigned)src[i] << 16);
}
#endif
#ifdef MK_TAIL
__global__ void __launch_bounds__(256) dbg_tail(unsigned* p) { p[blockIdx.x * 256 + threadIdx.x] = 1u; }
#endif
extern "C" void kernel_launch(void* const* d_in, const int* in_sizes, int n_in, void* d_out, int out_size, void* d_ws, size_t ws_size, hipStream_t stream) {
    static int grid = 0;
    if (grid == 0) {
        if (n_in != 34 || in_sizes[0] != T * D || out_size != T * D || ws_size < WS_END) {
            fprintf(stderr, "kernel_launch: unexpected shapes: n_in %d in0 %d out %d ws %zu (need %zu)\n", n_in, n_in > 0 ? in_sizes[0] : -1, out_size, ws_size, (size_t)WS_END); grid = -1; return; }
        int dev = 0, cus = 0, per_cu = 0;
        if (hipGetDevice(&dev) != hipSuccess || hipDeviceGetAttribute(&cus, hipDeviceAttributeMultiprocessorCount, dev) != hipSuccess) { grid = -1; return; }
        if (hipFuncSetAttribute((const void*)mk_fwd, hipFuncAttributeMaxDynamicSharedMemorySize, LDS_BYTES) != hipSuccess) { fprintf(stderr, "kernel_launch: hipFuncSetAttribute failed\n"); grid = -1; return; }
        if (hipOccupancyMaxActiveBlocksPerMultiprocessor(&per_cu, (const void*)mk_fwd, NTHR, LDS_BYTES) != hipSuccess || per_cu < 1) fprintf(stderr, "kernel_launch: occupancy query says %d\n", per_cu);
        (void)hipGetLastError();
        grid = 256; while (grid > cus) grid >>= 1;
    }
    if (grid < 0) return;
#ifdef MK_SENT
    (void)hipMemsetAsync(d_out, 0xFF, (size_t)T * D * 4, stream);
#endif
#ifdef MK_POISON
    (void)hipMemsetAsync((char*)d_ws, 0xAA, WS_END, stream);
#endif
    (void)hipMemsetAsync((char*)d_ws + WS_CTL, 0, CTL_BYTES, stream);
    Args a{};
    for (int i = 0; i < 34; ++i) a.in[i] = (const float*)d_in[i];
    a.out = (float*)d_out; a.ws = (unsigned char*)d_ws;
#if MK_ONE_LAUNCH
    a.ph_lo = 0; a.ph_hi = NPH;
    hipLaunchKernelGGL(mk_fwd, dim3(grid), dim3(NTHR), LDS_BYTES, stream, a);
#else
#ifdef MK_DBG9
    for (int k = 0; k <= MK_DBG9; ++k) { a.ph_lo = k; a.ph_hi = k + 1; hipLaunchKernelGGL(mk_fwd, dim3(grid), dim3(NTHR), LDS_BYTES, stream, a); }
    a.ph_lo = MK_DBG9; a.ph_hi = MK_DBG9 + 1; hipLaunchKernelGGL(mk_fwd, dim3(grid), dim3(NTHR), LDS_BYTES, stream, a);
    hipLaunchKernelGGL(dbg_copy, dim3(2048), dim3(256), 0, stream, (const u32x4*)((char*)d_ws + MK_DBG_BUF), (u32x4*)((char*)d_ws + MK_DBG_TMP), (size_t)T * D * 2 / 16);
    hipLaunchKernelGGL(mk_fwd, dim3(grid), dim3(NTHR), LDS_BYTES, stream, a);
    hipLaunchKernelGGL(dbg_cmp9, dim3(2048), dim3(256), 0, stream, (const unsigned*)((char*)d_ws + MK_DBG_TMP), (const unsigned*)((char*)d_ws + MK_DBG_BUF), (float*)d_out, (size_t)T * D / 2);
#elif defined(MK_DBG8)
    for (int k = 0; k <= MK_DBG8; ++k) { a.ph_lo = k; a.ph_hi = k + 1; hipLaunchKernelGGL(mk_fwd, dim3(grid), dim3(NTHR), LDS_BYTES, stream, a); }
#ifdef MK_DBG8_TWICE
    a.ph_lo = MK_DBG8; a.ph_hi = MK_DBG8 + 1; hipLaunchKernelGGL(mk_fwd, dim3(grid), dim3(NTHR), LDS_BYTES, stream, a);
#endif
    (void)hipMemcpyAsync(d_out, (char*)d_ws + MK_DBG_BUF, (size_t)T * D * 2, hipMemcpyDeviceToDevice, stream);
#ifndef MK_DBG8_NOMEMSET
    (void)hipMemsetAsync((char*)d_ws + MK_DBG_BUF, 0xAA, (size_t)T * D * 2, stream);
#endif
    a.ph_lo = MK_DBG8; a.ph_hi = MK_DBG8 + 1; hipLaunchKernelGGL(mk_fwd, dim3(grid), dim3(NTHR), LDS_BYTES, stream, a);
    hipLaunchKernelGGL(dbg_cmp, dim3(2048), dim3(256), 0, stream, (const unsigned*)d_out, (const unsigned*)((char*)d_ws + MK_DBG_BUF), (float*)d_out, (size_t)T * D / 2, (size_t)T * D);
    hipLaunchKernelGGL(dbg_zero, dim3(2048), dim3(256), 0, stream, (float*)d_out, (size_t)T * D / 2);
#elif defined(MK_DBG7)
    for (int k = 0; k <= MK_DBG7; ++k) { a.ph_lo = k; a.ph_hi = k + 1; hipLaunchKernelGGL(mk_fwd, dim3(grid), dim3(NTHR), LDS_BYTES, stream, a); }
    hipLaunchKernelGGL(dbg_y2_hash, dim3(2 * T / 4), dim3(256), 0, stream, (const unsigned*)((char*)d_ws + WS_Y2), (unsigned*)((char*)d_ws + 10 * MiB));
    (void)hipMemsetAsync((char*)d_ws + WS_CTL, 0, CTL_BYTES, stream);
    a.flip = 1;
    for (int k = 0; k <= MK_DBG7; ++k) { a.ph_lo = k; a.ph_hi = k + 1; hipLaunchKernelGGL(mk_fwd, dim3(grid), dim3(NTHR), LDS_BYTES, stream, a); }
    hipLaunchKernelGGL(dbg_y2_hash, dim3(2 * T / 4), dim3(256), 0, stream, (const unsigned*)((char*)d_ws + WS_Y2), (unsigned*)((char*)d_ws + 10 * MiB + 512 * 1024));
    hipLaunchKernelGGL(dbg_cmp7, dim3(T / 4), dim3(256), 0, stream, (const unsigned*)((char*)d_ws + 10 * MiB), (const unsigned*)((char*)d_ws + 10 * MiB + 512 * 1024), (float*)d_out);
#elif defined(MK_DBG6)
    for (int k = 0; k <= MK_DBG6; ++k) { a.ph_lo = k; a.ph_hi = k + 1; hipLaunchKernelGGL(mk_fwd, dim3(grid), dim3(NTHR), LDS_BYTES, stream, a); }
    hipLaunchKernelGGL(dbg_hs_hash, dim3(64, 16), dim3(256), 0, stream, (const int*)((char*)d_ws + WS_LIST), (const unsigned*)((char*)d_ws + WS_CTL) + CW_CNT + MK_DBG6_LAYER * 16 * 64, (const unsigned*)((char*)d_ws + WS_HS), (unsigned*)((char*)d_ws + 10 * MiB));
    (void)hipMemsetAsync((char*)d_ws + WS_CTL, 0, CTL_BYTES, stream);
    a.flip = 1;
    for (int k = 0; k <= MK_DBG6; ++k) { a.ph_lo = k; a.ph_hi = k + 1; hipLaunchKernelGGL(mk_fwd, dim3(grid), dim3(NTHR), LDS_BYTES, stream, a); }
    hipLaunchKernelGGL(dbg_hs_hash, dim3(64, 16), dim3(256), 0, stream, (const int*)((char*)d_ws + WS_LIST), (const unsigned*)((char*)d_ws + WS_CTL) + CW_CNT + MK_DBG6_LAYER * 16 * 64, (const unsigned*)((char*)d_ws + WS_HS), (unsigned*)((char*)d_ws + 10 * MiB + 512 * 1024));
    hipLaunchKernelGGL(dbg_cmp6, dim3(T / 4), dim3(256), 0, stream, (const unsigned*)((char*)d_ws + 10 * MiB), (const unsigned*)((char*)d_ws + 10 * MiB + 512 * 1024), (float*)d_out);
#elif defined(MK_DBG5)
    (void)hipMemsetAsync((char*)d_ws + 10 * MiB, 0, (2 * T + 64) * 4, stream);
    for (int k = 0; k <= MK_DBG5; ++k) { a.ph_lo = k; a.ph_hi = k + 1; hipLaunchKernelGGL(mk_fwd, dim3(grid), dim3(NTHR), LDS_BYTES, stream, a); }
    hipLaunchKernelGGL(dbg_list_mark, dim3(64, 16), dim3(256), 0, stream, (const int*)((char*)d_ws + WS_LIST), (const unsigned*)((char*)d_ws + WS_CTL) + CW_CNT + MK_DBG5_LAYER * 16 * 64, (int*)((char*)d_ws + 10 * MiB));
    hipLaunchKernelGGL(dbg_list_out, dim3(T / 4), dim3(256), 0, stream, (const int*)((char*)d_ws + 10 * MiB), (float*)d_out);
#elif defined(MK_DBG4)
    a.flip = 0;
    for (int k = 0; k < NPH; ++k) { a.ph_lo = k; a.ph_hi = k + 1; hipLaunchKernelGGL(mk_fwd, dim3(grid), dim3(NTHR), LDS_BYTES, stream, a); }
    (void)hipMemsetAsync((char*)d_ws + 12 * MiB, 0xAA, WS_END - 12 * MiB, stream);
    (void)hipMemsetAsync((char*)d_ws, 0xAA, 10 * MiB, stream);
    hipLaunchKernelGGL(dbg_sweep, dim3(4096), dim3(256), 0, stream, (const unsigned*)d_in[31], (size_t)64 * 1024 * 1024, (unsigned*)((char*)d_ws + 9 * MiB));
    (void)hipMemsetAsync((char*)d_ws + WS_CTL, 0, CTL_BYTES, stream);
    a.flip = 1;
    for (int k = 0; k < NPH; ++k) { a.ph_lo = k; a.ph_hi = k + 1; hipLaunchKernelGGL(mk_fwd, dim3(grid), dim3(NTHR), LDS_BYTES, stream, a); }
    hipLaunchKernelGGL(dbg_cmp4, dim3(T / 4), dim3(256), 0, stream, (const unsigned*)((char*)d_ws + 10 * MiB), (const unsigned*)((char*)d_ws + 11 * MiB), (float*)d_out);
#elif defined(MK_DBG3)
    for (int k = 0; k < NPH; ++k) { a.ph_lo = k; a.ph_hi = k + 1; hipLaunchKernelGGL(mk_fwd, dim3(grid), dim3(NTHR), LDS_BYTES, stream, a); }
    hipLaunchKernelGGL(dbg_hash, dim3(T / 4), dim3(256), 0, stream, (const unsigned*)d_out, (unsigned*)((char*)d_ws + 10 * MiB));
#ifdef MK_DBG3_POISON
    (void)hipMemsetAsync((char*)d_ws + 12 * MiB, 0xAA, WS_END - 12 * MiB, stream);
    (void)hipMemsetAsync((char*)d_ws, 0xAA, 10 * MiB, stream);
#endif
    (void)hipMemsetAsync((char*)d_ws + WS_CTL, 0, CTL_BYTES, stream);
    a.flip = 1;
    for (int k = 0; k < NPH; ++k) { a.ph_lo = k; a.ph_hi = k + 1; hipLaunchKernelGGL(mk_fwd, dim3(grid), dim3(NTHR), LDS_BYTES, stream, a); }
    hipLaunchKernelGGL(dbg_hash, dim3(T / 4), dim3(256), 0, stream, (const unsigned*)d_out, (unsigned*)((char*)d_ws + 11 * MiB));
    hipLaunchKernelGGL(dbg_cmp3, dim3(T / 4), dim3(256), 0, stream, (const unsigned*)((char*)d_ws + 10 * MiB), (const unsigned*)((char*)d_ws + 11 * MiB), (float*)d_out);
#elif defined(MK_DBG2)
    for (int k = 0; k <= MK_DBG2; ++k) { a.ph_lo = k; a.ph_hi = k + 1; hipLaunchKernelGGL(mk_fwd, dim3(grid), dim3(NTHR), LDS_BYTES, stream, a); }
    (void)hipMemcpyAsync(d_out, (char*)d_ws + MK_DBG_BUF, (size_t)T * D * 2, hipMemcpyDeviceToDevice, stream);
    (void)hipMemsetAsync((char*)d_ws, 0xAA, WS_END, stream);
    (void)hipMemsetAsync((char*)d_ws + WS_CTL, 0, CTL_BYTES, stream);
    a.flip = 1;
    for (int k = 0; k <= MK_DBG2; ++k) { a.ph_lo = k; a.ph_hi = k + 1; hipLaunchKernelGGL(mk_fwd, dim3(grid), dim3(NTHR), LDS_BYTES, stream, a); }
    hipLaunchKernelGGL(dbg_cmp, dim3(2048), dim3(256), 0, stream, (const unsigned*)d_out, (const unsigned*)((char*)d_ws + MK_DBG_BUF), (float*)d_out, (size_t)T * D / 2, (size_t)T * D);
    hipLaunchKernelGGL(dbg_zero, dim3(2048), dim3(256), 0, stream, (float*)d_out, (size_t)T * D / 2);
#elif defined(MK_DBG_STOP)
    for (int k = 0; k <= MK_DBG_STOP; ++k) { a.ph_lo = k; a.ph_hi = k + 1; hipLaunchKernelGGL(mk_fwd, dim3(grid), dim3(NTHR), LDS_BYTES, stream, a); }
#ifdef MK_DBG_F32
    (void)hipMemcpyAsync(d_out, (char*)d_ws + MK_DBG_BUF, (size_t)T * D * 4, hipMemcpyDeviceToDevice, stream);
#else
    hipLaunchKernelGGL(dbg_dump, dim3(2048), dim3(256), 0, stream, (const unsigned short*)((char*)d_ws + MK_DBG_BUF), (float*)d_out, (size_t)T * D);
#endif
#else
    for (int k = 0; k < NPH; ++k) { a.ph_lo = k; a.ph_hi = k + 1; hipLaunchKernelGGL(mk_fwd, dim3(grid), dim3(NTHR), LDS_BYTES, stream, a); }
#endif
#endif
#ifdef MK_TAIL
    hipLaunchKernelGGL(dbg_tail, dim3(256), dim3(256), 0, stream, (unsigned*)((char*)d_ws + 10 * MiB));
#endif
    const hipError_t le = hipPeekAtLastError();
    if (le != hipSuccess) fprintf(stderr, "kernel_launch: launch failed: %s\n", hipGetErrorName(le));
}
```

```cpp
#include <hip/hip_runtime.h>
#include <cstdio>
#include <cstdint>

#ifndef MK_ONE_LAUNCH
#define MK_ONE_LAUNCH 1
#endif

#define LAS __attribute__((address_space(3)))
#define GAS __attribute__((address_space(1)))
typedef unsigned short bf16;
typedef short bf16x8 __attribute__((ext_vector_type(8)));
typedef short s16x4 __attribute__((ext_vector_type(4)));
typedef short v4i16_t __attribute__((ext_vector_type(4)));
typedef float f32x4 __attribute__((ext_vector_type(4)));
typedef float f32x2 __attribute__((ext_vector_type(2)));
typedef float f32x16 __attribute__((ext_vector_type(16)));
typedef unsigned u32x4 __attribute__((ext_vector_type(4)));
typedef unsigned u32x2 __attribute__((ext_vector_type(2)));

constexpr int D = 1024, NB = 4, SEQ = 8192, T = NB * SEQ, CTXL = 256, TC = NB * CTXL, LK = SEQ + CTXL, MROWS = T + TC;
constexpr int NLAYER = 4, NEXP = 16;
constexpr float ALPHA = 1.681792830507429f;
constexpr float LN_EPS = 1e-5f;
constexpr int NWAVES = 8, NTHR = 512;

constexpr size_t MiB = 1u << 20;
constexpr size_t WS_CTL = 0, CTL_BYTES = 1 * MiB;
constexpr size_t WS_MODV = 1 * MiB;
constexpr size_t WS_ROPE = WS_MODV + 512 * 1024;
constexpr size_t WS_TOKE = 2 * MiB;
constexpr size_t WS_TOKW = WS_TOKE + 256 * 1024;
constexpr size_t WS_LIST = 3 * MiB;
constexpr size_t WS_DFT = 5 * MiB;
constexpr size_t DFT_F1 = WS_DFT;
constexpr size_t DFT_C256 = DFT_F1 + 128 * 64 * 2;
constexpr size_t DFT_K1 = DFT_C256 + 256 * 256 * 2;
constexpr size_t DFT_H1 = DFT_K1 + 256 * 128 * 2;
constexpr size_t DFT_H2B = DFT_H1 + 256 * 128 * 2;
constexpr size_t DFT_H3 = DFT_H2B + 256 * 256 * 2;
constexpr size_t WS_TWF = 6 * MiB;
constexpr size_t WS_TWH = WS_TWF + 64 * 128 * 8;
constexpr size_t WS_A2 = 8 * MiB;
constexpr size_t WS_A2B = 11 * MiB;
constexpr size_t WS_TRIG = WS_DFT + 512 * 1024;
constexpr size_t WS_WFB = 13 * MiB;
constexpr size_t WS_RWT = 15 * MiB;
constexpr size_t WS_F3T = 12 * MiB;
constexpr size_t WS_WQKV = 16 * MiB;
constexpr size_t WS_WO = 22 * MiB;
constexpr size_t WS_POOLW = 24 * MiB;
constexpr size_t WS_FW = 25 * MiB;
constexpr size_t WS_HWIN = 29 * MiB;
constexpr size_t WS_HWO = 35 * MiB;
constexpr size_t WS_WGU = 40 * MiB;
constexpr size_t WS_WD = 104 * MiB;
constexpr size_t WS_XR = 136 * MiB;
constexpr size_t WS_HA = 200 * MiB;
constexpr size_t AR = 268 * MiB;
constexpr size_t WS_Q = AR, WS_K = AR + 64 * MiB, WS_V = AR + 130 * MiB, WS_AO = AR + 196 * MiB;
constexpr size_t WS_Y = AR + 260 * MiB;
constexpr size_t WS_HS = AR + 324 * MiB;
constexpr size_t WS_Y2 = AR + 460 * MiB;
constexpr size_t WS_POOLED = AR;
constexpr size_t WS_FT = AR, WS_PQ = AR + 128 * MiB;
constexpr size_t WS_Z = AR, WS_VP = AR + 192 * MiB, WS_X0 = AR + 324 * MiB;
constexpr size_t WS_HT = AR, WS_HG = AR;
constexpr size_t WS_YH = AR + 388 * MiB, WS_YX = AR + 388 * MiB;
constexpr size_t WS_KH = AR + 516 * MiB;
constexpr size_t WS_KFULL = AR + 644 * MiB;
constexpr size_t WS_KT = AR + 676 * MiB;
constexpr size_t WS_END = AR + 756 * MiB;
constexpr size_t PLANE64 = 64 * MiB, PLANE32 = 32 * MiB;

constexpr int CW_BAR = 4096;
constexpr int CW_CNT = 16384;

constexpr int LDS_SCRATCH = 147456;
constexpr int LDS_MISC = LDS_SCRATCH;
constexpr int LDS_BYTES = LDS_SCRATCH + 8192;

__device__ __forceinline__ float bf2f(unsigned short u) { return __uint_as_float((unsigned)u << 16); }
__device__ __forceinline__ float bflo(unsigned w) { return __uint_as_float(w << 16); }
__device__ __forceinline__ float bfhi(unsigned w) { return __uint_as_float(w & 0xffff0000u); }
__device__ __forceinline__ unsigned pk2(float lo, float hi) { unsigned r; asm("v_cvt_pk_bf16_f32 %0, %1, %2" : "=v"(r) : "v"(lo), "v"(hi)); return r; }
__device__ __forceinline__ float fsin_rev(float rev) { return __builtin_amdgcn_sinf(rev); }
__device__ __forceinline__ float fcos_rev(float rev) { return __builtin_amdgcn_cosf(rev); }
__device__ __forceinline__ float frcp(float x) { return __builtin_amdgcn_rcpf(x); }
__device__ __forceinline__ float fsilu(float x) { return x * frcp(1.f + __expf(-x)); }
template <int CTRL> __device__ __forceinline__ float dpp_mov(float x) { return __builtin_bit_cast(float, __builtin_amdgcn_mov_dpp(__builtin_bit_cast(int, x), CTRL, 0xf, 0xf, true)); }
__device__ __forceinline__ float row16_sum(float v) { v += dpp_mov<0xB1>(v); v += dpp_mov<0x4E>(v); v += dpp_mov<0x124>(v); v += dpp_mov<0x128>(v); return v; }
__device__ __forceinline__ float wave_sum(float v) {
    v = row16_sum(v);
    { auto s_ = __builtin_amdgcn_permlane16_swap(__float_as_uint(v), __float_as_uint(v), false, false); v = __uint_as_float(s_[0]) + __uint_as_float(s_[1]); }
    { auto t_ = __builtin_amdgcn_permlane32_swap(__float_as_uint(v), __float_as_uint(v), false, false); v = __uint_as_float(t_[0]) + __uint_as_float(t_[1]); }
    return v;
}
#define LDS_WAIT() asm volatile("s_waitcnt lgkmcnt(0)" ::: "memory")
#define VM_WAIT() asm volatile("s_waitcnt vmcnt(0)" ::: "memory")

#define XB_TMO      128
#define XB_XCNT(j)  (256  + 64 * (j))
#define XB_XSUB(j)  (1280 + 64 * (j))
#define XB_XGEN(j)  (2304 + 64 * (j))
#define XB_TOP      3328
#define XB_TOPGEN   3392
#define XCD_BAR_WORDS 3456
#define XB_SPIN_CAP (1u << 22)

__device__ __forceinline__ unsigned xb_ld(unsigned* p)              { return __hip_atomic_load(p, __ATOMIC_RELAXED, __HIP_MEMORY_SCOPE_AGENT); }
__device__ __forceinline__ unsigned xb_add(unsigned* p, unsigned v) { return __hip_atomic_fetch_add(p, v, __ATOMIC_RELAXED, __HIP_MEMORY_SCOPE_AGENT); }
__device__ __forceinline__ unsigned xb_xcc_id() { return (unsigned)__builtin_amdgcn_s_getreg((3 << 11) | 20) & 0xFu; }
#define XB_SPIN(cond, bar) do { unsigned _sp = 0; while (cond) { __builtin_amdgcn_s_sleep(1); \
    if ((++_sp & 255u) == 0u) { if (xb_ld(&(bar)[XB_TMO])) break; if (_sp > XB_SPIN_CAP) { atomicAdd(&(bar)[XB_TMO], 1u); break; } } } } while (0)

struct XcdBarrier { unsigned* bar; unsigned x; volatile LAS unsigned* st; };

__device__ __forceinline__ int lane_id() { int l; asm volatile("v_mbcnt_lo_u32_b32 %0, -1, 0\n\tv_mbcnt_hi_u32_b32 %0, -1, %0" : "=v"(l)); return l; }
__device__ __forceinline__ XcdBarrier xcd_barrier_post(unsigned* bar, volatile LAS unsigned* st, int wave_s) {
    XcdBarrier b; b.bar = bar; b.x = xb_xcc_id(); b.st = st;
    if (wave_s == 0 && lane_id() == 0) (void)xb_add(&bar[XB_XCNT(b.x)], 1u);
    return b;
}
__device__ __forceinline__ void xcd_barrier_complete(unsigned* bar, unsigned x, unsigned& nloc, unsigned& nx) {
    const unsigned G = gridDim.x * gridDim.y * gridDim.z;
    unsigned sum, cnt, mine, sp = 0u;
    for (;;) {
        sum = 0u; cnt = 0u; mine = 0u;
#pragma unroll
        for (unsigned j = 0; j < 16; ++j) { const unsigned c = xb_ld(&bar[XB_XCNT(j)]); sum += c; cnt += (c > 0u) ? 1u : 0u; mine = (j == x) ? c : mine; }
        if (sum == G) break;
        __builtin_amdgcn_s_sleep(1);
        if ((++sp & 255u) == 0u) { if (xb_ld(&bar[XB_TMO])) break; if (sp > XB_SPIN_CAP) { atomicAdd(&bar[XB_TMO], 1u); break; } }
    }
    nloc = mine > 0u ? mine : 1u; nx = cnt > 0u ? cnt : 1u;
}
__device__ __forceinline__ void xcd_barrier(const XcdBarrier& b, int wave_s) {
    asm volatile("s_waitcnt vmcnt(0)" ::: "memory");
    __syncthreads();
    if (wave_s == 0 && lane_id() == 0) {
        unsigned* bar = b.bar;
        __builtin_amdgcn_s_waitcnt(0);
        unsigned nloc = b.st[0], nx = b.st[1];
        if (nloc == 0u) { xcd_barrier_complete(bar, b.x, nloc, nx); b.st[0] = nloc; b.st[1] = nx; }
        const unsigned old = xb_add(&bar[XB_XSUB(b.x)], 1u);
        const unsigned gen = old / nloc;
        if (old + 1u == (gen + 1u) * nloc) {
            __builtin_amdgcn_fence(__ATOMIC_RELEASE, "agent");
            asm volatile("s_waitcnt vmcnt(0)" ::: "memory");
            const unsigned og = xb_add(&bar[XB_TOP], 1u);
            const unsigned tg = og / nx;
            if (og + 1u == (tg + 1u) * nx) xb_add(&bar[XB_TOPGEN], 1u);
            else XB_SPIN(xb_ld(&bar[XB_TOPGEN]) == tg, bar);
            __builtin_amdgcn_fence(__ATOMIC_ACQUIRE, "agent");
            xb_add(&bar[XB_XGEN(b.x)], 1u);
            asm volatile("s_waitcnt vmcnt(0)" ::: "memory");
        } else {
            XB_SPIN(xb_ld(&bar[XB_XGEN(b.x)]) == gen, bar);
            __builtin_amdgcn_fence(__ATOMIC_ACQUIRE, "agent");
            asm volatile("s_waitcnt vmcnt(0)" ::: "memory");
        }
    }
    __syncthreads();
}
constexpr int SG_PA = 144, SG_ABYTES = 256 * SG_PA, SG_PBK = 544, SG_STAGE = 2 * SG_ABYTES;
static_assert(64 * SG_PBK <= SG_ABYTES && 2 * SG_STAGE <= LDS_SCRATCH, "sgemm LDS");

__device__ __forceinline__ s16x4 ds_tr(unsigned addr) {
    return __builtin_bit_cast(s16x4, __builtin_amdgcn_ds_read_tr16_b64_v4i16((LAS v4i16_t*)(uintptr_t)addr));
}

template <int MT, int BKIND, class P>
__device__ __forceinline__ void sgemm_unit(LAS unsigned char* lds, const int tid_in, const P& p) {
    int tid = tid_in; asm volatile("" : "+v"(tid));
#ifdef MK_SG_ENTRY_SYNC
    __syncthreads();
#endif
    constexpr int MB = MT / 32, NA = MT / 64;
    const int lane = tid & 63, wid = tid >> 6, wr = wid >> 2, wc = wid & 3, fr = lane & 15, fq = lane >> 4;
    f32x4 acc[MB][4];
#pragma unroll
    for (int a = 0; a < MB; ++a)
#pragma unroll
        for (int b = 0; b < 4; ++b) acc[a][b] = (f32x4){0.f, 0.f, 0.f, 0.f};
    int nk = p.K >> 6;
    asm volatile("" : "+s"(nk));
    const int srow = tid >> 3, sch = tid & 7;
    const int krow = tid >> 5, kch = tid & 31;
    const char* abase = (const char*)p.abase(); const char* bbase = (const char*)p.bbase();
    unsigned oa[NA], ob[4];
#pragma unroll
    for (int i = 0; i < NA; ++i) oa[i] = (p.aoff(srow + 64 * i) + sch * 8) * 2u;
    if constexpr (BKIND == 0) {
#pragma unroll
        for (int i = 0; i < 4; ++i) ob[i] = (p.boff(srow + 64 * i) + sch * 8) * 2u;
    }
    u32x4 ra[NA], rb[4];
    const unsigned lbase = (unsigned)(uintptr_t)lds;
    const unsigned wa_off = (unsigned)(srow * SG_PA + sch * 16);
    const unsigned wb_off = BKIND == 0 ? (unsigned)(srow * SG_PA + sch * 16) : (unsigned)(krow * SG_PBK + kch * 16);
#define SG_GLOAD(kt) do { \
        _Pragma("unroll") for (int i = 0; i < NA; ++i) ra[i] = *(const u32x4*)(abase + (size_t)(oa[i] + (unsigned)(kt) * 128u)); \
        if constexpr (BKIND == 0) { _Pragma("unroll") for (int i = 0; i < 4; ++i) rb[i] = *(const u32x4*)(bbase + (size_t)(ob[i] + (unsigned)(kt) * 128u)); } \
        else { _Pragma("unroll") for (int i = 0; i < 4; ++i) rb[i] = *(const u32x4*)(bbase + (size_t)((p.boff((kt) * 64 + krow + 16 * i) + kch * 8) * 2u)); } } while (0)
#define SG_LWRITE(st) do { const unsigned sb_ = lbase + (st) * SG_STAGE; \
        _Pragma("unroll") for (int i = 0; i < NA; ++i) *(LAS u32x4*)(uintptr_t)(sb_ + wa_off + i * 64 * SG_PA) = ra[i]; \
        _Pragma("unroll") for (int i = 0; i < 4; ++i) *(LAS u32x4*)(uintptr_t)(sb_ + SG_ABYTES + wb_off + i * (BKIND == 0 ? 64 * SG_PA : 16 * SG_PBK)) = rb[i]; } while (0)
    const unsigned fa_off = (unsigned)((wr * (MT / 2) + fr) * SG_PA + fq * 16);
    const unsigned fb_off = BKIND == 0 ? (unsigned)((wc * 64 + fr) * SG_PA + fq * 16)
                                       : (unsigned)((8 * fq + (fr >> 2)) * SG_PBK + (wc * 64 + 4 * (fr & 3)) * 2);
    SG_GLOAD(0);
    SG_LWRITE(0);
    __syncthreads();
#pragma nounroll
    for (int kt = 0; kt < nk; ++kt) {
        const int st = kt & 1;
        if (kt + 1 < nk) SG_GLOAD(kt + 1);
        const unsigned sa = lbase + st * SG_STAGE, sb = sa + SG_ABYTES;
#pragma unroll
        for (int ks = 0; ks < 2; ++ks) {
            bf16x8 bfr[4];
            if constexpr (BKIND == 0) {
#pragma unroll
                for (int nb = 0; nb < 4; ++nb) bfr[nb] = *(const LAS bf16x8*)(uintptr_t)(sb + fb_off + nb * 16 * SG_PA + ks * 64);
            } else {
#pragma unroll
                for (int nb = 0; nb < 4; ++nb) {
                    const s16x4 lo = ds_tr(sb + fb_off + ks * 32 * SG_PBK + nb * 32), hi = ds_tr(sb + fb_off + (ks * 32 + 4) * SG_PBK + nb * 32);
                    bfr[nb] = (bf16x8){lo[0], lo[1], lo[2], lo[3], hi[0], hi[1], hi[2], hi[3]};
                }
            }
#pragma unroll
            for (int mg = 0; mg < MB; mg += 4) {
                bf16x8 af[4];
#pragma unroll
                for (int mb = 0; mb < 4; ++mb) af[mb] = *(const LAS bf16x8*)(uintptr_t)(sa + fa_off + (mg + mb) * 16 * SG_PA + ks * 64);
#pragma unroll
                for (int mb = 0; mb < 4; ++mb)
#pragma unroll
                    for (int nb = 0; nb < 4; ++nb) acc[mg + mb][nb] = __builtin_amdgcn_mfma_f32_16x16x32_bf16(bfr[nb], af[mb], acc[mg + mb][nb], 0, 0, 0);
                if (MB > 4) __builtin_amdgcn_sched_barrier(0);
            }
            if (MB > 4) __builtin_amdgcn_sched_barrier(0);
        }
        if (kt + 1 < nk) SG_LWRITE(st ^ 1);
        __syncthreads();
    }
#undef SG_GLOAD
#undef SG_LWRITE
    p.epi(acc, wr, wc, fr, fq);
}

template <int MT, int BKIND, class Gen>
__device__ __forceinline__ void sgemm_stream(LAS unsigned char* lds, const int tid_in, const Gen& gen, const int u0, const int uN, const int ustep) {
    if (u0 >= uN) return;
    int tid = tid_in; asm volatile("" : "+v"(tid));
    constexpr int MB = MT / 32, NA = MT / 64;
    const int lane = tid & 63, wid = tid >> 6, wr = wid >> 2, wc = wid & 3, fr = lane & 15, fq = lane >> 4;
    const int srow = tid >> 3, sch = tid & 7, krow = tid >> 5, kch = tid & 31;
    u32x4 ra[NA], rb[4];
    const unsigned lbase = (unsigned)(uintptr_t)lds;
    const unsigned wa_off = (unsigned)(srow * SG_PA + sch * 16);
    const unsigned wb_off = BKIND == 0 ? (unsigned)(srow * SG_PA + sch * 16) : (unsigned)(krow * SG_PBK + kch * 16);
    const unsigned fa_off = (unsigned)((wr * (MT / 2) + fr) * SG_PA + fq * 16);
    const unsigned fb_off = BKIND == 0 ? (unsigned)((wc * 64 + fr) * SG_PA + fq * 16)
                                       : (unsigned)((8 * fq + (fr >> 2)) * SG_PBK + (wc * 64 + 4 * (fr & 3)) * 2);
#define SGS_GLOAD(P_, kt) do { const char* ab_ = (const char*)(P_).abase(); const char* bb_ = (const char*)(P_).bbase(); \
        _Pragma("unroll") for (int i = 0; i < NA; ++i) ra[i] = *(const u32x4*)(ab_ + (size_t)(((P_).aoff(srow + 64 * i) + sch * 8) * 2u + (unsigned)(kt) * 128u)); \
        if constexpr (BKIND == 0) { _Pragma("unroll") for (int i = 0; i < 4; ++i) rb[i] = *(const u32x4*)(bb_ + (size_t)(((P_).boff(srow + 64 * i) + sch * 8) * 2u + (unsigned)(kt) * 128u)); } \
        else { _Pragma("unroll") for (int i = 0; i < 4; ++i) rb[i] = *(const u32x4*)(bb_ + (size_t)(((P_).boff((kt) * 64 + krow + 16 * i) + kch * 8) * 2u)); } } while (0)
#define SGS_LWRITE(st) do { const unsigned sb_ = lbase + (st) * SG_STAGE; \
        _Pragma("unroll") for (int i = 0; i < NA; ++i) *(LAS u32x4*)(uintptr_t)(sb_ + wa_off + i * 64 * SG_PA) = ra[i]; \
        _Pragma("unroll") for (int i = 0; i < 4; ++i) *(LAS u32x4*)(uintptr_t)(sb_ + SG_ABYTES + wb_off + i * (BKIND == 0 ? 64 * SG_PA : 16 * SG_PBK)) = rb[i]; } while (0)
    auto cur = gen(u0);
    int g = 0;
    SGS_GLOAD(cur, 0); SGS_LWRITE(0); __syncthreads();
    for (int u = u0; u < uN; u += ustep) {
        const int un = u + ustep; const bool hn = un < uN;
        auto nxt = gen(hn ? un : u);
        f32x4 acc[MB][4];
#pragma unroll
        for (int a = 0; a < MB; ++a)
#pragma unroll
            for (int b = 0; b < 4; ++b) acc[a][b] = (f32x4){0.f, 0.f, 0.f, 0.f};
        int nk = cur.K >> 6; asm volatile("" : "+s"(nk));
#pragma nounroll
        for (int kt = 0; kt < nk; ++kt) {
            const int st = g & 1;
            if (kt + 1 < nk) SGS_GLOAD(cur, kt + 1); else if (hn) SGS_GLOAD(nxt, 0);
            const unsigned sa = lbase + st * SG_STAGE, sb = sa + SG_ABYTES;
#pragma unroll
            for (int ks = 0; ks < 2; ++ks) {
                bf16x8 bfr[4];
                if constexpr (BKIND == 0) {
#pragma unroll
                    for (int nb = 0; nb < 4; ++nb) bfr[nb] = *(const LAS bf16x8*)(uintptr_t)(sb + fb_off + nb * 16 * SG_PA + ks * 64);
                } else {
#pragma unroll
                    for (int nb = 0; nb < 4; ++nb) {
                        const s16x4 lo = ds_tr(sb + fb_off + ks * 32 * SG_PBK + nb * 32), hi = ds_tr(sb + fb_off + (ks * 32 + 4) * SG_PBK + nb * 32);
                        bfr[nb] = (bf16x8){lo[0], lo[1], lo[2], lo[3], hi[0], hi[1], hi[2], hi[3]};
                    }
                }
#pragma unroll
                for (int mg = 0; mg < MB; mg += 4) {
                    bf16x8 af[4];
#pragma unroll
                    for (int mb = 0; mb < 4; ++mb) af[mb] = *(const LAS bf16x8*)(uintptr_t)(sa + fa_off + (mg + mb) * 16 * SG_PA + ks * 64);
#pragma unroll
                    for (int mb = 0; mb < 4; ++mb)
#pragma unroll
                        for (int nb = 0; nb < 4; ++nb) acc[mg + mb][nb] = __builtin_amdgcn_mfma_f32_16x16x32_bf16(bfr[nb], af[mb], acc[mg + mb][nb], 0, 0, 0);
                    if (MB > 4) __builtin_amdgcn_sched_barrier(0);
                }
                if (MB > 4) __builtin_amdgcn_sched_barrier(0);
            }
            if (kt + 1 < nk || hn) SGS_LWRITE(st ^ 1);
            __syncthreads(); ++g;
        }
        cur.epi(acc, wr, wc, fr, fq);
        cur = nxt;
    }
#undef SGS_GLOAD
#undef SGS_LWRITE
}
namespace tg {
constexpr int BK = 64, HALF = 128, HTB = HALF * BK * 2, STAGE_BYTES = 8 * HTB;
static_assert(STAGE_BYTES + 16384 <= LDS_SCRATCH, "tgemm LDS");
__device__ __forceinline__ int lds_byte(int r, int c) { const int st = (r >> 4) * 2 + (c >> 5), rr = r & 15, cc = c & 31, ob = rr * 64 + cc * 2; return st * 1024 + (ob ^ (((ob >> 9) & 1) << 5)); }
__device__ __forceinline__ void stage_rc(int b, int& R, int& C) { const int st = b / 1024, sb = b % 1024, swz = sb ^ (((sb >> 9) & 1) << 5); R = (st >> 1) * 16 + swz / 64; C = (st & 1) * 32 + (swz % 64) / 2; }

struct TUnit { const char* a; const char* b; int i0, i1, i2, i3; };

template <bool GATHER, class Sched, class Epi>
__device__ __forceinline__ void tgemm_phase(LAS unsigned char* lds, const int tid_in, const int lda, const int ldb, const int K, const Sched& S, const Epi& E) {
    int tid = tid_in; asm volatile("" : "+v"(tid));
    const int wid = __builtin_amdgcn_readfirstlane(tid >> 6), lane = tid & 63, wr = wid >> 2, wc = wid & 3, fr = lane & 15, fq = lane >> 4;
    const int nt = K / BK;
    unsigned vB[2]; { int R0, C0, R1, C1; stage_rc(tid * 16, R0, C0); stage_rc(tid * 16 + 8192, R1, C1); vB[0] = (unsigned)(R0 * ldb + C0) * 2u; vB[1] = (unsigned)(R1 * ldb + C1) * 2u; }
    const unsigned hstepB = (unsigned)HALF * (unsigned)ldb * 2u;
    unsigned vA[2][2];
    LAS u32x2* const park = (LAS u32x2*)(lds + STAGE_BYTES) + tid * 4;
    const size_t kstep = (size_t)(BK * 2);
    const unsigned ldsw = (unsigned)wid * 1024u;
    const int aoff = lds_byte(wr * 64 + fr, fq * 8), boff = lds_byte(wc * 32 + fr, fq * 8);
#define TG_SA(b, h) (((b) * 2 + (h)) * HTB)
#define TG_SB(b, h) ((4 + (b) * 2 + (h)) * HTB)
#define TG_STAGE2(bufoff, gbase, o0, o1) do { \
        __builtin_amdgcn_global_load_lds((const unsigned*)((const char*)(gbase) + (o0)), (LAS unsigned*)(lds + (bufoff) + ldsw), 16, 0, 0); \
        __builtin_amdgcn_global_load_lds((const unsigned*)((const char*)(gbase) + (o1)), (LAS unsigned*)(lds + (bufoff) + ldsw + 8192), 16, 0, 0); } while (0)
#define TG_STAGE_B(bufoff, gbase, h) TG_STAGE2(bufoff, (gbase) + (size_t)(h) * hstepB, vB[0], vB[1])
#define TG_STAGE_A(bufoff, gbase, h, nx) do { if constexpr (GATHER) { const u32x2 q_ = park[((nx) ? 2 : 0) + (h)]; TG_STAGE2(bufoff, gbase, q_.x, q_.y); } else TG_STAGE2(bufoff, gbase, vA[h][0], vA[h][1]); } while (0)
#define TG_LDA(dst, b, h) do { _Pragma("unroll") for (int m = 0; m < 4; ++m) _Pragma("unroll") for (int k = 0; k < 2; ++k) dst[m][k] = *(const LAS bf16x8*)(lds + TG_SA(b, h) + aoff + m * 2048 + k * 1024); } while (0)
#define TG_LDB(dst, b, h) do { _Pragma("unroll") for (int n = 0; n < 2; ++n) _Pragma("unroll") for (int k = 0; k < 2; ++k) dst[n][k] = *(const LAS bf16x8*)(lds + TG_SB(b, h) + boff + n * 2048 + k * 1024); } while (0)
#define TG_MMA(ai, bj, At, Bt) do { __builtin_amdgcn_s_setprio(1); _Pragma("unroll") for (int m = 0; m < 4; ++m) _Pragma("unroll") for (int n = 0; n < 2; ++n) _Pragma("unroll") for (int k = 0; k < 2; ++k) \
        acc[ai][bj][m][n] = __builtin_amdgcn_mfma_f32_16x16x32_bf16(Bt[n][k], At[m][k], acc[ai][bj][m][n], 0, 0, 0); __builtin_amdgcn_s_setprio(0); } while (0)
#define TG_WAIT_V(n) asm volatile("s_waitcnt vmcnt(" #n ")" ::: "memory")
#define TG_WAIT_L(n) asm volatile("s_waitcnt lgkmcnt(" #n ")" ::: "memory")
#define TG_BAR __builtin_amdgcn_s_barrier()
#define TG_SCHED __builtin_amdgcn_sched_barrier(0)
#define TG_SETOFF(dst, u) do { int tz_ = tid_in; asm volatile("" : "+v"(tz_)); int r0_, c0_, r1_, c1_; stage_rc(tz_ * 16, r0_, c0_); stage_rc(tz_ * 16 + 8192, r1_, c1_); \
        _Pragma("unroll") for (int h = 0; h < 2; ++h) { \
        if constexpr (GATHER) { dst[h][0] = (unsigned)(S.arow(u, h * HALF + r0_) * lda + c0_) * 2u; dst[h][1] = (unsigned)(S.arow(u, h * HALF + r1_) * lda + c1_) * 2u; } \
        else { dst[h][0] = (unsigned)((h * HALF + r0_) * lda + c0_) * 2u; dst[h][1] = (unsigned)((h * HALF + r1_) * lda + c1_) * 2u; } } } while (0)
    TUnit cur, nxt; int ui = 0;
    if (!S.next(0, cur)) return;
    f32x4 acc[2][2][4][2];
#pragma unroll
    for (int a = 0; a < 2; ++a)
#pragma unroll
        for (int b = 0; b < 2; ++b)
#pragma unroll
            for (int m = 0; m < 4; ++m)
#pragma unroll
                for (int n = 0; n < 2; ++n) acc[a][b][m][n] = (f32x4){0.f, 0.f, 0.f, 0.f};
    bf16x8 At[4][2], B0[2][2], B1[2][2];
    const char* cA = cur.a; const char* cB = cur.b;
    TG_SETOFF(vA, cur);
    if constexpr (GATHER) { park[0] = (u32x2){vA[0][0], vA[0][1]}; park[1] = (u32x2){vA[1][0], vA[1][1]}; }
    TG_STAGE_B(TG_SB(0, 0), cB, 0); TG_STAGE_B(TG_SB(0, 1), cB, 1); TG_STAGE_A(TG_SA(0, 0), cA, 0, false); TG_STAGE_A(TG_SA(0, 1), cA, 1, false);
    if (wr == 1) TG_BAR;
    TG_WAIT_V(2); TG_BAR;
    TG_STAGE_B(TG_SB(1, 0), cB + kstep, 0); TG_STAGE_A(TG_SA(1, 0), cA + kstep, 0, false); TG_STAGE_B(TG_SB(1, 1), cB + kstep, 1);
    TG_WAIT_V(6); TG_BAR;
    for (;;) {
        const bool has_next = S.next(ui + 1, nxt);
        const char* nA = has_next ? nxt.a : cA; const char* nB = has_next ? nxt.b : cB;
        if constexpr (GATHER) { if (has_next) { unsigned q[2][2]; TG_SETOFF(q, nxt); park[2] = (u32x2){q[0][0], q[0][1]}; park[3] = (u32x2){q[1][0], q[1][1]}; } else { park[2] = park[0]; park[3] = park[1]; } }
        for (int t = 0; t < nt; t += 2) {
            const bool last = (t == nt - 2);
            const char* a1 = cA + (size_t)(t + 1) * kstep;
            const char* a2 = last ? nA : cA + (size_t)(t + 2) * kstep; const char* b2 = last ? nB : cB + (size_t)(t + 2) * kstep;
            const char* a3 = a2 + kstep; const char* b3 = b2 + kstep;
            TG_LDB(B0, 0, 0); TG_LDB(B1, 0, 1); TG_SCHED; TG_LDA(At, 0, 0); TG_STAGE_A(TG_SA(1, 1), a1, 1, false);
            TG_WAIT_V(8); TG_WAIT_L(0); TG_BAR; TG_MMA(0, 0, At, B0); TG_MMA(0, 1, At, B1); TG_BAR; TG_SCHED;
            TG_LDA(At, 0, 1); TG_STAGE_B(TG_SB(0, 0), b2, 0); TG_STAGE_B(TG_SB(0, 1), b2, 1); TG_STAGE_A(TG_SA(0, 0), a2, 0, last);
            TG_WAIT_V(8); TG_WAIT_L(0); TG_BAR; TG_MMA(1, 0, At, B0); TG_MMA(1, 1, At, B1); TG_BAR; TG_SCHED;
            TG_LDB(B0, 1, 0); TG_LDB(B1, 1, 1); TG_SCHED; TG_LDA(At, 1, 0); TG_STAGE_A(TG_SA(0, 1), a2, 1, last);
            TG_WAIT_V(8); TG_WAIT_L(0); TG_BAR; TG_MMA(0, 0, At, B0); TG_MMA(0, 1, At, B1); TG_BAR; TG_SCHED;
            TG_LDA(At, 1, 1); TG_STAGE_B(TG_SB(1, 0), b3, 0); TG_STAGE_B(TG_SB(1, 1), b3, 1); TG_STAGE_A(TG_SA(1, 0), a3, 0, last);
            TG_WAIT_V(8); TG_WAIT_L(0); TG_BAR; TG_MMA(1, 0, At, B0); TG_MMA(1, 1, At, B1); TG_BAR; TG_SCHED;
        }
        if (wr == 0) TG_BAR;
        E(acc, cur, wr, wc, fr, fq);
        if (!has_next) break;
#pragma unroll
        for (int a = 0; a < 2; ++a)
#pragma unroll
            for (int b = 0; b < 2; ++b)
#pragma unroll
                for (int m = 0; m < 4; ++m)
#pragma unroll
                    for (int n = 0; n < 2; ++n) acc[a][b][m][n] = (f32x4){0.f, 0.f, 0.f, 0.f};
        cur = nxt; cA = nA; cB = nB; ++ui;
        if constexpr (GATHER) { park[0] = park[2]; park[1] = park[3]; }
        if (wr == 1) TG_BAR;
    }
    TG_WAIT_V(0);
    TG_BAR;
#undef TG_SA
#undef TG_SB
#undef TG_STAGE2
#undef TG_STAGE_B
#undef TG_STAGE_A
#undef TG_LDA
#undef TG_LDB
#undef TG_MMA
#undef TG_WAIT_V
#undef TG_WAIT_L
#undef TG_BAR
#undef TG_SCHED
#undef TG_SETOFF
}
}
struct Args { const float* in[34]; float* out; unsigned char* ws; int ph_lo, ph_hi, flip, pad; };
struct Frame {
    LAS unsigned char* lds;
    unsigned char* ws;
    int tid, lane, wave, vcu, G, gw, NGW, flip;
};
enum { I_X = 0, I_C, I_CTX, I_CCTX, I_MODW, I_MODB, I_LNG, I_LNB, I_WQKV, I_WO, I_LAM, I_SUBLN, I_POOLW, I_POOLS, I_FW, I_FB,
       I_HWIN, I_HBIN, I_HCW, I_HCB, I_HF1, I_HFB1, I_HF2, I_HFB2, I_HF3, I_HFREQ, I_HSKIP, I_HWO, I_HBO, I_RW, I_RB, I_WG, I_WU, I_WD };

#ifndef CONV_NT
#define CONV_NT 0
#endif
template <bool NT> __device__ __forceinline__ void transpose_load64(f32x4 (&v)[16], const float* W, int ldw, int k0, int n0, int lane) {
    const int kq = lane >> 4, c4 = (lane & 15) * 4;
#pragma unroll
    for (int i = 0; i < 16; ++i) { const f32x4* p = (const f32x4*)(W + (size_t)(k0 + 4 * i + kq) * ldw + n0 + c4); if constexpr (NT) v[i] = __builtin_nontemporal_load(p); else v[i] = *p; }
}
__device__ __forceinline__ void transpose_finish64(const f32x4 (&v)[16], int k0, bf16* WT, int ldo, int out_row0, int out_row1, LAS float* scr, int lane);
__device__ __forceinline__ void transpose_item64(const float* W, int ldw, int k0, int n0, bf16* WT, int ldo, int out_row0, int out_row1, LAS float* scr, int lane) {
    f32x4 v[16];
    transpose_load64<false>(v, W, ldw, k0, n0, lane);
    transpose_finish64(v, k0, WT, ldo, out_row0, out_row1, scr, lane);
}
__device__ __forceinline__ void transpose_finish64(const f32x4 (&v)[16], int k0, bf16* WT, int ldo, int out_row0, int out_row1, LAS float* scr, int lane) {
    const int kq = lane >> 4, c4 = (lane & 15) * 4;
#pragma unroll
    for (int i = 0; i < 16; ++i) { const int kk = 4 * i + kq; scr[(c4 + 0) * 65 + kk] = v[i].x; scr[(c4 + 1) * 65 + kk] = v[i].y; scr[(c4 + 2) * 65 + kk] = v[i].z; scr[(c4 + 3) * 65 + kk] = v[i].w; }
    LDS_WAIT(); asm volatile("" ::: "memory");
    const int c = lane & 7;
#pragma unroll
    for (int j = 0; j < 8; ++j) { const int n = (lane >> 3) + 8 * j; const LAS float* s_ = scr + n * 65 + 8 * c;
        u32x4 o; o.x = pk2(s_[0], s_[1]); o.y = pk2(s_[2], s_[3]); o.z = pk2(s_[4], s_[5]); o.w = pk2(s_[6], s_[7]);
        const int orow = n < 32 ? out_row0 + n : out_row1 + (n - 32);
        *(u32x4*)(WT + (size_t)orow * ldo + k0 + 8 * c) = o; }
    LDS_WAIT(); asm volatile("" ::: "memory");
}
__device__ __forceinline__ void transpose_matrix(const Frame& F, const float* W, int K, int N, bf16* WT) {
    LAS float* scr = (LAS float*)(F.lds + F.wave * 16640);
    const int nblk = N / 64, items = (K / 64) * nblk;
    for (int it = F.gw; it < items; it += F.NGW) { const int kb = it / nblk, nb = it % nblk; transpose_item64(W, N, kb * 64, nb * 64, WT, K, nb * 64, nb * 64 + 32, scr, F.lane); }
}
struct CvtCtx { const float* wg; const float* wu; const float* wd; bf16* WGU; bf16* WDt; LAS float* scr; int layer, w0, nw, lane; };
__device__ __forceinline__ void cvt_load(const CvtCtx& c, int it, f32x4 (&v)[16]) {
    constexpr int PER = 256;
    const int e = it / (c.nw * PER), r = it % (c.nw * PER), which = c.w0 + r / PER, q = r % PER, kb = q / 16, n0 = (q % 16) * 64;
    const float* base = which == 0 ? c.wg : (which == 1 ? c.wu : c.wd);
    transpose_load64<CONV_NT != 0>(v, base + ((size_t)c.layer * 16 + e) * 1024 * 1024, 1024, kb * 64, n0, c.lane);
}
__device__ __forceinline__ void cvt_finish(const CvtCtx& c, int it, const f32x4 (&v)[16]) {
    constexpr int PER = 256;
    const int e = it / (c.nw * PER), r = it % (c.nw * PER), which = c.w0 + r / PER, q = r % PER, kb = q / 16, n0 = (q % 16) * 64;
    if (which < 2) { const int rb = (n0 >> 7) * 256 + (n0 & 127) + which * 128; transpose_finish64(v, kb * 64, c.WGU + (size_t)e * 2048 * 1024, 1024, rb, rb + 32, c.scr, c.lane); }
    else transpose_finish64(v, kb * 64, c.WDt + (size_t)e * 1024 * 1024, 1024, n0, n0 + 32, c.scr, c.lane);
}
__device__ __forceinline__ void convert_moe_part(const Frame& F, const float* wg, const float* wu, const float* wd, int layer, int part, int pi, int np) {
    CvtCtx c{wg, wu, wd, (bf16*)(F.ws + WS_WGU), (bf16*)(F.ws + WS_WD), (LAS float*)(F.lds + F.wave * 16640), layer, part == 1 ? 2 : 0, part == 2 ? 3 : (part == 0 ? 2 : 1), F.lane};
    const int items = 16 * c.nw * 256, step = np * NWAVES;
    int it = pi * NWAVES + F.wave;
    if (it >= items) return;
    f32x4 va[16], vb[16];
    cvt_load(c, it, va);
    for (;;) {
        const int i1 = it + step;
        if (i1 < items) cvt_load(c, i1, vb);
        cvt_finish(c, it, va);
        if (i1 >= items) break;
        const int i2 = i1 + step;
        if (i2 < items) cvt_load(c, i2, va);
        cvt_finish(c, i1, vb);
        if (i2 >= items) break;
        it = i2;
    }
}
__device__ __forceinline__ void convert_moe_layer(const Frame& F, const float* wg, const float* wu, const float* wd, int layer) { convert_moe_part(F, wg, wu, wd, layer, 2, F.vcu, F.G); }
__device__ __forceinline__ void mod_gemv(const Frame& F, const float* c, const float* cctx, const float* mw, const float* mb) {
    LAS float* sv = (LAS float*)(F.lds + 73728);
    LAS float* red = (LAS float*)(F.lds + 73728 + 20480);
    float* MODV = (float*)(F.ws + WS_MODV);
    for (int i = F.tid; i < 5 * 1024; i += NTHR) { const int v = i >> 10, k = i & 1023; const float x = v < 4 ? c[v * 1024 + k] : cctx[k]; sv[i] = fsilu(x); }
    __syncthreads();
    constexpr int CW = 96, NCH = 6144 / CW;
    for (int it = F.vcu; it < 4 * NCH; it += F.G) {
        const int layer = it / NCH, cc = it % NCH, rs = F.lane / 24, cl = F.lane - rs * 24; const bool act = F.lane < 48;
        const float* Wp = mw + (size_t)layer * 1024 * 6144 + cc * CW + cl * 4;
        f32x4 a[5];
#pragma unroll
        for (int v = 0; v < 5; ++v) a[v] = (f32x4){0.f, 0.f, 0.f, 0.f};
        const int k0 = F.wave * 128 + rs;
        for (int kb = 0; kb < 128; kb += 32) {
            f32x4 w[16];
#pragma unroll
            for (int j = 0; j < 16; ++j) w[j] = act ? *(const f32x4*)(Wp + (size_t)(k0 + kb + 2 * j) * 6144) : (f32x4){0.f, 0.f, 0.f, 0.f};
#pragma unroll
            for (int j = 0; j < 16; ++j)
#pragma unroll
                for (int v = 0; v < 5; ++v) a[v] += w[j] * sv[v * 1024 + (act ? k0 + kb + 2 * j : 0)];
        }
        if (act) {
#pragma unroll
            for (int v = 0; v < 5; ++v) *(LAS f32x4*)(red + ((F.wave * 2 + rs) * 5 + v) * CW + cl * 4) = a[v];
        }
        __syncthreads();
        for (int o = F.tid; o < 5 * CW; o += NTHR) { const int v = o / CW, n = o - v * CW; float s = mb[layer * 6144 + cc * CW + n];
#pragma unroll
            for (int w = 0; w < 16; ++w) s += red[(w * 5 + v) * CW + n];
            MODV[((size_t)layer * 5 + v) * 6144 + cc * CW + n] = s; }
        __syncthreads();
    }
}
__device__ __forceinline__ int row_f(int R) { return (R >> 5) * 16 + (R & 15); }
__device__ __forceinline__ int row_part(int R) { return (R >> 4) & 1; }
__device__ __forceinline__ void tables(const Frame& F) {
    const int gt = F.vcu * NTHR + F.tid, NGT = F.G * NTHR;
    float* rope = (float*)(F.ws + WS_ROPE);
    for (int i = gt; i < 192 * 16; i += NGT) {
        const int pos = i >> 4, fi = i & 15; const float inv = __expf(-(float)fi * (1.0f / 16.0f) * 9.210340371976184f);
        const int p = pos < 128 ? pos : pos - 128; const float rev = (float)p * inv * 0.15915494309189535f;
        float* base = rope + (pos < 128 ? 0 : 4096);
        base[p * 16 + fi] = fcos_rev(rev); base[(pos < 128 ? 2048 : 1024) + p * 16 + fi] = fsin_rev(rev);
    }
    bf16* f1 = (bf16*)(F.ws + DFT_F1);
    for (int i = gt; i < 128 * 64; i += NGT) { const int R = i >> 6, l1 = i & 63, f = row_f(R), pt = row_part(R); const float rev = (float)((f * l1) & 63) * (1.f / 64.f);
        f1[i] = (bf16)(pk2(pt ? -fsin_rev(rev) : fcos_rev(rev), 0.f) & 0xffff); }
    bf16* c256 = (bf16*)(F.ws + DFT_C256); bf16* h2b = (bf16*)(F.ws + DFT_H2B);
    for (int i = gt; i < 256 * 256; i += NGT) { const int R = i >> 8, k = i & 255, f = row_f(R), pt = row_part(R), l = k & 127, kp = k >> 7;
        const float rev = (float)((f * l) & 127) * (1.f / 128.f), cs = fcos_rev(rev), sn = fsin_rev(rev);
        const float v1 = pt == 0 ? (kp == 0 ? cs : sn) : (kp == 0 ? -sn : cs);
        const float v2 = pt == 0 ? (kp == 0 ? cs : -sn) : (kp == 0 ? sn : cs);
        c256[i] = (bf16)(pk2(v1, 0.f) & 0xffff); h2b[i] = (bf16)(pk2(v2, 0.f) & 0xffff); }
    bf16* k1 = (bf16*)(F.ws + DFT_K1); bf16* h1 = (bf16*)(F.ws + DFT_H1);
    for (int i = gt; i < 256 * 128; i += NGT) { const int R = i >> 7, k = i & 127, f = row_f(R), pt = row_part(R);
        { const float rev = (float)((f * k) & 127) * (1.f / 128.f); k1[i] = (bf16)(pk2(pt ? -fsin_rev(rev) : fcos_rev(rev), 0.f) & 0xffff); }
        { const int s1 = k & 63, kp = k >> 6; const float rev = (float)((f * s1) & 127) * (1.f / 128.f), cs = fcos_rev(rev), sn = fsin_rev(rev);
          const float v = pt == 0 ? (kp == 0 ? cs : sn) : (kp == 0 ? -sn : cs); h1[i] = (bf16)(pk2(v, 0.f) & 0xffff); } }
    bf16* h3 = (bf16*)(F.ws + DFT_H3);
    for (int i = gt; i < 128 * 256; i += NGT) { const int R = i >> 8, k = i & 255, t1 = row_f(R), pt = row_part(R), f1i = k & 127, kp = k >> 7;
        const float rev = (float)((t1 * f1i) & 127) * (1.f / 128.f), cs = fcos_rev(rev), sn = fsin_rev(rev);
        const float v = pt == 0 ? (kp == 0 ? cs : -sn) : (kp == 0 ? sn : cs); h3[i] = (bf16)(pk2(v, 0.f) & 0xffff); }
    bf16* trig = (bf16*)(F.ws + WS_TRIG); const float fsc = 1.0f / sqrtf(8192.0f * 256.0f);
    for (int i = gt; i < 2 * 256 * 256; i += NGT) { const int tg_ = i >> 16, k = (i >> 8) & 255, c = i & 255; const float rev = (float)((k * c) & 255) * (1.f / 256.f);
        trig[i] = (bf16)(pk2(fsc * (tg_ ? fsin_rev(rev) : fcos_rev(rev)), 0.f) & 0xffff); }
    f32x2* twf = (f32x2*)(F.ws + WS_TWF);
    for (int i = gt; i < 64 * 128; i += NGT) { const int a = i >> 7, b = i & 127; const float rev = (float)((a * b) & 8191) * (1.f / 8192.f); twf[i] = (f32x2){fcos_rev(rev), fsin_rev(rev)}; }
    f32x2* twh = (f32x2*)(F.ws + WS_TWH);
    for (int i = gt; i < 128 * 128; i += NGT) { const int a = i >> 7, b = i & 127; const float rev = (float)((a * b) & 16383) * (1.f / 16384.f); twh[i] = (f32x2){fcos_rev(rev), fsin_rev(rev)}; }
}
__device__ __forceinline__ void router_tables(const Frame& F, const float* rw) {
    bf16* RWT = (bf16*)(F.ws + WS_RWT); const int gt = F.vcu * NTHR + F.tid, NGT = F.G * NTHR;
    for (int idx = gt; idx < 1024 * 16; idx += NGT) { const int c = idx >> 4, e = idx & 15; const float w = rw[idx];
        const unsigned hi = pk2(w, 0.f) & 0xffffu; const float lo = w - __uint_as_float(hi << 16);
        RWT[e * 1024 + c] = (bf16)hi; RWT[16 * 1024 + e * 1024 + c] = (bf16)(pk2(lo, 0.f) & 0xffffu); }
}
__device__ __forceinline__ void fourier_w_copy(const Frame& F, const float* w) {
    bf16* WFB = (bf16*)(F.ws + WS_WFB); const int gt = F.vcu * NTHR + F.tid, NGT = F.G * NTHR;
    for (int i = gt; i < 1024 * 1024 / 8; i += NGT) { const f32x4 a = *(const f32x4*)(w + (size_t)i * 8), b2 = *(const f32x4*)(w + (size_t)i * 8 + 4);
        *(u32x4*)(WFB + (size_t)i * 8) = (u32x4){pk2(a.x, a.y), pk2(a.z, a.w), pk2(b2.x, b2.y), pk2(b2.z, b2.w)}; }
}
__device__ __forceinline__ void hyena_a2(const Frame& F, const float* f1, const float* fb1, const float* f2, const float* fb2, const float* freq) {
    float* A2 = (float*)(F.ws + WS_A2);
    LAS float* sc = (LAS float*)(F.lds + 143360 + F.wave * 512);
    const int j = F.lane; const float fr = freq[j];
    for (int t = F.gw; t < SEQ; t += F.NGW) {
        float zv = 0.f;
        if (j == 0) zv = (float)t * (1.f / 8192.f);
        else if (j < 33) { const int b = (j - 1) & 15; const float band = 1e-4f + (float)b * ((15.0f - 1e-4f) / 15.0f); const float rev = (float)t * band * (1.f / 8192.f);
            const float rr = rev - floorf(rev); zv = j < 17 ? fcos_rev(rr) : fsin_rev(rr); }
        sc[j] = zv; LDS_WAIT(); asm volatile("" ::: "memory");
        float s = fb1[j];
        for (int i = 0; i < 33; ++i) s += sc[i] * f1[i * 64 + j];
        const float a1 = __sinf(fr * s);
        LDS_WAIT(); asm volatile("" ::: "memory");
        sc[64 + j] = a1; LDS_WAIT(); asm volatile("" ::: "memory");
        float s2 = fb2[j];
        for (int i = 0; i < 64; ++i) s2 += sc[64 + i] * f2[i * 64 + j];
        { const float a2v = __sinf(fr * s2); A2[(size_t)t * 64 + j] = a2v; ((bf16*)(F.ws + WS_A2B))[(size_t)t * 64 + j] = (bf16)(pk2(a2v, 0.f) & 0xffff); }
        LDS_WAIT(); asm volatile("" ::: "memory");
    }
}
__device__ __forceinline__ void ld16f(const float* p, float (&v)[16], int lane) {
    const f32x4 a = *(const f32x4*)(p + lane * 8), b = *(const f32x4*)(p + lane * 8 + 4), c = *(const f32x4*)(p + 512 + lane * 8), d = *(const f32x4*)(p + 512 + lane * 8 + 4);
    v[0] = a.x; v[1] = a.y; v[2] = a.z; v[3] = a.w; v[4] = b.x; v[5] = b.y; v[6] = b.z; v[7] = b.w;
    v[8] = c.x; v[9] = c.y; v[10] = c.z; v[11] = c.w; v[12] = d.x; v[13] = d.y; v[14] = d.z; v[15] = d.w;
}
__device__ __forceinline__ void ld16b(const bf16* p, float (&v)[16], int lane) {
    const u32x4 a = *(const u32x4*)(p + lane * 8), c = *(const u32x4*)(p + 512 + lane * 8);
    v[0] = bflo(a.x); v[1] = bfhi(a.x); v[2] = bflo(a.y); v[3] = bfhi(a.y); v[4] = bflo(a.z); v[5] = bfhi(a.z); v[6] = bflo(a.w); v[7] = bfhi(a.w);
    v[8] = bflo(c.x); v[9] = bfhi(c.x); v[10] = bflo(c.y); v[11] = bfhi(c.y); v[12] = bflo(c.z); v[13] = bfhi(c.z); v[14] = bflo(c.w); v[15] = bfhi(c.w);
}
__device__ __forceinline__ void ldraw(const bf16* p, u32x4& a, u32x4& c, int lane) { a = *(const u32x4*)(p + lane * 8); c = *(const u32x4*)(p + 512 + lane * 8); }
__device__ __forceinline__ void unpack16(const u32x4 a, const u32x4 c, float (&v)[16]) {
    v[0] = bflo(a.x); v[1] = bfhi(a.x); v[2] = bflo(a.y); v[3] = bfhi(a.y); v[4] = bflo(a.z); v[5] = bfhi(a.z); v[6] = bflo(a.w); v[7] = bfhi(a.w);
    v[8] = bflo(c.x); v[9] = bfhi(c.x); v[10] = bflo(c.y); v[11] = bfhi(c.y); v[12] = bflo(c.z); v[13] = bfhi(c.z); v[14] = bflo(c.w); v[15] = bfhi(c.w);
}
__device__ __forceinline__ void st16b(bf16* p, const float (&v)[16], int lane) {
    u32x4 a, c; a.x = pk2(v[0], v[1]); a.y = pk2(v[2], v[3]); a.z = pk2(v[4], v[5]); a.w = pk2(v[6], v[7]);
    c.x = pk2(v[8], v[9]); c.y = pk2(v[10], v[11]); c.z = pk2(v[12], v[13]); c.w = pk2(v[14], v[15]);
    *(u32x4*)(p + lane * 8) = a; *(u32x4*)(p + 512 + lane * 8) = c;
}
__device__ __forceinline__ void st16f(float* p, const float (&v)[16], int lane) {
    *(f32x4*)(p + lane * 8) = (f32x4){v[0], v[1], v[2], v[3]}; *(f32x4*)(p + lane * 8 + 4) = (f32x4){v[4], v[5], v[6], v[7]};
    *(f32x4*)(p + 512 + lane * 8) = (f32x4){v[8], v[9], v[10], v[11]}; *(f32x4*)(p + 512 + lane * 8 + 4) = (f32x4){v[12], v[13], v[14], v[15]};
}
__device__ __forceinline__ void modulate0(const Frame& F, const float* x, const float* ctx) {
    const float* MODV = (const float*)(F.ws + WS_MODV); bf16* HA = (bf16*)(F.ws + WS_HA); bf16* XR = (bf16*)(F.ws + WS_XR);
    int m = F.gw; if (m >= MROWS) return;
    float xn[16], sh[16], sc[16]; int vprev = -1;
    ld16f(m < T ? x + (size_t)m * D : ctx + (size_t)(m - T) * D, xn, F.lane);
    for (; m < MROWS; m += F.NGW) {
        float xv[16];
#pragma unroll
        for (int i = 0; i < 16; ++i) xv[i] = xn[i];
        const int mn = m + F.NGW;
        if (mn < MROWS) ld16f(mn < T ? x + (size_t)mn * D : ctx + (size_t)(mn - T) * D, xn, F.lane);
        const int v = m < T ? m / SEQ : 4;
        if (v != vprev) { const float* mv = MODV + (size_t)v * 6144; ld16f(mv, sh, F.lane); ld16f(mv + 1024, sc, F.lane); vprev = v; }
        if (m < T) st16b(XR + (size_t)m * D, xv, F.lane);
#pragma unroll
        for (int i = 0; i < 16; ++i) xv[i] = xv[i] * (1.f + sc[i]) + sh[i];
        st16b(HA + (size_t)m * D, xv, F.lane);
    }
}
__device__ __forceinline__ void ln16(float (&v)[16], const float (&gam)[16], const float (&bet)[16]) {
    float s = 0.f;
#pragma unroll
    for (int i = 0; i < 16; ++i) s += v[i];
    const float mean = wave_sum(s) * (1.f / D); float q = 0.f;
#pragma unroll
    for (int i = 0; i < 16; ++i) { v[i] -= mean; q += v[i] * v[i]; }
    const float rstd = 1.0f / sqrtf(wave_sum(q) * (1.f / D) + LN_EPS);
#pragma unroll
    for (int i = 0; i < 16; ++i) v[i] = v[i] * rstd * gam[i] + bet[i];
}
__device__ __forceinline__ void ln1_route(const Frame& F, int layer, const float* lng, const float* lnb, const float* rb) {
    const float* MODV = (const float*)(F.ws + WS_MODV); bf16* HA = (bf16*)(F.ws + WS_HA); bf16* XR = (bf16*)(F.ws + WS_XR); const bf16* Y = (const bf16*)(F.ws + WS_Y);
    int* TOKE = (int*)(F.ws + WS_TOKE); float* TOKW = (float*)(F.ws + WS_TOKW); int* LIST = (int*)(F.ws + WS_LIST);
    unsigned* CNT = (unsigned*)(F.ws + WS_CTL) + CW_CNT + layer * 16 * 64;
    LAS float* slog = (LAS float*)F.lds;
    LAS int* s_e = (LAS int*)(F.lds + 66560);
    LAS int* s_r = (LAS int*)(F.lds + 66560 + 2048);
    LAS int* s_hist = (LAS int*)(F.lds + 66560 + 4096);
    const int TPB = T / F.G, t0 = (F.flip ? (F.G - 1 - F.vcu) : F.vcu) * TPB;
    if (F.tid < 32) s_hist[F.tid] = 0;
    __syncthreads();
    const int bt = t0 / SEQ; const float* mv = MODV + ((size_t)layer * 5 + bt) * 6144;
    float cy[16], gam[16], bet[16], sc2[16], sh2[16];
    ld16f(mv + 2048, cy, F.lane); ld16f(lng + (size_t)(layer * 2 + 0) * D, gam, F.lane); ld16f(lnb + (size_t)(layer * 2 + 0) * D, bet, F.lane);
    ld16f(mv + 4096, sc2, F.lane); ld16f(mv + 3072, sh2, F.lane);
#pragma unroll
    for (int i = 0; i < 16; ++i) { cy[i] += 1.f; sc2[i] += 1.f; }
    u32x4 pxa, pxc, pya, pyc;
    ldraw(XR + (size_t)(t0 + F.wave) * D, pxa, pxc, F.lane); ldraw(Y + (size_t)(t0 + F.wave) * D, pya, pyc, F.lane);
    for (int r = F.wave; r < TPB; r += NWAVES) {
        const int t = t0 + r; float v[16], y[16];
        unpack16(pxa, pxc, v); unpack16(pya, pyc, y);
        if (r + NWAVES < TPB) { ldraw(XR + (size_t)(t + NWAVES) * D, pxa, pxc, F.lane); ldraw(Y + (size_t)(t + NWAVES) * D, pya, pyc, F.lane); }
#pragma unroll
        for (int i = 0; i < 16; ++i) v[i] = ALPHA * v[i] + cy[i] * y[i];
        ln16(v, gam, bet);
        st16b(XR + (size_t)t * D, v, F.lane);
#pragma unroll
        for (int i = 0; i < 16; ++i) v[i] = v[i] * sc2[i] + sh2[i];
        st16b(HA + (size_t)t * D, v, F.lane);
    }
    asm volatile("s_waitcnt vmcnt(0)" ::: "memory");
    {
        const int fr = F.lane & 15, fq = F.lane >> 4;
        const bf16* ap = HA + (size_t)(t0 + F.wave + NWAVES * fr) * D + fq * 8;
        const bf16* bh = (const bf16*)(F.ws + WS_RWT) + fr * 1024 + fq * 8; const bf16* bl = bh + 16 * 1024;
        f32x4 acc = {0.f, 0.f, 0.f, 0.f};
#pragma unroll 8
        for (int ks = 0; ks < 32; ++ks) {
            const bf16x8 a = *(const bf16x8*)(ap + ks * 32), h = *(const bf16x8*)(bh + ks * 32), l = *(const bf16x8*)(bl + ks * 32);
            acc = __builtin_amdgcn_mfma_f32_16x16x32_bf16(a, h, acc, 0, 0, 0);
            acc = __builtin_amdgcn_mfma_f32_16x16x32_bf16(a, l, acc, 0, 0, 0);
        }
        LAS float* sl = slog + F.wave * 256; const float bias = rb[fr];
        sl[(4 * fq + 0) * 16 + fr] = acc.x + bias; sl[(4 * fq + 1) * 16 + fr] = acc.y + bias; sl[(4 * fq + 2) * 16 + fr] = acc.z + bias; sl[(4 * fq + 3) * 16 + fr] = acc.w + bias;
        LDS_WAIT(); asm volatile("" ::: "memory");
        if (F.lane < 16) {
            const int j = F.lane, r = F.wave + NWAVES * j, t = t0 + r;
            float lg[16];
            { const f32x4 q0_ = *(const LAS f32x4*)(sl + j * 16), q1_ = *(const LAS f32x4*)(sl + j * 16 + 4), q2_ = *(const LAS f32x4*)(sl + j * 16 + 8), q3_ = *(const LAS f32x4*)(sl + j * 16 + 12);
              lg[0] = q0_.x; lg[1] = q0_.y; lg[2] = q0_.z; lg[3] = q0_.w; lg[4] = q1_.x; lg[5] = q1_.y; lg[6] = q1_.z; lg[7] = q1_.w;
              lg[8] = q2_.x; lg[9] = q2_.y; lg[10] = q2_.z; lg[11] = q2_.w; lg[12] = q3_.x; lg[13] = q3_.y; lg[14] = q3_.z; lg[15] = q3_.w; }
            float mx = lg[0];
#pragma unroll
            for (int e = 1; e < 16; ++e) mx = fmaxf(mx, lg[e]);
            float pe[16];
#pragma unroll
            for (int e = 0; e < 16; ++e) pe[e] = __expf(lg[e] - mx);
            float best = -1.f; int bg = 0; float q0 = 0.f, q1 = 0.f, q2 = 0.f, q3 = 0.f;
#pragma unroll
            for (int g = 0; g < 4; ++g) {
                const float a = pe[4 * g], b = pe[4 * g + 1], c = pe[4 * g + 2], d = pe[4 * g + 3];
                const float m1 = fmaxf(fmaxf(a, b), fmaxf(c, d));
                const float m2 = fmaxf(fmaxf(fminf(a, b), fminf(c, d)), fminf(fmaxf(a, b), fmaxf(c, d)));
                const float gs = m1 + m2; const bool better = gs > best;
                best = better ? gs : best; bg = better ? g : bg; q0 = better ? a : q0; q1 = better ? b : q1; q2 = better ? c : q2; q3 = better ? d : q3;
            }
            int i0 = 0; float v0 = q0;
            if (q1 > v0) { v0 = q1; i0 = 1; } if (q2 > v0) { v0 = q2; i0 = 2; } if (q3 > v0) { v0 = q3; i0 = 3; }
            int i1 = -1; float v1 = -1.f;
            if (i0 != 0 && q0 > v1) { v1 = q0; i1 = 0; } if (i0 != 1 && q1 > v1) { v1 = q1; i1 = 1; }
            if (i0 != 2 && q2 > v1) { v1 = q2; i1 = 2; } if (i0 != 3 && q3 > v1) { v1 = q3; i1 = 3; }
            const float inv = 1.0f / (v0 + v1);
            const int e0 = bg * 4 + i0, e1 = bg * 4 + i1;
            TOKE[2 * t] = e0; TOKE[2 * t + 1] = e1; TOKW[2 * t] = v0 * inv; TOKW[2 * t + 1] = v1 * inv;
            s_e[2 * r] = e0; s_e[2 * r + 1] = e1;
            s_r[2 * r] = atomicAdd((int*)&s_hist[e0], 1); s_r[2 * r + 1] = atomicAdd((int*)&s_hist[e1], 1);
        }
    }
    __syncthreads();
    if (F.tid < 16) s_hist[16 + F.tid] = (int)atomicAdd(CNT + F.tid * 64, (unsigned)s_hist[F.tid]);
    __syncthreads();
    for (int i = F.tid; i < 2 * TPB; i += NTHR) { const int e = s_e[i]; const int rk = F.flip ? (s_hist[e] - 1 - s_r[i]) : s_r[i]; LIST[e * T + s_hist[16 + e] + rk] = (t0 + (i >> 1)) * 2 + (i & 1); }
    __syncthreads();
}
__device__ __forceinline__ void ln2_phase(const Frame& F, int layer, const float* lng, const float* lnb, float* out) {
    const float* MODV = (const float*)(F.ws + WS_MODV); bf16* HA = (bf16*)(F.ws + WS_HA); bf16* XR = (bf16*)(F.ws + WS_XR); const bf16* Y2 = (const bf16*)(F.ws + WS_Y2);
    const int TPB = T / F.G, t0 = F.vcu * TPB, bt = t0 / SEQ;
    const float* mv = MODV + ((size_t)layer * 5 + bt) * 6144; const float* mvn = MODV + ((size_t)(layer + 1 < NLAYER ? layer + 1 : layer) * 5 + bt) * 6144;
    float cy[16], gam[16], bet[16], sc1[16], sh1[16];
    ld16f(mv + 5120, cy, F.lane); ld16f(lng + (size_t)(layer * 2 + 1) * D, gam, F.lane); ld16f(lnb + (size_t)(layer * 2 + 1) * D, bet, F.lane);
    ld16f(mvn + 1024, sc1, F.lane); ld16f(mvn, sh1, F.lane);
#pragma unroll
    for (int i = 0; i < 16; ++i) { cy[i] += 1.f; sc1[i] += 1.f; }
    u32x4 pxa, pxc, paa, pac, pba, pbc;
    ldraw(XR + (size_t)(t0 + F.wave) * D, pxa, pxc, F.lane); ldraw(Y2 + (size_t)(2 * (t0 + F.wave)) * D, paa, pac, F.lane); ldraw(Y2 + (size_t)(2 * (t0 + F.wave) + 1) * D, pba, pbc, F.lane);
    for (int r = F.wave; r < TPB; r += NWAVES) {
        const int t = t0 + r; float v[16], ya[16], yb[16];
        unpack16(pxa, pxc, v); unpack16(paa, pac, ya); unpack16(pba, pbc, yb);
        if (r + NWAVES < TPB) { const int tn = t + NWAVES; ldraw(XR + (size_t)tn * D, pxa, pxc, F.lane); ldraw(Y2 + (size_t)(2 * tn) * D, paa, pac, F.lane); ldraw(Y2 + (size_t)(2 * tn + 1) * D, pba, pbc, F.lane); }
#pragma unroll
        for (int i = 0; i < 16; ++i) v[i] = ALPHA * v[i] + cy[i] * (ya[i] + yb[i]);
        ln16(v, gam, bet);
#ifdef MK_DBG4
        if (layer == NLAYER - 1) {
            unsigned hi_ = 0u, ho_ = 0u;
            { float a_[16], b_[16], c_[16]; ld16b(XR + (size_t)t * D, a_, F.lane); ld16b(Y2 + (size_t)(2 * t) * D, b_, F.lane); ld16b(Y2 + (size_t)(2 * t + 1) * D, c_, F.lane);
#pragma unroll
              for (int i = 0; i < 16; ++i) hi_ = hi_ * 0x9E3779B1u + (__float_as_uint(a_[i]) ^ (__float_as_uint(b_[i]) * 3u) ^ (__float_as_uint(c_[i]) * 7u)) * (2u * i + 1u); }
#pragma unroll
            for (int i = 0; i < 16; ++i) ho_ = ho_ * 0x9E3779B1u + __float_as_uint(v[i]) * (2u * i + 1u);
#pragma unroll
            for (int o = 1; o < 64; o <<= 1) { hi_ += __shfl_xor(hi_, o) * 31u; ho_ += __shfl_xor(ho_, o) * 31u; }
            unsigned* HH = (unsigned*)(F.ws + (F.flip ? 11 : 10) * MiB);
            if (F.lane == 0) { HH[2 * t] = hi_; HH[2 * t + 1] = ho_; }
        }
#endif
        if (layer == NLAYER - 1) {
#ifdef MK_DBG_STOP
            st16b(XR + (size_t)t * D, v, F.lane);
#endif
            st16f(out + (size_t)t * D, v, F.lane);
        } else {
            st16b(XR + (size_t)t * D, v, F.lane);
#pragma unroll
            for (int i = 0; i < 16; ++i) v[i] = v[i] * sc1[i] + sh1[i];
            st16b(HA + (size_t)t * D, v, F.lane);
        }
    }
#ifdef MK_READBACK
    if (layer == NLAYER - 1) {
        asm volatile("s_waitcnt vmcnt(0)" ::: "memory");
        const int r_last = F.wave + ((TPB - 1 - F.wave) / NWAVES) * NWAVES;
        const unsigned long long* p0 = (const unsigned long long*)(out + (size_t)(t0 + r_last) * D + F.lane * 8); const unsigned long long* p1 = p0 + 256;
        unsigned long long x = 0;
#pragma unroll
        for (int i = 0; i < 4; ++i) { x ^= __hip_atomic_load(p0 + i, __ATOMIC_RELAXED, __HIP_MEMORY_SCOPE_SYSTEM); x ^= __hip_atomic_load(p1 + i, __ATOMIC_RELAXED, __HIP_MEMORY_SCOPE_SYSTEM); }
        asm volatile("s_waitcnt vmcnt(0)" :: "v"(x) : "memory");
    }
#endif
}
__device__ __forceinline__ void unpack8(const u32x4 a, float (&f)[8]) { f[0] = bflo(a.x); f[1] = bfhi(a.x); f[2] = bflo(a.y); f[3] = bfhi(a.y); f[4] = bflo(a.z); f[5] = bfhi(a.z); f[6] = bflo(a.w); f[7] = bfhi(a.w); }
__device__ __forceinline__ void pool_pre(const Frame& F) {
    const bf16* HA = (const bf16*)(F.ws + WS_HA); bf16* PO = (bf16*)(F.ws + WS_POOLED);
    const int hw0 = F.lane < 32 ? 1 : 2, hw1 = F.lane < 32 ? 4 : 8;
    const u32x4 z4 = {0u, 0u, 0u, 0u};
    for (int blk = F.gw; blk < T / 16; blk += F.NGW) {
        const int tb = blk * 16, lb = tb % SEQ; const bf16* base = HA + (size_t)(tb - lb) * D;
        float s0[8], s1[8]; int n0 = 0, n1 = 0;
#pragma unroll
        for (int i = 0; i < 8; ++i) { s0[i] = 0.f; s1[i] = 0.f; }
#pragma unroll
        for (int dt = -8; dt < 8; ++dt) {
            const int ll = lb + dt; const bool inb = ll >= 0 && ll < SEQ;
            if (inb && dt >= -hw0 && dt < hw0) { float f[8]; unpack8(*(const u32x4*)(base + (size_t)ll * D + F.lane * 8), f); n0++;
#pragma unroll
                for (int i = 0; i < 8; ++i) s0[i] += f[i]; }
            if (inb && dt >= -hw1 && dt < hw1) { float f[8]; unpack8(*(const u32x4*)(base + (size_t)ll * D + 512 + F.lane * 8), f); n1++;
#pragma unroll
                for (int i = 0; i < 8; ++i) s1[i] += f[i]; }
        }
#define PP_LOAD(l_) do { const int e0_ = (l_) + hw0, v0_ = (l_) - hw0, e1_ = (l_) + hw1, v1_ = (l_) - hw1; \
            c0 = *(const u32x4*)(base + (size_t)(l_) * D + F.lane * 8); c1 = *(const u32x4*)(base + (size_t)(l_) * D + 512 + F.lane * 8); \
            a0 = e0_ < SEQ ? *(const u32x4*)(base + (size_t)e0_ * D + F.lane * 8) : z4; b0 = v0_ >= 0 ? *(const u32x4*)(base + (size_t)v0_ * D + F.lane * 8) : z4; \
            a1 = e1_ < SEQ ? *(const u32x4*)(base + (size_t)e1_ * D + 512 + F.lane * 8) : z4; b1 = v1_ >= 0 ? *(const u32x4*)(base + (size_t)v1_ * D + 512 + F.lane * 8) : z4; } while (0)
        u32x4 c0, c1, a0, b0, a1, b1;
        PP_LOAD(lb);
        for (int r = 0; r < 16; ++r) {
            const int l = lb + r;
            const int e0 = l + hw0, v0 = l - hw0, e1 = l + hw1, v1 = l - hw1;
            float fc0[8], fc1[8], fa0[8], fb0[8], fa1[8], fb1[8], o[16];
            unpack8(c0, fc0); unpack8(c1, fc1); unpack8(a0, fa0); unpack8(b0, fb0); unpack8(a1, fa1); unpack8(b1, fb1);
            if (r + 1 < 16) PP_LOAD(l + 1);
            const float r0 = 1.0f / (float)n0, r1 = 1.0f / (float)n1;
#pragma unroll
            for (int i = 0; i < 8; ++i) { o[i] = s0[i] * r0 - fc0[i]; o[8 + i] = s1[i] * r1 - fc1[i]; }
            st16b(PO + (size_t)(tb + r) * D, o, F.lane);
#pragma unroll
            for (int i = 0; i < 8; ++i) { s0[i] += fa0[i] - fb0[i]; s1[i] += fa1[i] - fb1[i]; }
            n0 += (e0 < SEQ ? 1 : 0) - (v0 >= 0 ? 1 : 0);
            n1 += (e1 < SEQ ? 1 : 0) - (v1 >= 0 ? 1 : 0);
        }
#undef PP_LOAD
    }
}
__device__ __forceinline__ void hyena_conv(const Frame& F, const float* cw, const float* cb) {
    const bf16* Z = (const bf16*)(F.ws + WS_Z); bf16* VP = (bf16*)(F.ws + WS_VP); bf16* X0 = (bf16*)(F.ws + WS_X0);
    for (int task = F.gw; task < (T / 32) * 2; task += F.NGW) {
        const int chunk = task >> 1, half = task & 1, t0 = chunk * 32, l0 = t0 % SEQ, cbase = half * 512 + F.lane * 8;
        float w[3][3][8], bia[3][8];
#pragma unroll
        for (int s = 0; s < 3; ++s) {
#pragma unroll
            for (int tp = 0; tp < 3; ++tp) { const f32x4 a = *(const f32x4*)(cw + tp * 3072 + s * 1024 + cbase), b = *(const f32x4*)(cw + tp * 3072 + s * 1024 + cbase + 4);
                w[s][tp][0] = a.x; w[s][tp][1] = a.y; w[s][tp][2] = a.z; w[s][tp][3] = a.w; w[s][tp][4] = b.x; w[s][tp][5] = b.y; w[s][tp][6] = b.z; w[s][tp][7] = b.w; }
            const f32x4 a = *(const f32x4*)(cb + s * 1024 + cbase), b = *(const f32x4*)(cb + s * 1024 + cbase + 4);
            bia[s][0] = a.x; bia[s][1] = a.y; bia[s][2] = a.z; bia[s][3] = a.w; bia[s][4] = b.x; bia[s][5] = b.y; bia[s][6] = b.z; bia[s][7] = b.w;
        }
        u32x4 prv[3], cur[3], nxt[3], fut[3];
#pragma unroll
        for (int s = 0; s < 3; ++s) {
            prv[s] = l0 > 0 ? *(const u32x4*)(Z + (size_t)(t0 - 1) * 3072 + s * 1024 + cbase) : (u32x4){0u, 0u, 0u, 0u};
            cur[s] = *(const u32x4*)(Z + (size_t)t0 * 3072 + s * 1024 + cbase);
            nxt[s] = (l0 + 1) < SEQ ? *(const u32x4*)(Z + (size_t)(t0 + 1) * 3072 + s * 1024 + cbase) : (u32x4){0u, 0u, 0u, 0u};
        }
        for (int r = 0; r < 32; ++r) {
            const int t = t0 + r; const bool hasf = (l0 + r + 2) < SEQ;
#pragma unroll
            for (int s = 0; s < 3; ++s) fut[s] = hasf ? *(const u32x4*)(Z + (size_t)(t + 2) * 3072 + s * 1024 + cbase) : (u32x4){0u, 0u, 0u, 0u};
            float o[3][8];
#pragma unroll
            for (int s = 0; s < 3; ++s) {
                const unsigned pw[4] = {prv[s].x, prv[s].y, prv[s].z, prv[s].w}, cwd[4] = {cur[s].x, cur[s].y, cur[s].z, cur[s].w}, nw[4] = {nxt[s].x, nxt[s].y, nxt[s].z, nxt[s].w};
#pragma unroll
                for (int i = 0; i < 4; ++i) {
                    o[s][2 * i] = bflo(pw[i]) * w[s][0][2 * i] + bflo(cwd[i]) * w[s][1][2 * i] + bflo(nw[i]) * w[s][2][2 * i] + bia[s][2 * i];
                    o[s][2 * i + 1] = bfhi(pw[i]) * w[s][0][2 * i + 1] + bfhi(cwd[i]) * w[s][1][2 * i + 1] + bfhi(nw[i]) * w[s][2][2 * i + 1] + bia[s][2 * i + 1];
                }
            }
            u32x4 ov, ox;
            ov.x = pk2(o[2][0] * o[1][0], o[2][1] * o[1][1]); ov.y = pk2(o[2][2] * o[1][2], o[2][3] * o[1][3]);
            ov.z = pk2(o[2][4] * o[1][4], o[2][5] * o[1][5]); ov.w = pk2(o[2][6] * o[1][6], o[2][7] * o[1][7]);
            ox.x = pk2(o[0][0], o[0][1]); ox.y = pk2(o[0][2], o[0][3]); ox.z = pk2(o[0][4], o[0][5]); ox.w = pk2(o[0][6], o[0][7]);
            *(u32x4*)(VP + (size_t)t * D + cbase) = ov; *(u32x4*)(X0 + (size_t)t * D + cbase) = ox;
#pragma unroll
            for (int s = 0; s < 3; ++s) { prv[s] = cur[s]; cur[s] = nxt[s]; nxt[s] = fut[s]; }
        }
    }
}
__device__ __forceinline__ void hyena_kfull(const Frame& F, const float* f3) {
    const float* A2 = (const float*)(F.ws + WS_A2); bf16* KF = (bf16*)(F.ws + WS_KFULL);
    const float dlo = -3.0701134573253943f, dhi = -15.350567286626972f;
    for (int n = F.gw; n < 2 * SEQ; n += F.NGW) {
        float o[16];
        if (n == SEQ) {
#pragma unroll
            for (int i = 0; i < 16; ++i) o[i] = 0.f;
        } else {
            const int t = n < SEQ ? n : 2 * SEQ - n, coff = n < SEQ ? 0 : 1024;
            const float a = A2[(size_t)t * 64 + F.lane];
#pragma unroll
            for (int i = 0; i < 16; ++i) o[i] = 0.f;
            for (int j = 0; j < 64; ++j) {
                const float aj = __shfl(a, j); float fv[16];
                ld16f(f3 + (size_t)j * 2048 + coff, fv, F.lane);
#pragma unroll
                for (int i = 0; i < 16; ++i) o[i] += aj * fv[i];
            }
            const float tt = (float)t * (1.f / 8192.f);
#pragma unroll
            for (int i = 0; i < 16; ++i) { const int d = (i < 8 ? 0 : 512) + F.lane * 8 + (i & 7); const float delta = -(dlo + (dhi - dlo) * (float)d * (1.f / 1023.f)); o[i] *= __expf(-tt * delta); }
        }
        st16b(KF + (size_t)n * D, o, F.lane);
    }
}
namespace att {
constexpr int QBLK = 32, KVBLK = 64;
constexpr float SCALE = 0.125f, THR = 8.f;
constexpr int SHM_V = KVBLK * 128 * 2, SHM_K = KVBLK * 64 * 2;
constexpr int NBUF = 3;
constexpr int OFF_V = 0, OFF_K = NBUF * SHM_V, OFF_WS = OFF_K + NBUF * SHM_K, OFF_O0 = OFF_WS + NWAVES * 64 * 4;
constexpr int LDS_NEED = OFF_O0 + NWAVES * 8192;
static_assert(LDS_NEED <= LDS_SCRATCH, "attention LDS");
#define KSWZ64(row, colB) ((row) * 128 + ((colB) ^ (((row) & 7) << 4)))
#define SBAR() __builtin_amdgcn_sched_barrier(0)
__device__ __forceinline__ int crow(int r, int hi) { return (r & 3) + 8 * (r >> 2) + 4 * hi; }
__device__ __forceinline__ unsigned cvtpk(float lo, float hi) { unsigned r; asm volatile("v_cvt_pk_bf16_f32 %0, %1, %2" : "=v"(r) : "v"(lo), "v"(hi)); return r; }

__device__ __forceinline__ void partialSM(f32x16& p0, f32x16& p1, float& m_reg, float& mn, float& alpha) {
    constexpr float C = SCALE * 1.4426950408889634f;
    float pmax = p0[0];
#pragma unroll
    for (int r = 1; r < 16; ++r) pmax = fmaxf(pmax, p0[r]);
#pragma unroll
    for (int r = 0; r < 16; ++r) pmax = fmaxf(pmax, p1[r]);
    { auto rr = __builtin_amdgcn_permlane32_swap(__float_as_uint(pmax), __float_as_uint(pmax), false, false);
      pmax = fmaxf(__uint_as_float(rr[0]), __uint_as_float(rr[1])); }
    if (__builtin_expect(__all(pmax - m_reg <= THR / SCALE), 1)) { mn = m_reg; alpha = 1.f; }
    else { mn = fmaxf(m_reg, pmax); alpha = __builtin_amdgcn_exp2f((m_reg - mn) * C); m_reg = mn; }
    const float mnC = -mn * C;
#pragma unroll
    for (int r = 0; r < 16; ++r) p0[r] = fmaf(p0[r], C, mnC);
#pragma unroll
    for (int r = 0; r < 16; ++r) p1[r] = fmaf(p1[r], C, mnC);
#pragma unroll
    for (int r = 0; r < 16; ++r) p0[r] = __builtin_amdgcn_exp2f(p0[r]);
}
__device__ __forceinline__ void finishSM(f32x16& p0, f32x16& p1, float alpha, float& l_reg, bf16x8& pa0, bf16x8& pa1, bf16x8& pa2, bf16x8& pa3) {
#pragma unroll
    for (int r = 0; r < 16; ++r) p1[r] = __builtin_amdgcn_exp2f(p1[r]);
    float ps = 0;
#pragma unroll
    for (int r = 0; r < 16; ++r) ps += p0[r];
#pragma unroll
    for (int r = 0; r < 16; ++r) ps += p1[r];
    { auto rr = __builtin_amdgcn_permlane32_swap(__float_as_uint(ps), __float_as_uint(ps), false, false);
      ps = __uint_as_float(rr[0]) + __uint_as_float(rr[1]); }
    l_reg = l_reg * alpha + ps;
#define PK4(P, BASE, OUT) do { unsigned a0 = cvtpk(P[BASE + 0], P[BASE + 1]), a1 = cvtpk(P[BASE + 2], P[BASE + 3]);   \
    unsigned b0 = cvtpk(P[BASE + 4], P[BASE + 5]), b1 = cvtpk(P[BASE + 6], P[BASE + 7]);                              \
    auto r0 = __builtin_amdgcn_permlane32_swap(a0, b0, false, false); auto r1 = __builtin_amdgcn_permlane32_swap(a1, b1, false, false); \
    u32x4 w = {r0[0], r1[0], r0[1], r1[1]}; OUT = *reinterpret_cast<bf16x8*>(&w); } while (0)
    PK4(p0, 0, pa0); PK4(p0, 8, pa1); PK4(p1, 0, pa2); PK4(p1, 8, pa3);
#undef PK4
}
__device__ __forceinline__ void qkt(f32x16& p0, f32x16& p1, const LAS unsigned char* Ks, const bf16x8* qr, int r32, int hi) {
    p0 = f32x16{}; p1 = f32x16{};
#pragma unroll
    for (int d0 = 0; d0 < 4; ++d0) { const int cb = (d0 * 16 + hi * 8) * 2;
        const bf16x8 b0 = *(const LAS bf16x8*)(Ks + KSWZ64(r32, cb));
        const bf16x8 b1 = *(const LAS bf16x8*)(Ks + KSWZ64(32 + r32, cb));
        p0 = __builtin_amdgcn_mfma_f32_32x32x16_bf16(b0, qr[d0], p0, 0, 0, 0);
        p1 = __builtin_amdgcn_mfma_f32_32x32x16_bf16(b1, qr[d0], p1, 0, 0, 0); }
}
__device__ __forceinline__ int v_st(int k, int c) { const int kk = (k & ~0xC) | ((k & 4) << 1) | ((k & 8) >> 1); return ((kk >> 3) * 4 + (c >> 5)) * 512 + ((kk & 7) * 32 + (c & 31)) * 2; }
__device__ __forceinline__ int v_rd_base(int lane) { return ((lane & 3) << 3) | (((lane >> 2) & 3) << 6) | (((lane >> 4) & 1) << 5) | (((lane >> 5) & 1) << 8); }
constexpr int v_rd_off(int d0, int ks, int half) { return d0 * 512 + ks * 4096 + half * 2048; }
template <int OFF> __device__ __forceinline__ s16x4 tr_read(int vb) {
    s16x4 r; asm volatile("ds_read_b64_tr_b16 %0, %1 offset:%2" : "=&v"(r) : "v"(vb), "i"(OFF) : "memory"); return r;
}
template <int D0> __device__ __forceinline__ void pv_one(f32x16& od, int vb, bf16x8 pa0, bf16x8 pa1, bf16x8 pa2, bf16x8 pa3) {
    const s16x4 l0 = tr_read<v_rd_off(D0, 0, 0)>(vb), h0 = tr_read<v_rd_off(D0, 0, 1)>(vb), l1 = tr_read<v_rd_off(D0, 1, 0)>(vb), h1 = tr_read<v_rd_off(D0, 1, 1)>(vb);
    const s16x4 l2 = tr_read<v_rd_off(D0, 2, 0)>(vb), h2 = tr_read<v_rd_off(D0, 2, 1)>(vb), l3 = tr_read<v_rd_off(D0, 3, 0)>(vb), h3 = tr_read<v_rd_off(D0, 3, 1)>(vb);
    asm volatile("s_waitcnt lgkmcnt(0)" ::: "memory"); SBAR();
#define PK(L, H) (bf16x8){L[0], L[1], L[2], L[3], H[0], H[1], H[2], H[3]}
    od = __builtin_amdgcn_mfma_f32_32x32x16_bf16(pa0, PK(l0, h0), od, 0, 0, 0);
    od = __builtin_amdgcn_mfma_f32_32x32x16_bf16(pa1, PK(l1, h1), od, 0, 0, 0);
    od = __builtin_amdgcn_mfma_f32_32x32x16_bf16(pa2, PK(l2, h2), od, 0, 0, 0);
    od = __builtin_amdgcn_mfma_f32_32x32x16_bf16(pa3, PK(l3, h3), od, 0, 0, 0);
#undef PK
}
#ifndef ATT_PV_BY_K
#define ATT_PV_BY_K 1
#endif
#ifndef ATT_PV_TIED
#define ATT_PV_TIED 0
#endif
template <int KS> __device__ __forceinline__ void pv_ks(f32x16* o, int vb, bf16x8 pa) {
    const s16x4 l0 = tr_read<v_rd_off(0, KS, 0)>(vb), h0 = tr_read<v_rd_off(0, KS, 1)>(vb), l1 = tr_read<v_rd_off(1, KS, 0)>(vb), h1 = tr_read<v_rd_off(1, KS, 1)>(vb);
    const s16x4 l2 = tr_read<v_rd_off(2, KS, 0)>(vb), h2 = tr_read<v_rd_off(2, KS, 1)>(vb), l3 = tr_read<v_rd_off(3, KS, 0)>(vb), h3 = tr_read<v_rd_off(3, KS, 1)>(vb);
#if ATT_PV_TIED
    s16x4 L0 = l0, H0 = h0, L1 = l1, H1 = h1, L2 = l2, H2 = h2, L3 = l3, H3 = h3;
    asm volatile("s_waitcnt lgkmcnt(0)" : "+v"(L0), "+v"(H0), "+v"(L1), "+v"(H1), "+v"(L2), "+v"(H2), "+v"(L3), "+v"(H3) :: "memory");
#define PK(L, H) (bf16x8){L[0], L[1], L[2], L[3], H[0], H[1], H[2], H[3]}
    o[0] = __builtin_amdgcn_mfma_f32_32x32x16_bf16(pa, PK(L0, H0), o[0], 0, 0, 0);
    o[1] = __builtin_amdgcn_mfma_f32_32x32x16_bf16(pa, PK(L1, H1), o[1], 0, 0, 0);
    o[2] = __builtin_amdgcn_mfma_f32_32x32x16_bf16(pa, PK(L2, H2), o[2], 0, 0, 0);
    o[3] = __builtin_amdgcn_mfma_f32_32x32x16_bf16(pa, PK(L3, H3), o[3], 0, 0, 0);
#undef PK
    return;
#endif
    asm volatile("s_waitcnt lgkmcnt(0)" ::: "memory"); SBAR();
#define PK(L, H) (bf16x8){L[0], L[1], L[2], L[3], H[0], H[1], H[2], H[3]}
    o[0] = __builtin_amdgcn_mfma_f32_32x32x16_bf16(pa, PK(l0, h0), o[0], 0, 0, 0);
    o[1] = __builtin_amdgcn_mfma_f32_32x32x16_bf16(pa, PK(l1, h1), o[1], 0, 0, 0);
    o[2] = __builtin_amdgcn_mfma_f32_32x32x16_bf16(pa, PK(l2, h2), o[2], 0, 0, 0);
    o[3] = __builtin_amdgcn_mfma_f32_32x32x16_bf16(pa, PK(l3, h3), o[3], 0, 0, 0);
#undef PK
}
#ifndef ATT_PV_PREF
#define ATT_PV_PREF 0
#endif
template <int KS> __device__ __forceinline__ void v_read_ks(s16x4 (&v)[8], int vb) {
    v[0] = tr_read<v_rd_off(0, KS, 0)>(vb); v[1] = tr_read<v_rd_off(0, KS, 1)>(vb); v[2] = tr_read<v_rd_off(1, KS, 0)>(vb); v[3] = tr_read<v_rd_off(1, KS, 1)>(vb);
    v[4] = tr_read<v_rd_off(2, KS, 0)>(vb); v[5] = tr_read<v_rd_off(2, KS, 1)>(vb); v[6] = tr_read<v_rd_off(3, KS, 0)>(vb); v[7] = tr_read<v_rd_off(3, KS, 1)>(vb);
}
__device__ __forceinline__ void pv_mma4(f32x16* o, const s16x4 (&v)[8], bf16x8 pa) {
#define PK(L, H) (bf16x8){L[0], L[1], L[2], L[3], H[0], H[1], H[2], H[3]}
    o[0] = __builtin_amdgcn_mfma_f32_32x32x16_bf16(pa, PK(v[0], v[1]), o[0], 0, 0, 0);
    o[1] = __builtin_amdgcn_mfma_f32_32x32x16_bf16(pa, PK(v[2], v[3]), o[1], 0, 0, 0);
    o[2] = __builtin_amdgcn_mfma_f32_32x32x16_bf16(pa, PK(v[4], v[5]), o[2], 0, 0, 0);
    o[3] = __builtin_amdgcn_mfma_f32_32x32x16_bf16(pa, PK(v[6], v[7]), o[3], 0, 0, 0);
#undef PK
}
__device__ __forceinline__ void pv_d0(f32x16* o, int vb, bf16x8 pa0, bf16x8 pa1, bf16x8 pa2, bf16x8 pa3) {
#if ATT_PV_PREF
    s16x4 va[8], vc[8];
    v_read_ks<0>(va, vb); v_read_ks<1>(vc, vb);
    asm volatile("s_waitcnt lgkmcnt(8)" ::: "memory"); SBAR(); pv_mma4(o, va, pa0); SBAR();
    v_read_ks<2>(va, vb); asm volatile("s_waitcnt lgkmcnt(8)" ::: "memory"); SBAR(); pv_mma4(o, vc, pa1); SBAR();
    v_read_ks<3>(vc, vb); asm volatile("s_waitcnt lgkmcnt(8)" ::: "memory"); SBAR(); pv_mma4(o, va, pa2); SBAR();
    asm volatile("s_waitcnt lgkmcnt(0)" ::: "memory"); SBAR(); pv_mma4(o, vc, pa3);
    return;
#endif
#if ATT_PV_BY_K
    pv_ks<0>(o, vb, pa0); pv_ks<1>(o, vb, pa1); pv_ks<2>(o, vb, pa2); pv_ks<3>(o, vb, pa3);
#else
    pv_one<0>(o[0], vb, pa0, pa1, pa2, pa3); pv_one<1>(o[1], vb, pa0, pa1, pa2, pa3); pv_one<2>(o[2], vb, pa0, pa1, pa2, pa3); pv_one<3>(o[3], vb, pa0, pa1, pa2, pa3);
#endif
}

#ifndef ATT_DMA
#define ATT_DMA 1
#endif
#ifndef ATT_PROBE
#define ATT_PROBE 0
#endif
#if ATT_PROBE == 4
#define ATT_XBAR() __syncthreads()
#else
#define ATT_XBAR() do { } while (0)
#endif
#if ATT_PROBE == 1
#define ATT_PROBE_VALU(P) do { _Pragma("unroll") for (int r_ = 0; r_ < 16; ++r_) { float t0_, t1_; asm volatile("v_exp_f32 %0, %2\n\tv_exp_f32 %1, %2" : "=&v"(t0_), "=&v"(t1_) : "v"(P[r_])); } } while (0)
#else
#define ATT_PROBE_VALU(P) do { } while (0)
#endif
#if ATT_PROBE == 2
#define ATT_PROBE_LDS(vb) do { s16x4 d_[8]; v_read8p<0>(d_, (vb)); v_read8p<1>(d_, (vb)); asm volatile("s_waitcnt lgkmcnt(0)" ::: "memory"); } while (0)
#else
#define ATT_PROBE_LDS(vb) do { } while (0)
#endif
#if ATT_PROBE == 3
#define ATT_PROBE_VALU3 1
#endif
template <int D0> __device__ __forceinline__ void v_read8p(s16x4 (&v)[8], int vb) {
    v[0] = tr_read<v_rd_off(D0, 0, 0)>(vb); v[1] = tr_read<v_rd_off(D0, 0, 1)>(vb); v[2] = tr_read<v_rd_off(D0, 1, 0)>(vb); v[3] = tr_read<v_rd_off(D0, 1, 1)>(vb);
    v[4] = tr_read<v_rd_off(D0, 2, 0)>(vb); v[5] = tr_read<v_rd_off(D0, 2, 1)>(vb); v[6] = tr_read<v_rd_off(D0, 3, 0)>(vb); v[7] = tr_read<v_rd_off(D0, 3, 1)>(vb);
}
template <int PASS>
__device__ __forceinline__ void attn_pass(const bf16* __restrict__ Qb, const bf16* __restrict__ Kh, const bf16* __restrict__ Vh, bf16* __restrict__ Ob,
                                          float lam, const float* __restrict__ subln, float post, LAS unsigned char* lds, const int tid_in) {
    constexpr int LDK = 1024, seq = LK;
    int tid = tid_in; asm volatile("" : "+v"(tid));
    const int wid = tid >> 6, lane = tid & 63, r32 = lane & 31, hi = lane >> 5;
    LAS unsigned char* V_lds = lds + OFF_V; LAS unsigned char* K_lds = lds + OFF_K;
    LAS float* wsl = (LAS float*)(lds + OFF_WS) + wid * 64; LAS float* li_l = wsl; LAS float* al_l = wsl + 32;
    LAS unsigned* park = (LAS unsigned*)(lds + OFF_O0 + wid * 8192);
    float m_reg = -1e30f, l_reg = 0; f32x16 o[4] = {}; bf16x8 qr[4];
    const bf16* Qw = Qb + (size_t)(wid * QBLK + r32) * 1024 + hi * 8;
#pragma unroll
    for (int d0 = 0; d0 < 4; ++d0) qr[d0] = *(const bf16x8*)(Qw + d0 * 16);
    const int sr = tid >> 4, sc = (tid & 15) * 8, vst0 = v_st(sr, sc), vst1 = v_st(32 + sr, sc);
    const int kr = tid >> 3, kc = (tid & 7) * 8, kst = KSWZ64(kr, kc * 2);
    const int vb0 = (int)(uintptr_t)V_lds + v_rd_base(lane);
#if ATT_DMA
    const int widu = __builtin_amdgcn_readfirstlane(wid);
    unsigned kgo, vgo0, vgo1;
    { const int p = widu * 64 + lane, krow_ = p >> 3, kcp = p & 7; kgo = (unsigned)(krow_ * (LDK * 2) + ((kcp ^ (krow_ & 7)) << 4)); }
    { const int p = widu * 64 + lane, s_ = p >> 5, q_ = p & 31, kk = (s_ >> 2) * 8 + (q_ >> 2), k_ = (kk & ~0xC) | ((kk & 4) << 1) | ((kk & 8) >> 1), c_ = (s_ & 3) * 32 + (q_ & 3) * 8; vgo0 = (unsigned)(k_ * (LDK * 2) + c_ * 2); }
    { const int p = (8 + widu) * 64 + lane, s_ = p >> 5, q_ = p & 31, kk = (s_ >> 2) * 8 + (q_ >> 2), k_ = (kk & ~0xC) | ((kk & 4) << 1) | ((kk & 8) >> 1), c_ = (s_ & 3) * 32 + (q_ & 3) * 8; vgo1 = (unsigned)(k_ * (LDK * 2) + c_ * 2); }
#define SDMA(b, k0) do { const char* kt_ = (const char*)Kh + (size_t)(k0) * (LDK * 2); const char* vt_ = (const char*)Vh + (size_t)(k0) * (LDK * 2); \
    __builtin_amdgcn_global_load_lds((const unsigned*)(kt_ + kgo), (LAS unsigned*)(K_lds + (b) * SHM_K + widu * 1024), 16, 0, 0); \
    __builtin_amdgcn_global_load_lds((const unsigned*)(vt_ + vgo0), (LAS unsigned*)(V_lds + (b) * SHM_V + widu * 1024), 16, 0, 0); \
    __builtin_amdgcn_global_load_lds((const unsigned*)(vt_ + vgo1), (LAS unsigned*)(V_lds + (b) * SHM_V + (8 + widu) * 1024), 16, 0, 0); } while (0)
#endif
    struct { bf16x8 vs0, vs1, ks0; } sr_[1];
#define SLOAD(i, k0) do { sr_[i].vs0 = *(const bf16x8*)(&Vh[(size_t)((k0) + sr) * LDK + sc]); sr_[i].vs1 = *(const bf16x8*)(&Vh[(size_t)((k0) + 32 + sr) * LDK + sc]); \
    sr_[i].ks0 = *(const bf16x8*)(&Kh[(size_t)((k0) + kr) * LDK + kc]); } while (0)
#define SWRITE(b, i) do { *(LAS bf16x8*)(V_lds + (b) * SHM_V + vst0) = sr_[i].vs0; *(LAS bf16x8*)(V_lds + (b) * SHM_V + vst1) = sr_[i].vs1; \
    *(LAS bf16x8*)(K_lds + (b) * SHM_K + kst) = sr_[i].ks0; } while (0)
#define SWAIT() asm volatile("s_waitcnt vmcnt(0)" ::: "memory")
#define RESC(a) do { if (__any((a) < 1.f)) { if (hi == 0) al_l[r32] = (a); asm volatile("s_waitcnt lgkmcnt(0)" ::: "memory"); \
    _Pragma("unroll") for (int d = 0; d < 4; ++d) _Pragma("unroll") for (int r = 0; r < 16; ++r) o[d][r] *= al_l[crow(r, hi)]; } } while (0)
    f32x16 pA0, pA1, pB0, pB1; float mnA, mnB, alA, alB; bf16x8 pa0, pa1, pa2, pa3; constexpr int NT = seq / KVBLK;
#if ATT_DMA
    SDMA(0, 0); SWAIT(); __syncthreads();
#else
    SLOAD(0, 0); asm volatile("s_waitcnt vmcnt(0)" ::: "memory"); SWRITE(0, 0); __syncthreads();
#endif
    qkt(pA0, pA1, K_lds, qr, r32, hi); partialSM(pA0, pA1, m_reg, mnA, alA);
#if ATT_DMA
    SDMA(1, KVBLK); SWAIT(); __syncthreads();
#else
    SLOAD(0, KVBLK);
    SWAIT(); SWRITE(1, 0); __syncthreads();
#endif
    int bc = 1;
#if ATT_DMA
#define ATT_STAGE_ISSUE(b, k0) SDMA(b, k0)
#define ATT_STAGE_LAND(b) SWAIT()
#else
#define ATT_STAGE_ISSUE(b, k0) SLOAD(0, k0)
#define ATT_STAGE_LAND(b) do { SWAIT(); SWRITE(b, 0); } while (0)
#endif
#define ATT_STEP(PC0, PC1, MNC, ALC, PP0, PP1, ALP, KNEXT) do { const int bp_ = bc == 0 ? 2 : bc - 1, bn_ = bc == 2 ? 0 : bc + 1; \
        SBAR(); qkt(PC0, PC1, K_lds + bc * SHM_K, qr, r32, hi); \
        finishSM(PP0, PP1, ALP, l_reg, pa0, pa1, pa2, pa3); ATT_PROBE_VALU(PP0); SBAR(); \
        ATT_STAGE_ISSUE(bn_, (KNEXT)); SBAR(); ATT_PROBE_LDS(vb0 + bp_ * SHM_V); \
        pv_d0(o, vb0 + bp_ * SHM_V, pa0, pa1, pa2, pa3); partialSM(PC0, PC1, m_reg, MNC, ALC); \
        ATT_STAGE_LAND(bn_); \
        RESC(ALC); __syncthreads(); ATT_XBAR(); bc = bn_; } while (0)
    for (int j = 1; j + 1 < NT; j += 2) {
        ATT_STEP(pB0, pB1, mnB, alB, pA0, pA1, alA, (j + 1) * KVBLK);
        ATT_STEP(pA0, pA1, mnA, alA, pB0, pB1, alB, (j + 2) * KVBLK);
    }
#undef ATT_STEP
    {
        const int bp_ = bc == 0 ? 2 : bc - 1;
        SBAR(); qkt(pB0, pB1, K_lds + bc * SHM_K, qr, r32, hi);
        finishSM(pA0, pA1, alA, l_reg, pa0, pa1, pa2, pa3); SBAR();
        pv_d0(o, vb0 + bp_ * SHM_V, pa0, pa1, pa2, pa3); partialSM(pB0, pB1, m_reg, mnB, alB);
        RESC(alB);
        finishSM(pB0, pB1, alB, l_reg, pa0, pa1, pa2, pa3); SBAR();
        pv_d0(o, vb0 + bc * SHM_V, pa0, pa1, pa2, pa3);
    }
    if (hi == 0) li_l[r32] = l_reg; asm volatile("s_waitcnt lgkmcnt(0)" ::: "memory");
    float rli[16];
#pragma unroll
    for (int r = 0; r < 16; ++r) rli[r] = __builtin_amdgcn_rcpf(li_l[crow(r, hi)]);
    if constexpr (PASS == 0) {
#pragma unroll
        for (int d0 = 0; d0 < 4; ++d0)
#pragma unroll
            for (int r = 0; r < 16; r += 2) park[(d0 * 8 + (r >> 1)) * 64 + lane] = cvtpk(o[d0][r] * rli[r], o[d0][r + 1] * rli[r + 1]);
    } else {
        float ss[16];
#pragma unroll
        for (int r = 0; r < 16; r += 2) {
            float s0 = 0.f, s1 = 0.f;
#pragma unroll
            for (int d0 = 0; d0 < 4; ++d0) { const unsigned w = park[(d0 * 8 + (r >> 1)) * 64 + lane];
                const float a = bflo(w) - lam * (o[d0][r] * rli[r]), b = bfhi(w) - lam * (o[d0][r + 1] * rli[r + 1]);
                o[d0][r] = a; o[d0][r + 1] = b; s0 += a * a; s1 += b * b; }
            ss[r] = s0; ss[r + 1] = s1;
        }
#pragma unroll
        for (int r = 0; r < 16; ++r) {
            float s = ss[r];
            s += __shfl_xor(s, 1); s += __shfl_xor(s, 2); s += __shfl_xor(s, 4); s += __shfl_xor(s, 8); s += __shfl_xor(s, 16);
            ss[r] = post * (1.0f / sqrtf(s * (1.f / 128.f) + LN_EPS));
        }
        float sl[4];
#pragma unroll
        for (int d0 = 0; d0 < 4; ++d0) sl[d0] = subln[d0 * 32 + r32];
        bf16* Ow = Ob + (size_t)(wid * QBLK) * 1024;
#pragma unroll
        for (int r = 0; r < 16; ++r) { const int orow = crow(r, hi);
#pragma unroll
            for (int d0 = 0; d0 < 4; ++d0) Ow[(size_t)orow * 1024 + d0 * 32 + r32] = (bf16)(cvtpk(o[d0][r] * ss[r] * sl[d0], 0.f) & 0xffff); }
    }
    __syncthreads();
#undef SLOAD
#undef SWRITE
#undef SWAIT
#undef RESC
}

template <int OFF> __device__ __forceinline__ bf16x8 k_read(int a) { bf16x8 r; asm volatile("ds_read_b128 %0, %1 offset:%2" : "=&v"(r) : "v"(a), "i"(OFF) : "memory"); return r; }
#define LGKM(n) asm volatile("s_waitcnt lgkmcnt(" #n ")" ::: "memory")
#define PPBAR() do { asm volatile("s_waitcnt lgkmcnt(0)" ::: "memory"); __builtin_amdgcn_s_barrier(); asm volatile("" ::: "memory"); } while (0)
template <int D0> __device__ __forceinline__ void v_read8(s16x4 (&v)[8], int vb) {
    v[0] = tr_read<v_rd_off(D0, 0, 0)>(vb); v[1] = tr_read<v_rd_off(D0, 0, 1)>(vb); v[2] = tr_read<v_rd_off(D0, 1, 0)>(vb); v[3] = tr_read<v_rd_off(D0, 1, 1)>(vb);
    v[4] = tr_read<v_rd_off(D0, 2, 0)>(vb); v[5] = tr_read<v_rd_off(D0, 2, 1)>(vb); v[6] = tr_read<v_rd_off(D0, 3, 0)>(vb); v[7] = tr_read<v_rd_off(D0, 3, 1)>(vb);
}
__device__ __forceinline__ void pv4(f32x16& od, const s16x4 (&v)[8], bf16x8 pa0, bf16x8 pa1, bf16x8 pa2, bf16x8 pa3) {
#define PK(L, H) (bf16x8){L[0], L[1], L[2], L[3], H[0], H[1], H[2], H[3]}
    od = __builtin_amdgcn_mfma_f32_32x32x16_bf16(pa0, PK(v[0], v[1]), od, 0, 0, 0);
    od = __builtin_amdgcn_mfma_f32_32x32x16_bf16(pa1, PK(v[2], v[3]), od, 0, 0, 0);
    od = __builtin_amdgcn_mfma_f32_32x32x16_bf16(pa2, PK(v[4], v[5]), od, 0, 0, 0);
    od = __builtin_amdgcn_mfma_f32_32x32x16_bf16(pa3, PK(v[6], v[7]), od, 0, 0, 0);
#undef PK
}
template <int PASS>
__device__ __forceinline__ void attn_pass_pp(const bf16* __restrict__ Qb, const bf16* __restrict__ Kh, const bf16* __restrict__ Vh, bf16* __restrict__ Ob,
                                             float lam, const float* __restrict__ subln, float post, LAS unsigned char* lds, const int tid_in) {
    constexpr int LDK = 1024, seq = LK, NT = seq / KVBLK;
    int tid = tid_in; asm volatile("" : "+v"(tid));
    const int wid = tid >> 6, lane = tid & 63, r32 = lane & 31, hi = lane >> 5;
    const int simd = (int)__builtin_amdgcn_s_getreg((1 << 11) | (4 << 6) | 4);
    LAS int* sm = (LAS int*)(lds + LDS_MISC + 1024);
    if (lane == 0) sm[wid] = simd;
    __syncthreads();
    int rank = 0;
#pragma unroll
    for (int w = 0; w < NWAVES; ++w) rank += (w < wid && sm[w] == simd) ? 1 : 0;
#ifdef ATT_ROLE
    const int grp = __builtin_amdgcn_readfirstlane(ATT_ROLE(wid));
#else
    const int grp = __builtin_amdgcn_readfirstlane(rank & 1);
#endif
    LAS unsigned char* V_lds = lds + OFF_V; LAS unsigned char* K_lds = lds + OFF_K;
    LAS float* wsl = (LAS float*)(lds + OFF_WS) + wid * 64; LAS float* li_l = wsl; LAS float* al_l = wsl + 32;
    LAS unsigned* park = (LAS unsigned*)(lds + OFF_O0 + wid * 8192);
    float m_reg = -1e30f, l_reg = 0; f32x16 o[4] = {}; bf16x8 qr[4];
    const bf16* Qw = Qb + (size_t)(wid * QBLK + r32) * 1024 + hi * 8;
#pragma unroll
    for (int d0 = 0; d0 < 4; ++d0) qr[d0] = *(const bf16x8*)(Qw + d0 * 16);
    const int sr = tid >> 4, sc = (tid & 15) * 8, vst0 = v_st(sr, sc), vst1 = v_st(32 + sr, sc);
    const int kr = tid >> 3, kc = (tid & 7) * 8, kst = KSWZ64(kr, kc * 2);
    const int vb0 = (int)(uintptr_t)V_lds + v_rd_base(lane);
    int kad[4];
#pragma unroll
    for (int d0 = 0; d0 < 4; ++d0) kad[d0] = (int)(uintptr_t)K_lds + KSWZ64(r32, (d0 * 16 + hi * 8) * 2);
    struct { bf16x8 vs0, vs1, ks0; } sr_[1];
#define SLOAD(i, k0) do { sr_[i].vs0 = *(const bf16x8*)(&Vh[(size_t)((k0) + sr) * LDK + sc]); sr_[i].vs1 = *(const bf16x8*)(&Vh[(size_t)((k0) + 32 + sr) * LDK + sc]); \
    sr_[i].ks0 = *(const bf16x8*)(&Kh[(size_t)((k0) + kr) * LDK + kc]); } while (0)
#define SWRITE(b, i) do { *(LAS bf16x8*)(V_lds + (b) * SHM_V + vst0) = sr_[i].vs0; *(LAS bf16x8*)(V_lds + (b) * SHM_V + vst1) = sr_[i].vs1; \
    *(LAS bf16x8*)(K_lds + (b) * SHM_K + kst) = sr_[i].ks0; } while (0)
#define SWAIT() asm volatile("s_waitcnt vmcnt(0)" ::: "memory")
#define RESC(a) do { if (__any((a) < 1.f)) { if (hi == 0) al_l[r32] = (a); asm volatile("s_waitcnt lgkmcnt(0)" ::: "memory"); \
    _Pragma("unroll") for (int d = 0; d < 4; ++d) _Pragma("unroll") for (int r = 0; r < 16; ++r) o[d][r] *= al_l[crow(r, hi)]; } } while (0)
    f32x16 p0, p1; float mn, al; bf16x8 pa0, pa1, pa2, pa3;
#define QKT_ISSUE(kb_) const int kof_ = (kb_) * SHM_K; \
        const bf16x8 ka0 = k_read<0>(kad[0] + kof_), kb0 = k_read<4096>(kad[0] + kof_), ka1 = k_read<0>(kad[1] + kof_), kb1 = k_read<4096>(kad[1] + kof_); \
        const bf16x8 ka2 = k_read<0>(kad[2] + kof_), kb2 = k_read<4096>(kad[2] + kof_), ka3 = k_read<0>(kad[3] + kof_), kb3 = k_read<4096>(kad[3] + kof_)
#define QKT_MMA() do { p0 = f32x16{}; p1 = f32x16{}; \
        p0 = __builtin_amdgcn_mfma_f32_32x32x16_bf16(ka0, qr[0], p0, 0, 0, 0); p1 = __builtin_amdgcn_mfma_f32_32x32x16_bf16(kb0, qr[0], p1, 0, 0, 0); \
        p0 = __builtin_amdgcn_mfma_f32_32x32x16_bf16(ka1, qr[1], p0, 0, 0, 0); p1 = __builtin_amdgcn_mfma_f32_32x32x16_bf16(kb1, qr[1], p1, 0, 0, 0); \
        p0 = __builtin_amdgcn_mfma_f32_32x32x16_bf16(ka2, qr[2], p0, 0, 0, 0); p1 = __builtin_amdgcn_mfma_f32_32x32x16_bf16(kb2, qr[2], p1, 0, 0, 0); \
        p0 = __builtin_amdgcn_mfma_f32_32x32x16_bf16(ka3, qr[3], p0, 0, 0, 0); p1 = __builtin_amdgcn_mfma_f32_32x32x16_bf16(kb3, qr[3], p1, 0, 0, 0); } while (0)
    SLOAD(0, 0); SWAIT(); SWRITE(0, 0); SLOAD(0, KVBLK); __syncthreads();
    if (grp == 1) PPBAR();
    {
        SWAIT(); SWRITE(1, 0); SLOAD(0, 2 * KVBLK);
        QKT_ISSUE(0); LGKM(0); SBAR(); __builtin_amdgcn_s_setprio(1); QKT_MMA(); __builtin_amdgcn_s_setprio(0); SBAR();
    }
    PPBAR();
    int bj = 0;
    for (int j = 0; j + 1 < NT; ++j) {
        partialSM(p0, p1, m_reg, mn, al); RESC(al); finishSM(p0, p1, al, l_reg, pa0, pa1, pa2, pa3);
        PPBAR();
        const int bj1 = bj == 2 ? 0 : bj + 1, bj2 = bj1 == 2 ? 0 : bj1 + 1;
        {
            SWAIT(); SWRITE(bj2, 0);
            { const int tn = j + 3 < NT ? j + 3 : NT - 1; SLOAD(0, tn * KVBLK); }
            SBAR();
            QKT_ISSUE(bj1);
            const int vb = vb0 + bj * SHM_V;
            s16x4 va[8], vc[8];
            v_read8<0>(va, vb);
            LGKM(8); SBAR(); __builtin_amdgcn_s_setprio(1);
            QKT_MMA(); SBAR();
            v_read8<1>(vc, vb); LGKM(8); SBAR(); pv4(o[0], va, pa0, pa1, pa2, pa3); SBAR();
            v_read8<2>(va, vb); LGKM(8); SBAR(); pv4(o[1], vc, pa0, pa1, pa2, pa3); SBAR();
            v_read8<3>(vc, vb); LGKM(8); SBAR(); pv4(o[2], va, pa0, pa1, pa2, pa3); SBAR();
            LGKM(0); SBAR(); pv4(o[3], vc, pa0, pa1, pa2, pa3); __builtin_amdgcn_s_setprio(0); SBAR();
        }
        PPBAR();
        bj = bj1;
    }
    partialSM(p0, p1, m_reg, mn, al); RESC(al); finishSM(p0, p1, al, l_reg, pa0, pa1, pa2, pa3);
    PPBAR();
    {
        const int vb = vb0 + bj * SHM_V; s16x4 va[8], vc[8];
        v_read8<0>(va, vb); v_read8<1>(vc, vb); LGKM(8); SBAR(); pv4(o[0], va, pa0, pa1, pa2, pa3); SBAR();
        v_read8<2>(va, vb); LGKM(8); SBAR(); pv4(o[1], vc, pa0, pa1, pa2, pa3); SBAR();
        v_read8<3>(vc, vb); LGKM(8); SBAR(); pv4(o[2], va, pa0, pa1, pa2, pa3); SBAR();
        LGKM(0); SBAR(); pv4(o[3], vc, pa0, pa1, pa2, pa3); SBAR();
    }
    SWAIT();
    if (grp == 0) PPBAR();
#undef QKT_ISSUE
#undef QKT_MMA
    if (hi == 0) li_l[r32] = l_reg; asm volatile("s_waitcnt lgkmcnt(0)" ::: "memory");
    float rli[16];
#pragma unroll
    for (int r = 0; r < 16; ++r) rli[r] = __builtin_amdgcn_rcpf(li_l[crow(r, hi)]);
    if constexpr (PASS == 0) {
#pragma unroll
        for (int d0 = 0; d0 < 4; ++d0)
#pragma unroll
            for (int r = 0; r < 16; r += 2) park[(d0 * 8 + (r >> 1)) * 64 + lane] = cvtpk(o[d0][r] * rli[r], o[d0][r + 1] * rli[r + 1]);
    } else {
        float ss[16];
#pragma unroll
        for (int r = 0; r < 16; r += 2) {
            float s0 = 0.f, s1 = 0.f;
#pragma unroll
            for (int d0 = 0; d0 < 4; ++d0) { const unsigned w = park[(d0 * 8 + (r >> 1)) * 64 + lane];
                const float a = bflo(w) - lam * (o[d0][r] * rli[r]), b = bfhi(w) - lam * (o[d0][r + 1] * rli[r + 1]);
                o[d0][r] = a; o[d0][r + 1] = b; s0 += a * a; s1 += b * b; }
            ss[r] = s0; ss[r + 1] = s1;
        }
#pragma unroll
        for (int r = 0; r < 16; ++r) {
            float s = ss[r];
            s += __shfl_xor(s, 1); s += __shfl_xor(s, 2); s += __shfl_xor(s, 4); s += __shfl_xor(s, 8); s += __shfl_xor(s, 16);
            ss[r] = post * (1.0f / sqrtf(s * (1.f / 128.f) + LN_EPS));
        }
        float sl[4];
#pragma unroll
        for (int d0 = 0; d0 < 4; ++d0) sl[d0] = subln[d0 * 32 + r32];
        bf16* Ow = Ob + (size_t)(wid * QBLK) * 1024;
#pragma unroll
        for (int r = 0; r < 16; ++r) { const int orow = crow(r, hi);
#pragma unroll
            for (int d0 = 0; d0 < 4; ++d0) Ow[(size_t)orow * 1024 + d0 * 32 + r32] = (bf16)(cvtpk(o[d0][r] * ss[r] * sl[d0], 0.f) & 0xffff); }
    }
    __syncthreads();
#undef SLOAD
#undef SWRITE
#undef SWAIT
#undef RESC
}
template <int PASS>
__device__ __forceinline__ void attn_pass_il(const bf16* __restrict__ Qb, const bf16* __restrict__ Kh, const bf16* __restrict__ Vh, bf16* __restrict__ Ob,
                                          float lam, const float* __restrict__ subln, float post, LAS unsigned char* lds, const int tid_in) {
    constexpr int LDK = 1024, seq = LK;
    int tid = tid_in; asm volatile("" : "+v"(tid));
    const int wid = tid >> 6, lane = tid & 63, r32 = lane & 31, hi = lane >> 5;
    LAS unsigned char* V_lds = lds + OFF_V; LAS unsigned char* K_lds = lds + OFF_K;
    LAS float* wsl = (LAS float*)(lds + OFF_WS) + wid * 64; LAS float* li_l = wsl; LAS float* al_l = wsl + 32;
    LAS unsigned* park = (LAS unsigned*)(lds + OFF_O0 + wid * 8192);
    float m_reg = -1e30f, l_reg = 0; f32x16 o[4] = {}; bf16x8 qr[4];
    const bf16* Qw = Qb + (size_t)(wid * QBLK + r32) * 1024 + hi * 8;
#pragma unroll
    for (int d0 = 0; d0 < 4; ++d0) qr[d0] = *(const bf16x8*)(Qw + d0 * 16);
    const int sr = tid >> 4, sc = (tid & 15) * 8, vst0 = v_st(sr, sc), vst1 = v_st(32 + sr, sc);
    const int kr = tid >> 3, kc = (tid & 7) * 8, kst = KSWZ64(kr, kc * 2);
    const int vb0 = (int)(uintptr_t)V_lds + v_rd_base(lane);
    struct { bf16x8 vs0, vs1, ks0; } sr_[1];
#define SLOAD(i, k0) do { sr_[i].vs0 = *(const bf16x8*)(&Vh[(size_t)((k0) + sr) * LDK + sc]); sr_[i].vs1 = *(const bf16x8*)(&Vh[(size_t)((k0) + 32 + sr) * LDK + sc]); \
    sr_[i].ks0 = *(const bf16x8*)(&Kh[(size_t)((k0) + kr) * LDK + kc]); } while (0)
#define SWRITE(b, i) do { *(LAS bf16x8*)(V_lds + (b) * SHM_V + vst0) = sr_[i].vs0; *(LAS bf16x8*)(V_lds + (b) * SHM_V + vst1) = sr_[i].vs1; \
    *(LAS bf16x8*)(K_lds + (b) * SHM_K + kst) = sr_[i].ks0; } while (0)
#define SWAIT() asm volatile("s_waitcnt vmcnt(0)" ::: "memory")
#define RESC(a) do { if (__any((a) < 1.f)) { if (hi == 0) al_l[r32] = (a); asm volatile("s_waitcnt lgkmcnt(0)" ::: "memory"); \
    _Pragma("unroll") for (int d = 0; d < 4; ++d) _Pragma("unroll") for (int r = 0; r < 16; ++r) o[d][r] *= al_l[crow(r, hi)]; } } while (0)
    f32x16 pA0, pA1, pB0, pB1; float mnA, mnB, alA, alB; bf16x8 pa0, pa1, pa2, pa3; constexpr int NT = seq / KVBLK;
    SLOAD(0, 0); asm volatile("s_waitcnt vmcnt(0)" ::: "memory"); SWRITE(0, 0); __syncthreads();
    qkt(pA0, pA1, K_lds, qr, r32, hi); partialSM(pA0, pA1, m_reg, mnA, alA);
    SLOAD(0, KVBLK);
    SWAIT(); SWRITE(1, 0); __syncthreads();
    int bc = 1;
#define ATT_STEP(PC0, PC1, MNC, ALC, PP0, PP1, ALP, KNEXT) do { const int bp_ = bc == 0 ? 2 : bc - 1, bn_ = bc == 2 ? 0 : bc + 1; \
        SBAR(); qkt(PC0, PC1, K_lds + bc * SHM_K, qr, r32, hi); \
        finishSM(PP0, PP1, ALP, l_reg, pa0, pa1, pa2, pa3); SBAR(); \
        SLOAD(0, (KNEXT)); SBAR(); \
          \
        { const int vb_ = vb0 + bp_ * SHM_V; s16x4 va[8], vc[8]; float pm_, mnC_; constexpr float C_ = SCALE * 1.4426950408889634f; \
          v_read8<0>(va, vb_); v_read8<1>(vc, vb_); \
          LGKM(8); SBAR(); pv4(o[0], va, pa0, pa1, pa2, pa3); SBAR(); \
          pm_ = PC0[0]; _Pragma("unroll") for (int r = 1; r < 16; ++r) pm_ = fmaxf(pm_, PC0[r]); SBAR(); \
          v_read8<2>(va, vb_); LGKM(8); SBAR(); pv4(o[1], vc, pa0, pa1, pa2, pa3); SBAR(); \
          _Pragma("unroll") for (int r = 0; r < 16; ++r) pm_ = fmaxf(pm_, PC1[r]); \
          { auto rr = __builtin_amdgcn_permlane32_swap(__float_as_uint(pm_), __float_as_uint(pm_), false, false); pm_ = fmaxf(__uint_as_float(rr[0]), __uint_as_float(rr[1])); } \
          if (__builtin_expect(__all(pm_ - m_reg <= THR / SCALE), 1)) { MNC = m_reg; ALC = 1.f; } \
          else { MNC = fmaxf(m_reg, pm_); ALC = __builtin_amdgcn_exp2f((m_reg - MNC) * C_); m_reg = MNC; } \
          mnC_ = -MNC * C_; SBAR(); \
          v_read8<3>(vc, vb_); LGKM(8); SBAR(); pv4(o[2], va, pa0, pa1, pa2, pa3); SBAR(); \
          _Pragma("unroll") for (int r = 0; r < 16; ++r) PC0[r] = fmaf(PC0[r], C_, mnC_); \
          _Pragma("unroll") for (int r = 0; r < 16; ++r) PC1[r] = fmaf(PC1[r], C_, mnC_); SBAR(); \
          LGKM(0); SBAR(); pv4(o[3], vc, pa0, pa1, pa2, pa3); SBAR(); \
          _Pragma("unroll") for (int r = 0; r < 16; ++r) PC0[r] = __builtin_amdgcn_exp2f(PC0[r]); SBAR(); } \
        SWAIT(); SWRITE(bn_, 0); \
        RESC(ALC); __syncthreads(); bc = bn_; } while (0)
    for (int j = 1; j + 1 < NT; j += 2) {
        ATT_STEP(pB0, pB1, mnB, alB, pA0, pA1, alA, (j + 1) * KVBLK);
        ATT_STEP(pA0, pA1, mnA, alA, pB0, pB1, alB, (j + 2) * KVBLK);
    }
#undef ATT_STEP
    {
        const int bp_ = bc == 0 ? 2 : bc - 1;
        SBAR(); qkt(pB0, pB1, K_lds + bc * SHM_K, qr, r32, hi);
        finishSM(pA0, pA1, alA, l_reg, pa0, pa1, pa2, pa3); SBAR();
        pv_d0(o, vb0 + bp_ * SHM_V, pa0, pa1, pa2, pa3); partialSM(pB0, pB1, m_reg, mnB, alB);
        RESC(alB);
        finishSM(pB0, pB1, alB, l_reg, pa0, pa1, pa2, pa3); SBAR();
        pv_d0(o, vb0 + bc * SHM_V, pa0, pa1, pa2, pa3);
    }
    if (hi == 0) li_l[r32] = l_reg; asm volatile("s_waitcnt lgkmcnt(0)" ::: "memory");
    float rli[16];
#pragma unroll
    for (int r = 0; r < 16; ++r) rli[r] = __builtin_amdgcn_rcpf(li_l[crow(r, hi)]);
    if constexpr (PASS == 0) {
#pragma unroll
        for (int d0 = 0; d0 < 4; ++d0)
#pragma unroll
            for (int r = 0; r < 16; r += 2) park[(d0 * 8 + (r >> 1)) * 64 + lane] = cvtpk(o[d0][r] * rli[r], o[d0][r + 1] * rli[r + 1]);
    } else {
        float ss[16];
#pragma unroll
        for (int r = 0; r < 16; r += 2) {
            float s0 = 0.f, s1 = 0.f;
#pragma unroll
            for (int d0 = 0; d0 < 4; ++d0) { const unsigned w = park[(d0 * 8 + (r >> 1)) * 64 + lane];
                const float a = bflo(w) - lam * (o[d0][r] * rli[r]), b = bfhi(w) - lam * (o[d0][r + 1] * rli[r + 1]);
                o[d0][r] = a; o[d0][r + 1] = b; s0 += a * a; s1 += b * b; }
            ss[r] = s0; ss[r + 1] = s1;
        }
#pragma unroll
        for (int r = 0; r < 16; ++r) {
            float s = ss[r];
            s += __shfl_xor(s, 1); s += __shfl_xor(s, 2); s += __shfl_xor(s, 4); s += __shfl_xor(s, 8); s += __shfl_xor(s, 16);
            ss[r] = post * (1.0f / sqrtf(s * (1.f / 128.f) + LN_EPS));
        }
        float sl[4];
#pragma unroll
        for (int d0 = 0; d0 < 4; ++d0) sl[d0] = subln[d0 * 32 + r32];
        bf16* Ow = Ob + (size_t)(wid * QBLK) * 1024;
#pragma unroll
        for (int r = 0; r < 16; ++r) { const int orow = crow(r, hi);
#pragma unroll
            for (int d0 = 0; d0 < 4; ++d0) Ow[(size_t)orow * 1024 + d0 * 32 + r32] = (bf16)(cvtpk(o[d0][r] * ss[r] * sl[d0], 0.f) & 0xffff); }
    }
    __syncthreads();
#undef SLOAD
#undef SWRITE
#undef SWAIT
#undef RESC
}

#undef LGKM
#undef PPBAR
}
__device__ __forceinline__ void st4(bf16* p, f32x4 v) { *(u32x2*)p = (u32x2){pk2(v.x, v.y), pk2(v.z, v.w)}; }

template <int lda, int ldb, int ldc, int KK>
struct PlainP {
    const bf16* a0; const bf16* b0; bf16* out; const float* bias; const float* scale;
    static constexpr int K = KK;
    __device__ __forceinline__ const bf16* abase() const { return a0; }
    __device__ __forceinline__ const bf16* bbase() const { return b0; }
    __device__ __forceinline__ unsigned aoff(int r) const { return (unsigned)(r * lda); }
    __device__ __forceinline__ unsigned boff(int r) const { return (unsigned)(r * ldb); }
    __device__ __forceinline__ void epi(f32x4 (&acc)[8][4], int wr, int wc, int fr, int fq) const {
#pragma unroll
        for (int nb = 0; nb < 4; ++nb) {
            const int col = wc * 64 + nb * 16 + 4 * fq;
            const f32x4 bv = bias ? *(const f32x4*)(bias + col) : (f32x4){0.f, 0.f, 0.f, 0.f};
            const f32x4 sv = scale ? *(const f32x4*)(scale + col) : (f32x4){1.f, 1.f, 1.f, 1.f};
#pragma unroll
            for (int mb = 0; mb < 8; ++mb) st4(out + (size_t)(wr * 128 + mb * 16 + fr) * ldc + col, (acc[mb][nb] + bv) * sv);
        }
    }
};
struct QkvP {
    const bf16* a0; const bf16* b0; int pm, pn; bf16 *Q, *Kb, *Vb; const float* rope;
    static constexpr int K = 1024;
    __device__ __forceinline__ const bf16* abase() const { return a0; }
    __device__ __forceinline__ const bf16* bbase() const { return b0; }
    __device__ __forceinline__ unsigned aoff(int r) const { return (unsigned)(r * 1024); }
    __device__ __forceinline__ unsigned boff(int r) const { return (unsigned)(r * 1024); }
    __device__ __forceinline__ void epi(f32x4 (&acc)[8][4], int wr, int wc, int fr, int fq) const {
        const int part = pn >> 2, cbase = (pn & 3) * 256 + wc * 64 + 4 * fq;
#pragma unroll
        for (int mb = 0; mb < 8; ++mb) {
            const int m = pm * 256 + wr * 128 + mb * 16 + fr; const bool latent = m < T;
            int kvrow, l = 0;
            if (latent) { const int b = m / SEQ; l = m % SEQ; kvrow = b * LK + l; } else { const int mm = m - T; kvrow = (mm / CTXL) * LK + SEQ + (mm % CTXL); }
            f32x4 v0 = acc[mb][0], v1 = acc[mb][1], v2 = acc[mb][2], v3 = acc[mb][3];
            if (part < 2 && latent) {
                const int rp = l >> 6, cp = l & 63;
                const f32x4 cr = *(const f32x4*)(rope + rp * 16 + 4 * fq), sr = *(const f32x4*)(rope + 2048 + rp * 16 + 4 * fq);
                const f32x4 cc = *(const f32x4*)(rope + 4096 + cp * 16 + 4 * fq), sc = *(const f32x4*)(rope + 5120 + cp * 16 + 4 * fq);
                const f32x4 a = v0, b = v1, c = v2, d = v3;
                v0 = a * cr - b * sr; v1 = b * cr + a * sr; v2 = c * cc - d * sc; v3 = d * cc + c * sc;
            }
            bf16* dst = (part == 0 ? Q + (size_t)m * 1024 : (part == 1 ? Kb : Vb) + (size_t)kvrow * 1024) + cbase;
            if (part > 0 || latent) { st4(dst, v0); st4(dst + 16, v1); st4(dst + 32, v2); st4(dst + 48, v3); }
        }
    }
};
struct GuP {
    const bf16* HA; const int* list; int cnt, rt; const bf16* b0; bf16* out;
    static constexpr int K = 1024;
    __device__ __forceinline__ const bf16* abase() const { return HA; }
    __device__ __forceinline__ const bf16* bbase() const { return b0; }
    __device__ __forceinline__ unsigned aoff(int r) const { const int idx = rt * 256 + r; const int tok = idx < cnt ? (list[idx] >> 1) : 0; return (unsigned)(tok * 1024); }
    __device__ __forceinline__ unsigned boff(int r) const { return (unsigned)(r * 1024); }
    __device__ __forceinline__ void epi(f32x4 (&acc)[8][4], int wr, int wc, int fr, int fq) const {
#pragma unroll
        for (int mb = 0; mb < 8; ++mb)
#pragma unroll
            for (int nb = 0; nb < 2; ++nb) {
                const f32x4 g = acc[mb][nb], u = acc[mb][nb + 2];
                const f32x4 h = {fsilu(g.x) * u.x, fsilu(g.y) * u.y, fsilu(g.z) * u.z, fsilu(g.w) * u.w};
                st4(out + (size_t)(wr * 128 + mb * 16 + fr) * 1024 + wc * 32 + nb * 16 + 4 * fq, h);
            }
    }
};
struct DnP {
    const bf16* a0; const bf16* b0; const int* list; const float* tokw; int cnt, rt; bf16* Y2; int col0;
    static constexpr int K = 1024;
    __device__ __forceinline__ const bf16* abase() const { return a0; }
    __device__ __forceinline__ const bf16* bbase() const { return b0; }
    __device__ __forceinline__ unsigned aoff(int r) const { return (unsigned)(r * 1024); }
    __device__ __forceinline__ unsigned boff(int r) const { return (unsigned)(r * 1024); }
    __device__ __forceinline__ void epi(f32x4 (&acc)[8][4], int wr, int wc, int fr, int fq) const {
#pragma unroll
        for (int mb = 0; mb < 8; ++mb) {
            const int idx = rt * 256 + wr * 128 + mb * 16 + fr;
            if (idx < cnt) { const int slot = list[idx]; const float w = tokw[slot];
#pragma unroll
                for (int nb = 0; nb < 4; ++nb) st4(Y2 + (size_t)slot * 1024 + col0 + wc * 64 + nb * 16 + 4 * fq, acc[mb][nb] * w); }
        }
    }
};
struct FwP {
    const bf16* A; const bf16* B; bf16* FW; int kbase, colk, ct;
    static constexpr int K = 256;
    __device__ __forceinline__ const bf16* abase() const { return A; }
    __device__ __forceinline__ const bf16* bbase() const { return B; }
    __device__ __forceinline__ unsigned aoff(int r) const { return (unsigned)(r * 256); }
    __device__ __forceinline__ unsigned boff(int k) const { return (unsigned)(k * 1024); }
    __device__ __forceinline__ void epi(f32x4 (&acc)[4][4], int wr, int wc, int fr, int fq) const {
#pragma unroll
        for (int mb = 0; mb < 4; ++mb) { const int kidx = kbase + wr * 64 + mb * 16 + fr;
#pragma unroll
            for (int nb = 0; nb < 4; ++nb) { const int n = ct * 256 + wc * 64 + nb * 16 + 4 * fq; bf16* o = FW + (size_t)n * 2048 + colk + kidx; const f32x4 v = acc[mb][nb];
                o[0] = (bf16)(pk2(v.x, 0.f) & 0xffff); o[2048] = (bf16)(pk2(v.y, 0.f) & 0xffff); o[4096] = (bf16)(pk2(v.z, 0.f) & 0xffff); o[6144] = (bf16)(pk2(v.w, 0.f) & 0xffff); } }
    }
};
struct KfP {
    const bf16* A2b; const bf16* F3T; bf16* KF; int rt, ct;
    static constexpr int K = 64;
    __device__ __forceinline__ const bf16* abase() const { return A2b; }
    __device__ __forceinline__ const bf16* bbase() const { return F3T; }
    __device__ __forceinline__ unsigned aoff(int r) const { const int n = rt * 256 + r; const int t = n < SEQ ? n : (n == SEQ ? 0 : 2 * SEQ - n); return (unsigned)(t * 64); }
    __device__ __forceinline__ unsigned boff(int r) const { return (unsigned)(((rt >= 32 ? 1024 : 0) + ct * 256 + r) * 64); }
    __device__ __forceinline__ void epi(f32x4 (&acc)[8][4], int wr, int wc, int fr, int fq) const {
        const float dlo = -3.0701134573253943f, dhi = -15.350567286626972f;
#pragma unroll
        for (int nb = 0; nb < 4; ++nb) {
            const int d = ct * 256 + wc * 64 + nb * 16 + 4 * fq;
            f32x4 dl; dl.x = -(dlo + (dhi - dlo) * (float)(d + 0) * (1.f / 1023.f)); dl.y = -(dlo + (dhi - dlo) * (float)(d + 1) * (1.f / 1023.f));
            dl.z = -(dlo + (dhi - dlo) * (float)(d + 2) * (1.f / 1023.f)); dl.w = -(dlo + (dhi - dlo) * (float)(d + 3) * (1.f / 1023.f));
#pragma unroll
            for (int mb = 0; mb < 8; ++mb) {
                const int n = rt * 256 + wr * 128 + mb * 16 + fr; const int t = n < SEQ ? n : 2 * SEQ - n; const float tt = -(float)t * (1.f / 8192.f);
                f32x4 v = acc[mb][nb]; v.x *= __expf(tt * dl.x); v.y *= __expf(tt * dl.y); v.z *= __expf(tt * dl.z); v.w *= __expf(tt * dl.w);
                if (n == SEQ) v = (f32x4){0.f, 0.f, 0.f, 0.f};
                st4(KF + (size_t)n * 1024 + d, v);
            }
        }
    }
};
#ifndef DFT_WIDE_STORE
#define DFT_WIDE_STORE 1
#endif
enum { E_TW = 0, E_TWC = 1, E_PLANES = 2, E_KHAT = 3, E_MULK = 4, E_HY = 5 };
template <int MT, int EK>
struct DftP {
    const bf16* A; int K; const bf16* bs0; unsigned seg1; int ksplit; unsigned kstride;
    bf16* out0; bf16* out1; size_t rstride;
    const f32x2* tw; int twi; int fbase;
    float* kh;
    const bf16* vp; const bf16* x0; const float* skip;
    __device__ __forceinline__ const bf16* abase() const { return A; }
    __device__ __forceinline__ const bf16* bbase() const { return bs0; }
    __device__ __forceinline__ unsigned aoff(int r) const { return (unsigned)(r * K); }
    __device__ __forceinline__ unsigned boff(int k) const { return k < ksplit ? (unsigned)k * kstride : seg1 + (unsigned)(k - ksplit) * kstride; }
    __device__ __forceinline__ void epi(f32x4 (&acc)[MT / 32][4], int wr, int wc, int fr, int fq) const {
#pragma unroll
        for (int mp = 0; mp < MT / 64; ++mp) {
            const int f = fbase + ((wr * (MT / 2) + mp * 32) >> 5) * 16 + fr;
#pragma unroll
            for (int nb = 0; nb < 4; ++nb) {
                const int col = wc * 64 + nb * 16 + 4 * fq;
                f32x4 re = acc[2 * mp][nb], im = acc[2 * mp + 1][nb];
                if constexpr (EK == E_TW || EK == E_TWC) {
                    const f32x2 t = tw[f * 128 + twi]; const float c = t.x, s = (EK == E_TW) ? t.y : -t.y;
                    const f32x4 r2 = re * c + im * s, i2 = im * c - re * s; re = r2; im = i2;
                }
                if constexpr (EK == E_MULK) {
                    const u32x4 kq = *(const u32x4*)(kh + ((size_t)f * 1024 + col));
                    const f32x4 kr = {bflo(kq.x), bflo(kq.y), bflo(kq.z), bflo(kq.w)}, ki = {bfhi(kq.x), bfhi(kq.y), bfhi(kq.z), bfhi(kq.w)};
                    const f32x4 r2 = re * kr - im * ki, i2 = re * ki + im * kr; re = r2; im = i2;
                }
                if constexpr (EK == E_KHAT) {
                    const float sc = 1.0f / 16384.0f;
                    *(u32x4*)(kh + ((size_t)f * 1024 + col)) = (u32x4){pk2(re.x * sc, im.x * sc), pk2(re.y * sc, im.y * sc), pk2(re.z * sc, im.z * sc), pk2(re.w * sc, im.w * sc)};
                } else if constexpr (EK == E_HY) {
#if DFT_WIDE_STORE
                    {
                        const auto q0 = __builtin_amdgcn_permlane16_swap(__float_as_uint(re.x), __float_as_uint(im.x), false, false), q1 = __builtin_amdgcn_permlane16_swap(__float_as_uint(re.y), __float_as_uint(im.y), false, false);
                        const auto q2 = __builtin_amdgcn_permlane16_swap(__float_as_uint(re.z), __float_as_uint(im.z), false, false), q3 = __builtin_amdgcn_permlane16_swap(__float_as_uint(re.w), __float_as_uint(im.w), false, false);
                        const f32x4 lo = {__uint_as_float(q0[0]), __uint_as_float(q1[0]), __uint_as_float(q2[0]), __uint_as_float(q3[0])}, hi = {__uint_as_float(q0[1]), __uint_as_float(q1[1]), __uint_as_float(q2[1]), __uint_as_float(q3[1])};
                        const int c8 = wc * 64 + nb * 16 + (fq >> 1) * 8;
                        const size_t ro8 = (size_t)(128 * f + twi) * 1024 + c8 + ((fq & 1) ? (size_t)SEQ * 1024 : (size_t)0);
                        const f32x4 sk0 = *(const f32x4*)(skip + c8), sk1 = *(const f32x4*)(skip + c8 + 4);
                        const u32x4 vv = *(const u32x4*)(vp + ro8), xx = *(const u32x4*)(x0 + ro8);
                        const f32x4 v0 = {bflo(vv.x), bfhi(vv.x), bflo(vv.y), bfhi(vv.y)}, v1 = {bflo(vv.z), bfhi(vv.z), bflo(vv.w), bfhi(vv.w)};
                        const f32x4 g0 = {bflo(xx.x), bfhi(xx.x), bflo(xx.y), bfhi(xx.y)}, g1 = {bflo(xx.z), bfhi(xx.z), bflo(xx.w), bfhi(xx.w)};
                        const f32x4 o0 = (lo + v0 * sk0) * g0, o1 = (hi + v1 * sk1) * g1;
                        *(u32x4*)(out0 + ro8) = (u32x4){pk2(o0.x, o0.y), pk2(o0.z, o0.w), pk2(o1.x, o1.y), pk2(o1.z, o1.w)};
                        continue;
                    }
#endif
                    const size_t ro = (size_t)(128 * f + twi) * 1024 + col, ro1 = ro + (size_t)SEQ * 1024;
                    const f32x4 sk = *(const f32x4*)(skip + col);
                    const u32x2 va = *(const u32x2*)(vp + ro), vb = *(const u32x2*)(vp + ro1), xa = *(const u32x2*)(x0 + ro), xb = *(const u32x2*)(x0 + ro1);
                    const f32x4 v0 = {bflo(va.x), bfhi(va.x), bflo(va.y), bfhi(va.y)}, v1 = {bflo(vb.x), bfhi(vb.x), bflo(vb.y), bfhi(vb.y)};
                    const f32x4 g0 = {bflo(xa.x), bfhi(xa.x), bflo(xa.y), bfhi(xa.y)}, g1 = {bflo(xb.x), bfhi(xb.x), bflo(xb.y), bfhi(xb.y)};
                    st4(out0 + ro, (re + v0 * sk) * g0); st4(out0 + ro1, (im + v1 * sk) * g1);
                } else {
#if DFT_WIDE_STORE
                    const auto s0 = __builtin_amdgcn_permlane16_swap(pk2(re.x, re.y), pk2(im.x, im.y), false, false);
                    const auto s1 = __builtin_amdgcn_permlane16_swap(pk2(re.z, re.w), pk2(im.z, im.w), false, false);
                    bf16* pl = (fq & 1) ? out1 : out0;
                    *(u32x4*)(pl + (size_t)f * rstride + wc * 64 + nb * 16 + (fq >> 1) * 8) = (u32x4){s0[0], s1[0], s0[1], s1[1]};
#else
                    st4(out0 + (size_t)f * rstride + col, re); st4(out1 + (size_t)f * rstride + col, im);
#endif
                }
            }
        }
    }
};
namespace tgx {
using tg::TUnit;
#ifndef TG_WIDE_STORE
#define TG_WIDE_STORE 1
#endif
template <int WIDE> __device__ __forceinline__ void st8x2(bf16* p0, const f32x4 v0, const f32x4 v1, int fq) {
    if constexpr (WIDE != 0) {
    const auto s0 = __builtin_amdgcn_permlane16_swap(pk2(v0.x, v0.y), pk2(v1.x, v1.y), false, false);
    const auto s1 = __builtin_amdgcn_permlane16_swap(pk2(v0.z, v0.w), pk2(v1.z, v1.w), false, false);
    *(u32x4*)(p0 - 4 * fq + (fq >> 1) * 8 + (fq & 1) * 16) = (u32x4){s0[0], s1[0], s0[1], s1[1]};
    } else { st4(p0, v0); st4(p0 + 16, v1); }
}
#ifndef TGW_PLAIN
#define TGW_PLAIN 1
#endif
#ifndef TGW_QKV
#define TGW_QKV 1
#endif
#ifndef TGW_GU
#define TGW_GU 1
#endif
#ifndef TGW_DN
#define TGW_DN 1
#endif
struct DenseSched {
    const char* A; const char* B; int nN, nU, G, vcu; size_t astep, bstep;
    __device__ __forceinline__ bool next(int i, TUnit& u) const {
        const int L = i * G + vcu; if (L >= nU) return false;
        const int pm = L / nN, pn = L - pm * nN; u.a = A + (size_t)pm * astep; u.b = B + (size_t)pn * bstep; u.i0 = pm; u.i1 = pn; u.i2 = 0; u.i3 = 0; return true; }
};
struct EpiPlain {
    bf16* out; int ldc; const float* bias;
    __device__ __forceinline__ void operator()(const f32x4 (&acc)[2][2][4][2], const TUnit& u, int wr, int wc, int fr, int fq) const {
        const int col0 = u.i1 * 256 + wc * 32 + 4 * fq;
        bf16* const base = out + (size_t)(u.i0 * 256 + wr * 64 + fr) * ldc + col0;
        if (bias) {
#pragma unroll
            for (int ai = 0; ai < 2; ++ai)
#pragma unroll
                for (int m = 0; m < 4; ++m) { bf16* rowp = base + (size_t)(ai * 128 + m * 16) * ldc;
#pragma unroll
                    for (int bj = 0; bj < 2; ++bj) st8x2<TGW_PLAIN>(rowp + bj * 128, acc[ai][bj][m][0] + *(const f32x4*)(bias + col0 + bj * 128), acc[ai][bj][m][1] + *(const f32x4*)(bias + col0 + bj * 128 + 16), fq); }
        } else {
#pragma unroll
            for (int ai = 0; ai < 2; ++ai)
#pragma unroll
                for (int m = 0; m < 4; ++m) { bf16* rowp = base + (size_t)(ai * 128 + m * 16) * ldc;
#pragma unroll
                    for (int bj = 0; bj < 2; ++bj) st8x2<TGW_PLAIN>(rowp + bj * 128, acc[ai][bj][m][0], acc[ai][bj][m][1], fq); }
        }
    }
};
struct EpiScale {
    bf16* out; int ldc; const float* scale;
    __device__ __forceinline__ void operator()(const f32x4 (&acc)[2][2][4][2], const TUnit& u, int wr, int wc, int fr, int fq) const {
        const int col0 = u.i1 * 256 + wc * 32 + 4 * fq;
#pragma unroll
        for (int ai = 0; ai < 2; ++ai)
#pragma unroll
            for (int m = 0; m < 4; ++m) { bf16* rowp = out + (size_t)(u.i0 * 256 + ai * 128 + wr * 64 + m * 16 + fr) * ldc + col0;
#pragma unroll
                for (int bj = 0; bj < 2; ++bj)
#pragma unroll
                    for (int n = 0; n < 2; ++n) st4(rowp + bj * 128 + n * 16, acc[ai][bj][m][n] * *(const f32x4*)(scale + col0 + bj * 128 + n * 16)); }
    }
};
struct PoolSched {
    const char* A; const char* B; int G, vcu;
    __device__ __forceinline__ bool next(int i, TUnit& u) const {
        const int L = i * G + vcu; if (L >= 512) return false;
        const int pm = L >> 2, g = L & 3; u.a = A + (size_t)pm * (256 * 1024 * 2) + g * 512; u.b = B + (size_t)g * (65536 * 2); u.i0 = pm; u.i1 = g; u.i2 = 0; u.i3 = 0; return true; }
};
struct QkvSched {
    const char* A; const char* B; int G, vcu;
    __device__ __forceinline__ bool next(int i, TUnit& u) const {
        const int L = i * G + vcu; if (L >= 1536 + 32) return false;
        int pm, pn; if (L < 1536) { pm = L / 12; pn = L - pm * 12; } else { const int L2 = L - 1536; pm = 128 + (L2 >> 3); pn = 4 + (L2 & 7); }
        u.a = A + (size_t)pm * (256 * 1024 * 2); u.b = B + (size_t)pn * (256 * 1024 * 2); u.i0 = pm; u.i1 = pn; u.i2 = 0; u.i3 = 0; return true; }
};
struct EpiQkv {
    bf16 *Q, *Kb, *Vb; const float* rope;
    __device__ __forceinline__ void operator()(const f32x4 (&acc)[2][2][4][2], const TUnit& u, int wr, int wc, int fr, int fq) const {
        const int pm = u.i0, pn = u.i1, part = pn >> 2, cb = (pn & 3) * 256 + wc * 32 + 4 * fq;
        const int ang = (wc & 1) ? 4096 : 0;
#pragma unroll
        for (int ai = 0; ai < 2; ++ai)
#pragma unroll
            for (int m = 0; m < 4; ++m) {
                const int mg = pm * 256 + ai * 128 + wr * 64 + m * 16 + fr; const bool latent = mg < T;
                int kvrow, l = 0;
                if (latent) { const int b = mg / SEQ; l = mg % SEQ; kvrow = b * LK + l; } else { const int mm = mg - T; kvrow = (mm / CTXL) * LK + SEQ + (mm % CTXL); }
                f32x4 cs = {1.f, 1.f, 1.f, 1.f}, sn = {0.f, 0.f, 0.f, 0.f};
                if (part < 2 && latent) { const int p = (wc & 1) ? (l & 63) : (l >> 6); cs = *(const f32x4*)(rope + ang + p * 16 + 4 * fq); sn = *(const f32x4*)(rope + ang + ((wc & 1) ? 1024 : 2048) + p * 16 + 4 * fq); }
                bf16* dst = (part == 0 ? Q + (size_t)mg * 1024 : (part == 1 ? Kb : Vb) + (size_t)kvrow * 1024) + cb;
#pragma unroll
                for (int bj = 0; bj < 2; ++bj) { const f32x4 a = acc[ai][bj][m][0], b = acc[ai][bj][m][1];
                    if (part > 0 || latent) st8x2<TGW_QKV>(dst + bj * 128, a * cs - b * sn, b * cs + a * sn, fq); }
            }
    }
};
struct GuSched {
    const char* HA; const char* W; const int* LIST; const LAS int* mt; int G, vcu, ntl;
    __device__ __forceinline__ bool next(int i, TUnit& u) const {
        const int L = i * G + vcu; if (L >= ntl * 8) return false;
        const int ti = L >> 3, pn = L & 7; int e = 0;
        for (int k = 1; k < 16; ++k) if (mt[16 + k] <= ti) e = k;
        u.a = HA; u.b = W + ((size_t)e * 2048 + pn * 256) * 2048; u.i0 = ti; u.i1 = pn; u.i2 = e; u.i3 = ti - mt[16 + e]; return true; }
    __device__ __forceinline__ int arow(const TUnit& u, int r) const { const int idx = u.i3 * 256 + r; return idx < mt[u.i2] ? (LIST[(size_t)u.i2 * T + idx] >> 1) : 0; }
};
struct EpiGu {
    bf16* HS;
    __device__ __forceinline__ void operator()(const f32x4 (&acc)[2][2][4][2], const TUnit& u, int wr, int wc, int fr, int fq) const {
        bf16* base = HS + (size_t)u.i0 * 256 * 1024 + u.i1 * 128 + wc * 32 + 4 * fq;
#pragma unroll
        for (int ai = 0; ai < 2; ++ai)
#pragma unroll
            for (int m = 0; m < 4; ++m) { f32x4 h[2];
#pragma unroll
                for (int n = 0; n < 2; ++n) { const f32x4 g = acc[ai][0][m][n], up = acc[ai][1][m][n];
                    h[n] = (f32x4){fsilu(g.x) * up.x, fsilu(g.y) * up.y, fsilu(g.z) * up.z, fsilu(g.w) * up.w}; }
                st8x2<TGW_GU>(base + (size_t)(ai * 128 + wr * 64 + m * 16 + fr) * 1024, h[0], h[1], fq); }
    }
};
struct DnSched {
    const char* HS; const char* W; const LAS int* mt; int G, vcu, ntl;
    __device__ __forceinline__ bool next(int i, TUnit& u) const {
        const int L = i * G + vcu; if (L >= ntl * 4) return false;
        const int ti = L >> 2, pn = L & 3; int e = 0;
        for (int k = 1; k < 16; ++k) if (mt[16 + k] <= ti) e = k;
        u.a = HS + (size_t)ti * (256 * 1024 * 2); u.b = W + ((size_t)e * 1024 + pn * 256) * 2048; u.i0 = ti; u.i1 = pn; u.i2 = e; u.i3 = ti - mt[16 + e]; return true; }
};
struct EpiDn {
    bf16* Y2; const int* LIST; const float* TOKW; const LAS int* mt;
    __device__ __forceinline__ void operator()(const f32x4 (&acc)[2][2][4][2], const TUnit& u, int wr, int wc, int fr, int fq) const {
        const int cnt = mt[u.i2], col0 = u.i1 * 256 + wc * 32 + 4 * fq;
        int slot[2][4]; float w[2][4];
#pragma unroll
        for (int ai = 0; ai < 2; ++ai)
#pragma unroll
            for (int m = 0; m < 4; ++m) { const int idx = u.i3 * 256 + ai * 128 + wr * 64 + m * 16 + fr; slot[ai][m] = LIST[(size_t)u.i2 * T + (idx < cnt ? idx : 0)]; }
#pragma unroll
        for (int ai = 0; ai < 2; ++ai)
#pragma unroll
            for (int m = 0; m < 4; ++m) w[ai][m] = TOKW[slot[ai][m]];
#pragma unroll
        for (int ai = 0; ai < 2; ++ai)
#pragma unroll
            for (int m = 0; m < 4; ++m) { const int idx = u.i3 * 256 + ai * 128 + wr * 64 + m * 16 + fr;
                if (idx < cnt) { bf16* rowp = Y2 + (size_t)slot[ai][m] * 1024 + col0;
#pragma unroll
                    for (int bj = 0; bj < 2; ++bj) st8x2<TGW_DN>(rowp + bj * 128, acc[ai][bj][m][0] * w[ai][m], acc[ai][bj][m][1] * w[ai][m], fq); } }
    }
};
}
#ifndef MK_ONLY
#define MK_ONLY -1
#endif
#ifndef ATT_PP
#define ATT_PP 0
#endif
#if ATT_PP == 1
#define ATT_FN attn_pass_pp
#elif ATT_PP == 2
#define ATT_FN attn_pass_il
#else
#define ATT_FN attn_pass
#endif
#define EN(k) (MK_ONLY < 0 || MK_ONLY == (k))
#ifndef F1_UNITS
#define F1_UNITS (NB * 128 * 4)
#endif
#ifndef F1_K
#define F1_K 64
#define F1_AMAT DFT_F1
#endif
#ifndef F1_EK
#define F1_EK E_TW
#endif
#ifndef MK_REP
#define MK_REP -1
#endif
#ifndef SETTLE_TICKS
#define SETTLE_TICKS 0
#endif
enum { PH_P0 = 0, PH_MOD, PH_QKV, PH_ATT, PH_AWO, PH_M0, PH_POOLPRE = PH_M0 + 4, PH_POOLG, PH_M1, PH_F1 = PH_M1 + 4, PH_F2, PH_F3, PH_M2,
       PH_H1 = PH_M2 + 4, PH_H2, PH_H3, PH_H4, PH_H5, PH_H6, PH_H7, PH_M3, NPH = PH_M3 + 4 };

__device__ __forceinline__ void dense_gemm(const Frame& F, const bf16* A, int lda, int Mrows, const bf16* Bt, int ldb, int N, int K, bf16* out, int ldc, const float* bias) {
    tgx::DenseSched S{(const char*)A, (const char*)Bt, N / 256, (Mrows / 256) * (N / 256), F.G, F.vcu, (size_t)256 * lda * 2, (size_t)256 * ldb * 2};
    tgx::EpiPlain E{out, ldc, bias};
    tg::tgemm_phase<false>(F.lds, F.tid, lda, ldb, K, S, E);
}
__device__ __forceinline__ Frame make_frame(LAS unsigned char* lds, unsigned char* ws, int wave_s) {
    Frame F; F.lds = lds; F.ws = ws;
    int t = wave_s * 64 + lane_id(); asm volatile("" : "+v"(t));
    int bx = blockIdx.x; asm volatile("" : "+s"(bx));
    F.tid = t; F.lane = t & 63; F.wave = __builtin_amdgcn_readfirstlane(t >> 6);
    F.G = gridDim.x; F.vcu = (F.G % 8 == 0) ? (bx % 8) * (F.G / 8) + bx / 8 : bx;
    F.gw = F.vcu * NWAVES + F.wave; F.NGW = F.G * NWAVES;
    return F;
}
__global__ void __launch_bounds__(NTHR, 2) mk_fwd(Args args) {
    extern __shared__ __attribute__((aligned(16))) unsigned char lds_raw[];
    LAS unsigned char* const lds0 = (LAS unsigned char*)lds_raw;
    volatile LAS unsigned* MISC = (volatile LAS unsigned*)(lds0 + LDS_MISC);
    const int wave_s = __builtin_amdgcn_readfirstlane((int)threadIdx.x >> 6);
    if (wave_s == 0) MISC[lane_id()] = 0u;
    __syncthreads();
    typedef const Args __attribute__((address_space(4))) CArgs;
#define MKF() CArgs* ka = (CArgs*)__builtin_amdgcn_kernarg_segment_ptr(); asm volatile("" : "+s"(ka)); unsigned char* const ws = ka->ws; Frame F_ = make_frame(lds0, ws, wave_s); F_.flip = ka->flip; const Frame F = F_; (void)ws
    const int lo = args.ph_lo, hi = args.ph_hi;
    const bool multi = (hi - lo) > 1;
    unsigned* ctl = (unsigned*)(args.ws + WS_CTL);
    XcdBarrier bar; bar.bar = ctl + CW_BAR; bar.x = 0; bar.st = MISC;
    if (multi) bar = xcd_barrier_post(ctl + CW_BAR, MISC, wave_s);
#define IN(k) (lo <= (k) && (k) < hi)
#define SEAM_FORCE() do { XcdBarrier b_ = bar; unsigned* bp_ = b_.bar; asm volatile("" : "+s"(bp_)); b_.bar = bp_; xcd_barrier(b_, wave_s); } while (0)
#define SEAM(k) do { if (IN(k) && IN((k) + 1)) { XcdBarrier b_ = bar; unsigned* bp_ = b_.bar; asm volatile("" : "+s"(bp_)); b_.bar = bp_; xcd_barrier(b_, wave_s); } } while (0)
#define TAIL_CONVERT(nunits, PART, LAYER) do { const int rem_ = (nunits) % F.G; int pi_ = F.vcu, np_ = F.G; if (rem_ != 0 && F.G - rem_ >= 64) { pi_ = F.vcu - rem_; np_ = F.G - rem_; } \
        if (pi_ >= 0) { __syncthreads(); convert_moe_part(F, ka->in[I_WG], ka->in[I_WU], ka->in[I_WD], (LAYER), (PART), pi_, np_); } } while (0)

    for (int rep_ = 0; rep_ < (MK_REP == (PH_P0) ? 2 : 1); ++rep_) if (EN(PH_P0) && IN(PH_P0)) { if (rep_) { SEAM_FORCE(); } MKF();
        for (int q_ = 0; q_ < (MK_REP == 901 ? 2 : 1); ++q_) { mod_gemv(F, ka->in[I_C], ka->in[I_CCTX], ka->in[I_MODW], ka->in[I_MODB]);
        __syncthreads(); }
        for (int q_ = 0; q_ < (MK_REP == 904 ? 2 : 1); ++q_) {
        {
            LAS float* scr = (LAS float*)(F.lds + F.wave * 16640);
            for (int it = F.gw; it < 2144; it += F.NGW) {
                const float* W; bf16* WT; int K, N, q;
                if (it < 768) { W = ka->in[I_WQKV]; WT = (bf16*)(ws + WS_WQKV); K = 1024; N = 3072; q = it; }
                else if (it < 1024) { W = ka->in[I_WO]; WT = (bf16*)(ws + WS_WO); K = 1024; N = 1024; q = it - 768; }
                else if (it < 1792) { W = ka->in[I_HWIN]; WT = (bf16*)(ws + WS_HWIN); K = 1024; N = 3072; q = it - 1024; }
                else if (it < 2048) { W = ka->in[I_HWO]; WT = (bf16*)(ws + WS_HWO); K = 1024; N = 1024; q = it - 1792; }
                else if (it < 2080) { W = ka->in[I_HF3]; WT = (bf16*)(ws + WS_F3T); K = 64; N = 2048; q = it - 2048; }
                else { const int g = (it - 2080) >> 4; W = ka->in[I_POOLW] + g * 65536; WT = (bf16*)(ws + WS_POOLW) + g * 65536; K = 256; N = 256; q = (it - 2080) & 15; }
                const int nblk = N >> 6, kb = q / nblk, nb = q - kb * nblk;
                transpose_item64(W, N, kb * 64, nb * 64, WT, K, nb * 64, nb * 64 + 32, scr, F.lane);
            }
        }
        __syncthreads(); }
        for (int q_ = 0; q_ < (MK_REP == 902 ? 2 : 1); ++q_) { tables(F); __syncthreads(); }
        for (int q_ = 0; q_ < (MK_REP == 905 ? 2 : 1); ++q_) { fourier_w_copy(F, ka->in[I_FW]);
        router_tables(F, ka->in[I_RW]); __syncthreads(); }
        for (int q_ = 0; q_ < (MK_REP == 903 ? 2 : 1); ++q_) { hyena_a2(F, ka->in[I_HF1], ka->in[I_HFB1], ka->in[I_HF2], ka->in[I_HFB2], ka->in[I_HFREQ]);
        __syncthreads(); }
    }
    SEAM(PH_P0);
#ifdef MK_XBAR
    for (int xb_ = 0; xb_ < MK_XBAR; ++xb_) { SEAM_FORCE(); }
#endif
    for (int rep_ = 0; rep_ < (MK_REP == (PH_MOD) ? 2 : 1); ++rep_) if (EN(PH_MOD) && IN(PH_MOD)) { if (rep_) { SEAM_FORCE(); } MKF(); modulate0(F, ka->in[I_X], ka->in[I_CTX]);
        { auto mk_ = [=](int un) {
            const int ct = un & 3, rh = (un >> 2) & 1, tg_ = (un >> 3) & 1, g = un >> 4;
            FwP p{(const bf16*)(ws + WS_TRIG) + (size_t)(tg_ * 256 + rh * 128) * 256, (const bf16*)(ws + WS_WFB) + (size_t)(g * 256) * 1024 + ct * 256, (bf16*)(ws + WS_FW), rh * 128, tg_ * 1024 + g * 256, ct};
            return p; };
          sgemm_stream<128, 1>(F.lds, F.tid, mk_, F.vcu, 64, F.G); }
    }
    SEAM(PH_MOD);

    for (int rep_ = 0; rep_ < (MK_REP == (PH_QKV) ? 2 : 1); ++rep_) if (EN(PH_QKV) && IN(PH_QKV)) { if (rep_) { SEAM_FORCE(); } MKF();
        tgx::QkvSched S{(const char*)(ws + WS_HA), (const char*)(ws + WS_WQKV), F.G, F.vcu};
        tgx::EpiQkv E{(bf16*)(ws + WS_Q), (bf16*)(ws + WS_K), (bf16*)(ws + WS_V), (const float*)(ws + WS_ROPE)};
        tg::tgemm_phase<false>(F.lds, F.tid, 1024, 1024, 1024, S, E);
        TAIL_CONVERT(1536 + 32, 0, 0);
    }
    SEAM(PH_QKV);
    for (int rep_ = 0; rep_ < (MK_REP == (PH_ATT) ? 2 : 1); ++rep_) if (EN(PH_ATT) && IN(PH_ATT)) { if (rep_) { SEAM_FORCE(); } MKF();
        const float* lamp = ka->in[I_LAM]; float d01 = 0.f, d23 = 0.f;
        for (int i = 0; i < 64; ++i) { d01 += lamp[i] * lamp[64 + i]; d23 += lamp[128 + i] * lamp[192 + i]; }
        const float lam_init = 0.2f, lam = __expf(d01) - __expf(d23) + lam_init;
        const bf16* Q = (const bf16*)(ws + WS_Q); const bf16* Kb = (const bf16*)(ws + WS_K); const bf16* Vb = (const bf16*)(ws + WS_V); bf16* AO = (bf16*)(ws + WS_AO);
        for (int u = F.vcu; u < NB * 8 * 32; u += F.G) {
            const int qb = u & 31, h = (u >> 5) & 7, b = u >> 8;
            const bf16* q0 = Q + (size_t)(b * SEQ + qb * 256) * 1024 + h * 128; const bf16* k0 = Kb + (size_t)b * LK * 1024 + h * 128; const bf16* v0 = Vb + (size_t)b * LK * 1024 + h * 128;
            bf16* o0 = AO + (size_t)(b * SEQ + qb * 256) * 1024 + h * 128;
            att::ATT_FN<0>(q0, k0, v0, o0, lam, ka->in[I_SUBLN], 1.f - lam_init, F.lds, F.tid);
            att::ATT_FN<1>(q0 + 64, k0 + 64, v0, o0, lam, ka->in[I_SUBLN], 1.f - lam_init, F.lds, F.tid);
        }
    }
    SEAM(PH_ATT);
    for (int rep_ = 0; rep_ < (MK_REP == (PH_AWO) ? 2 : 1); ++rep_) if (EN(PH_AWO) && IN(PH_AWO)) { if (rep_) { SEAM_FORCE(); } MKF(); dense_gemm(F, (const bf16*)(ws + WS_AO), 1024, T, (const bf16*)(ws + WS_WO), 1024, 1024, 1024, (bf16*)(ws + WS_Y), 1024, nullptr); }
    SEAM(PH_AWO);

    { constexpr int layer = 0;
        constexpr int pb = layer == 0 ? PH_M0 : layer == 1 ? PH_M1 : layer == 2 ? PH_M2 : PH_M3;
        for (int rep_ = 0; rep_ < (MK_REP == (100) ? 2 : 1); ++rep_) if (EN(100) && IN(pb)) { if (rep_) { SEAM_FORCE(); } MKF(); ln1_route(F, layer, ka->in[I_LNG], ka->in[I_LNB], ka->in[I_RB]); }
        SEAM(pb);
        LAS int* mt = (LAS int*)(lds0 + LDS_MISC + 256);
        if (IN(pb + 1) || IN(pb + 2)) { MKF();
            if (F.tid < 16) mt[F.tid] = (int)__hip_atomic_load(ctl + CW_CNT + (layer * 16 + F.tid) * 64, __ATOMIC_RELAXED, __HIP_MEMORY_SCOPE_AGENT);
            __syncthreads();
            if (F.tid == 0) { int s = 0; for (int e = 0; e < 16; ++e) { mt[16 + e] = s; s += (mt[e] + 255) >> 8; } mt[32] = s; }
            __syncthreads();
        }
        for (int rep_ = 0; rep_ < (MK_REP == (101) ? 2 : 1); ++rep_) if (EN(101) && IN(pb + 1)) { if (rep_) { SEAM_FORCE(); } MKF();
            tgx::GuSched S{(const char*)(ws + WS_HA), (const char*)(ws + WS_WGU), (const int*)(ws + WS_LIST), mt, F.G, F.vcu, mt[32]};
            tgx::EpiGu E{(bf16*)(ws + WS_HS)};
            tg::tgemm_phase<true>(F.lds, F.tid, 1024, 1024, 1024, S, E);
            TAIL_CONVERT(mt[32] * 8, 1, layer);
        }
        SEAM(pb + 1);
        for (int rep_ = 0; rep_ < (MK_REP == (102) ? 2 : 1); ++rep_) if (EN(102) && IN(pb + 2)) { if (rep_) { SEAM_FORCE(); } MKF();
            tgx::DnSched S{(const char*)(ws + WS_HS), (const char*)(ws + WS_WD), mt, F.G, F.vcu, mt[32]};
            tgx::EpiDn E{(bf16*)(ws + WS_Y2), (const int*)(ws + WS_LIST), (const float*)(ws + WS_TOKW), mt};
            tg::tgemm_phase<false>(F.lds, F.tid, 1024, 1024, 1024, S, E);
            if (layer + 1 < NLAYER) TAIL_CONVERT(mt[32] * 4, 0, layer + 1);
        }
        SEAM(pb + 2);
#ifdef MK_PRE_DELAY
        if (layer == NLAYER - 1 && IN(pb + 3)) { const unsigned long long t0_ = __builtin_amdgcn_s_memrealtime(); while (__builtin_amdgcn_s_memrealtime() - t0_ < (unsigned long long)MK_PRE_DELAY) __builtin_amdgcn_s_sleep(16); }
#endif
        for (int rep_ = 0; rep_ < ((MK_REP == 203 && layer == 3) ? 2 : 1); ++rep_) if (EN(103) && IN(pb + 3)) { if (rep_) { SEAM_FORCE(); } MKF();
            ln2_phase(F, layer, ka->in[I_LNG], ka->in[I_LNB], ka->out);
        }
        if (layer + 1 < NLAYER) SEAM(pb + 3);
    }
    { constexpr int layer = 1;
        if (layer == 1) {
            for (int rep_ = 0; rep_ < (MK_REP == (PH_POOLPRE) ? 2 : 1); ++rep_) if (EN(PH_POOLPRE) && IN(PH_POOLPRE)) { if (rep_) { SEAM_FORCE(); } MKF(); pool_pre(F); }
            SEAM(PH_POOLPRE);
            for (int rep_ = 0; rep_ < (MK_REP == (PH_POOLG) ? 2 : 1); ++rep_) if (EN(PH_POOLG) && IN(PH_POOLG)) { if (rep_) { SEAM_FORCE(); } MKF();
                tgx::PoolSched S{(const char*)(ws + WS_POOLED), (const char*)(ws + WS_POOLW), F.G, F.vcu};
                tgx::EpiScale E{(bf16*)(ws + WS_Y), 1024, ka->in[I_POOLS]};
                tg::tgemm_phase<false>(F.lds, F.tid, 1024, 256, 256, S, E);
            }
            SEAM(PH_POOLG);
        }
    }
    { constexpr int layer = 1;
        constexpr int pb = layer == 0 ? PH_M0 : layer == 1 ? PH_M1 : layer == 2 ? PH_M2 : PH_M3;
        for (int rep_ = 0; rep_ < (MK_REP == (100) ? 2 : 1); ++rep_) if (EN(100) && IN(pb)) { if (rep_) { SEAM_FORCE(); } MKF(); ln1_route(F, layer, ka->in[I_LNG], ka->in[I_LNB], ka->in[I_RB]); }
        SEAM(pb);
        LAS int* mt = (LAS int*)(lds0 + LDS_MISC + 256);
        if (IN(pb + 1) || IN(pb + 2)) { MKF();
            if (F.tid < 16) mt[F.tid] = (int)__hip_atomic_load(ctl + CW_CNT + (layer * 16 + F.tid) * 64, __ATOMIC_RELAXED, __HIP_MEMORY_SCOPE_AGENT);
            __syncthreads();
            if (F.tid == 0) { int s = 0; for (int e = 0; e < 16; ++e) { mt[16 + e] = s; s += (mt[e] + 255) >> 8; } mt[32] = s; }
            __syncthreads();
        }
        for (int rep_ = 0; rep_ < (MK_REP == (101) ? 2 : 1); ++rep_) if (EN(101) && IN(pb + 1)) { if (rep_) { SEAM_FORCE(); } MKF();
            tgx::GuSched S{(const char*)(ws + WS_HA), (const char*)(ws + WS_WGU), (const int*)(ws + WS_LIST), mt, F.G, F.vcu, mt[32]};
            tgx::EpiGu E{(bf16*)(ws + WS_HS)};
            tg::tgemm_phase<true>(F.lds, F.tid, 1024, 1024, 1024, S, E);
            TAIL_CONVERT(mt[32] * 8, 1, layer);
        }
        SEAM(pb + 1);
        for (int rep_ = 0; rep_ < (MK_REP == (102) ? 2 : 1); ++rep_) if (EN(102) && IN(pb + 2)) { if (rep_) { SEAM_FORCE(); } MKF();
            tgx::DnSched S{(const char*)(ws + WS_HS), (const char*)(ws + WS_WD), mt, F.G, F.vcu, mt[32]};
            tgx::EpiDn E{(bf16*)(ws + WS_Y2), (const int*)(ws + WS_LIST), (const float*)(ws + WS_TOKW), mt};
            tg::tgemm_phase<false>(F.lds, F.tid, 1024, 1024, 1024, S, E);
            if (layer + 1 < NLAYER) TAIL_CONVERT(mt[32] * 4, 0, layer + 1);
        }
        SEAM(pb + 2);
#ifdef MK_PRE_DELAY
        if (layer == NLAYER - 1 && IN(pb + 3)) { const unsigned long long t0_ = __builtin_amdgcn_s_memrealtime(); while (__builtin_amdgcn_s_memrealtime() - t0_ < (unsigned long long)MK_PRE_DELAY) __builtin_amdgcn_s_sleep(16); }
#endif
        for (int rep_ = 0; rep_ < ((MK_REP == 203 && layer == 3) ? 2 : 1); ++rep_) if (EN(103) && IN(pb + 3)) { if (rep_) { SEAM_FORCE(); } MKF();
            ln2_phase(F, layer, ka->in[I_LNG], ka->in[I_LNB], ka->out);
        }
        if (layer + 1 < NLAYER) SEAM(pb + 3);
    }
    { constexpr int layer = 2;
        if (layer == 2) {
            for (int rep_ = 0; rep_ < (MK_REP == (PH_F1) ? 2 : 1); ++rep_) if (EN(PH_F1) && IN(PH_F1)) { if (rep_) { SEAM_FORCE(); } MKF();
                { auto mk_ = [=](int u) {
                    const int nt = u & 3, l2 = (u >> 2) & 127, b = u >> 9, col0 = nt * 256;
                    DftP<128, F1_EK> p{};
                    p.A = (const bf16*)(ws + F1_AMAT); p.K = F1_K; p.bs0 = (const bf16*)(ws + WS_HA) + ((size_t)b * SEQ + l2) * 1024 + col0; p.seg1 = 0; p.ksplit = F1_K; p.kstride = 128 * 1024;
                    p.out0 = (bf16*)(ws + WS_FT) + ((size_t)(b * 64) * 128 + l2) * 1024 + col0; p.out1 = p.out0 + PLANE64 / 2; p.rstride = 128 * 1024;
                    p.tw = (const f32x2*)(ws + WS_TWF); p.twi = l2;
                    return p; };
                  sgemm_stream<128, 1>(F.lds, F.tid, mk_, F.vcu, F1_UNITS, F.G); }
            }
            SEAM(PH_F1);
            for (int rep_ = 0; rep_ < (MK_REP == (PH_F2) ? 2 : 1); ++rep_) if (EN(PH_F2) && IN(PH_F2)) { if (rep_) { SEAM_FORCE(); } MKF();
                { auto mk_ = [=](int u) {
                    const int nt = u & 3, k1 = (u >> 2) & 63, b = u >> 8, col0 = nt * 256;
                    DftP<256, E_PLANES> p{};
                    p.A = (const bf16*)(ws + DFT_C256); p.K = 256; p.fbase = 0; p.bs0 = (const bf16*)(ws + WS_FT) + ((size_t)(b * 64 + k1) * 128) * 1024 + col0; p.seg1 = (unsigned)(PLANE64 / 2); p.ksplit = 128; p.kstride = 1024;
                    p.out0 = (bf16*)(ws + WS_PQ) + ((size_t)b * SEQ + k1) * 2048 + col0; p.out1 = p.out0 + 1024; p.rstride = 64 * 2048;
                    return p; };
                  sgemm_stream<256, 1>(F.lds, F.tid, mk_, F.vcu, (NB * 64 * 4), F.G); }
            }
            SEAM(PH_F2);
            for (int rep_ = 0; rep_ < (MK_REP == (PH_F3) ? 2 : 1); ++rep_) if (EN(PH_F3) && IN(PH_F3)) { if (rep_) { SEAM_FORCE(); } MKF(); dense_gemm(F, (const bf16*)(ws + WS_PQ), 2048, T, (const bf16*)(ws + WS_FW), 2048, 1024, 2048, (bf16*)(ws + WS_Y), 1024, ka->in[I_FB]); }
            SEAM(PH_F3);
        }
    }
    { constexpr int layer = 2;
        constexpr int pb = layer == 0 ? PH_M0 : layer == 1 ? PH_M1 : layer == 2 ? PH_M2 : PH_M3;
        for (int rep_ = 0; rep_ < (MK_REP == (100) ? 2 : 1); ++rep_) if (EN(100) && IN(pb)) { if (rep_) { SEAM_FORCE(); } MKF(); ln1_route(F, layer, ka->in[I_LNG], ka->in[I_LNB], ka->in[I_RB]); }
        SEAM(pb);
        LAS int* mt = (LAS int*)(lds0 + LDS_MISC + 256);
        if (IN(pb + 1) || IN(pb + 2)) { MKF();
            if (F.tid < 16) mt[F.tid] = (int)__hip_atomic_load(ctl + CW_CNT + (layer * 16 + F.tid) * 64, __ATOMIC_RELAXED, __HIP_MEMORY_SCOPE_AGENT);
            __syncthreads();
            if (F.tid == 0) { int s = 0; for (int e = 0; e < 16; ++e) { mt[16 + e] = s; s += (mt[e] + 255) >> 8; } mt[32] = s; }
            __syncthreads();
        }
        for (int rep_ = 0; rep_ < (MK_REP == (101) ? 2 : 1); ++rep_) if (EN(101) && IN(pb + 1)) { if (rep_) { SEAM_FORCE(); } MKF();
            tgx::GuSched S{(const char*)(ws + WS_HA), (const char*)(ws + WS_WGU), (const int*)(ws + WS_LIST), mt, F.G, F.vcu, mt[32]};
            tgx::EpiGu E{(bf16*)(ws + WS_HS)};
            tg::tgemm_phase<true>(F.lds, F.tid, 1024, 1024, 1024, S, E);
            TAIL_CONVERT(mt[32] * 8, 1, layer);
        }
        SEAM(pb + 1);
        for (int rep_ = 0; rep_ < (MK_REP == (102) ? 2 : 1); ++rep_) if (EN(102) && IN(pb + 2)) { if (rep_) { SEAM_FORCE(); } MKF();
            tgx::DnSched S{(const char*)(ws + WS_HS), (const char*)(ws + WS_WD), mt, F.G, F.vcu, mt[32]};
            tgx::EpiDn E{(bf16*)(ws + WS_Y2), (const int*)(ws + WS_LIST), (const float*)(ws + WS_TOKW), mt};
            tg::tgemm_phase<false>(F.lds, F.tid, 1024, 1024, 1024, S, E);
            if (layer + 1 < NLAYER) TAIL_CONVERT(mt[32] * 4, 0, layer + 1);
        }
        SEAM(pb + 2);
#ifdef MK_PRE_DELAY
        if (layer == NLAYER - 1 && IN(pb + 3)) { const unsigned long long t0_ = __builtin_amdgcn_s_memrealtime(); while (__builtin_amdgcn_s_memrealtime() - t0_ < (unsigned long long)MK_PRE_DELAY) __builtin_amdgcn_s_sleep(16); }
#endif
        for (int rep_ = 0; rep_ < ((MK_REP == 203 && layer == 3) ? 2 : 1); ++rep_) if (EN(103) && IN(pb + 3)) { if (rep_) { SEAM_FORCE(); } MKF();
            ln2_phase(F, layer, ka->in[I_LNG], ka->in[I_LNB], ka->out);
        }
        if (layer + 1 < NLAYER) SEAM(pb + 3);
    }
    { constexpr int layer = 3;
        if (layer == 3) {
            for (int rep_ = 0; rep_ < (MK_REP == (PH_H1) ? 2 : 1); ++rep_) if (EN(PH_H1) && IN(PH_H1)) { if (rep_) { SEAM_FORCE(); } MKF();
                dense_gemm(F, (const bf16*)(ws + WS_HA), 1024, T, (const bf16*)(ws + WS_HWIN), 1024, 3072, 1024, (bf16*)(ws + WS_Z), 3072, ka->in[I_HBIN]);
                { auto mk_ = [=](int un) {
                    KfP p{(const bf16*)(ws + WS_A2B), (const bf16*)(ws + WS_F3T), (bf16*)(ws + WS_KFULL), un >> 2, un & 3};
                    return p; };
                  sgemm_stream<256, 0>(F.lds, F.tid, mk_, F.vcu, 64 * 4, F.G); }
            }
            SEAM(PH_H1);
            for (int rep_ = 0; rep_ < (MK_REP == (PH_H2) ? 2 : 1); ++rep_) if (EN(PH_H2) && IN(PH_H2)) { if (rep_) { SEAM_FORCE(); } MKF();
                hyena_conv(F, ka->in[I_HCW], ka->in[I_HCB]);
                { auto mk_ = [=](int u) {
                    const int nt = u & 3, n2 = u >> 2, col0 = nt * 256;
                    DftP<256, E_TW> p{};
                    p.A = (const bf16*)(ws + DFT_K1); p.K = 128; p.fbase = 0; p.bs0 = (const bf16*)(ws + WS_KFULL) + (size_t)n2 * 1024 + col0; p.seg1 = 0; p.ksplit = 128; p.kstride = 128 * 1024;
                    p.out0 = (bf16*)(ws + WS_KT) + (size_t)n2 * 1024 + col0; p.out1 = p.out0 + PLANE32 / 2; p.rstride = 128 * 1024;
                    p.tw = (const f32x2*)(ws + WS_TWH); p.twi = n2;
                    return p; };
                  sgemm_stream<256, 1>(F.lds, F.tid, mk_, F.vcu, (128 * 4), F.G); }
            }
            SEAM(PH_H2);
            for (int rep_ = 0; rep_ < (MK_REP == (PH_H3) ? 2 : 1); ++rep_) if (EN(PH_H3) && IN(PH_H3)) { if (rep_) { SEAM_FORCE(); } MKF();
                { auto mk_ = [=](int u) {
                    const int nt = u & 3, s2 = (u >> 2) & 127, pp = u >> 9, col0 = nt * 256;
                    DftP<256, E_TW> p{};
                    p.A = (const bf16*)(ws + DFT_H1); p.K = 128; p.fbase = 0; p.bs0 = (const bf16*)(ws + WS_VP) + ((size_t)(2 * pp) * SEQ + s2) * 1024 + col0; p.seg1 = (unsigned)(SEQ * 1024); p.ksplit = 64; p.kstride = 128 * 1024;
                    p.out0 = (bf16*)(ws + WS_HT) + ((size_t)(pp * 128) * 128 + s2) * 1024 + col0; p.out1 = p.out0 + PLANE64 / 2; p.rstride = 128 * 1024;
                    p.tw = (const f32x2*)(ws + WS_TWH); p.twi = s2;
                    return p; };
                  sgemm_stream<256, 1>(F.lds, F.tid, mk_, F.vcu, (2 * 128 * 4), F.G); }
                { auto mk_ = [=](int u) {
                    const int nt = u & 3, f1 = u >> 2, col0 = nt * 256;
                    DftP<256, E_KHAT> p{};
                    p.A = (const bf16*)(ws + DFT_C256); p.K = 256; p.fbase = 0; p.bs0 = (const bf16*)(ws + WS_KT) + (size_t)(f1 * 128) * 1024 + col0; p.seg1 = (unsigned)(PLANE32 / 2); p.ksplit = 128; p.kstride = 1024;
                    p.kh = (float*)(ws + WS_KH) + ((size_t)(f1 * 128) * 1024 + col0);
                    return p; };
                  sgemm_stream<256, 1>(F.lds, F.tid, mk_, F.vcu, (128 * 4), F.G); }
            }
            SEAM(PH_H3);
            for (int rep_ = 0; rep_ < (MK_REP == (PH_H4) ? 2 : 1); ++rep_) if (EN(PH_H4) && IN(PH_H4)) { if (rep_) { SEAM_FORCE(); } MKF();
                { auto mk_ = [=](int u) {
                    const int nt = u & 3, f1 = (u >> 2) & 127, pp = u >> 9, col0 = nt * 256;
                    DftP<256, E_MULK> p{};
                    p.A = (const bf16*)(ws + DFT_C256); p.K = 256; p.fbase = 0; p.bs0 = (const bf16*)(ws + WS_HT) + ((size_t)(pp * 128 + f1) * 128) * 1024 + col0; p.seg1 = (unsigned)(PLANE64 / 2); p.ksplit = 128; p.kstride = 1024;
                    p.out0 = (bf16*)(ws + WS_YH) + ((size_t)(pp * 128 + f1) * 128) * 1024 + col0; p.out1 = p.out0 + PLANE64 / 2; p.rstride = 1024;
                    p.kh = (float*)(ws + WS_KH) + ((size_t)(f1 * 128) * 1024 + col0);
                    return p; };
                  sgemm_stream<256, 1>(F.lds, F.tid, mk_, F.vcu, (2 * 128 * 4), F.G); }
            }
            SEAM(PH_H4);
            for (int rep_ = 0; rep_ < (MK_REP == (PH_H5) ? 2 : 1); ++rep_) if (EN(PH_H5) && IN(PH_H5)) { if (rep_) { SEAM_FORCE(); } MKF();
                { auto mk_ = [=](int u) {
                    const int nt = u & 3, f1 = (u >> 2) & 127, pp = u >> 9, col0 = nt * 256;
                    DftP<256, E_TWC> p{};
                    p.A = (const bf16*)(ws + DFT_H2B); p.K = 256; p.fbase = 0; p.bs0 = (const bf16*)(ws + WS_YH) + ((size_t)(pp * 128 + f1) * 128) * 1024 + col0; p.seg1 = (unsigned)(PLANE64 / 2); p.ksplit = 128; p.kstride = 1024;
                    p.out0 = (bf16*)(ws + WS_HG) + ((size_t)(pp * 128 + f1) * 128) * 1024 + col0; p.out1 = p.out0 + PLANE64 / 2; p.rstride = 1024;
                    p.tw = (const f32x2*)(ws + WS_TWH); p.twi = f1;
                    return p; };
                  sgemm_stream<256, 1>(F.lds, F.tid, mk_, F.vcu, (2 * 128 * 4), F.G); }
            }
            SEAM(PH_H5);
            for (int rep_ = 0; rep_ < (MK_REP == (PH_H6) ? 2 : 1); ++rep_) if (EN(PH_H6) && IN(PH_H6)) { if (rep_) { SEAM_FORCE(); } MKF();
                { auto mk_ = [=](int u) {
                    const int nt = u & 3, t2 = (u >> 2) & 127, pp = u >> 9, col0 = nt * 256;
                    DftP<128, E_HY> p{};
                    p.A = (const bf16*)(ws + DFT_H3); p.K = 256; p.bs0 = (const bf16*)(ws + WS_HG) + ((size_t)(pp * 128) * 128 + t2) * 1024 + col0; p.seg1 = (unsigned)(PLANE64 / 2); p.ksplit = 128; p.kstride = 128 * 1024;
                    p.out0 = (bf16*)(ws + WS_YX) + (size_t)(2 * pp) * SEQ * 1024 + col0; p.twi = t2;
                    p.vp = (const bf16*)(ws + WS_VP) + (size_t)(2 * pp) * SEQ * 1024 + col0; p.x0 = (const bf16*)(ws + WS_X0) + (size_t)(2 * pp) * SEQ * 1024 + col0; p.skip = ka->in[I_HSKIP] + col0;
                    return p; };
                  sgemm_stream<128, 1>(F.lds, F.tid, mk_, F.vcu, 2 * 128 * 4, F.G); }
            }
            SEAM(PH_H6);
            for (int rep_ = 0; rep_ < (MK_REP == (PH_H7) ? 2 : 1); ++rep_) if (EN(PH_H7) && IN(PH_H7)) { if (rep_) { SEAM_FORCE(); } MKF(); dense_gemm(F, (const bf16*)(ws + WS_YX), 1024, T, (const bf16*)(ws + WS_HWO), 1024, 1024, 1024, (bf16*)(ws + WS_Y), 1024, ka->in[I_HBO]); }
            SEAM(PH_H7);
        }
    }
    { constexpr int layer = 3;
        constexpr int pb = layer == 0 ? PH_M0 : layer == 1 ? PH_M1 : layer == 2 ? PH_M2 : PH_M3;
        for (int rep_ = 0; rep_ < (MK_REP == (100) ? 2 : 1); ++rep_) if (EN(100) && IN(pb)) { if (rep_) { SEAM_FORCE(); } MKF(); ln1_route(F, layer, ka->in[I_LNG], ka->in[I_LNB], ka->in[I_RB]); }
        SEAM(pb);
        LAS int* mt = (LAS int*)(lds0 + LDS_MISC + 256);
        if (IN(pb + 1) || IN(pb + 2)) { MKF();
            if (F.tid < 16) mt[F.tid] = (int)__hip_atomic_load(ctl + CW_CNT + (layer * 16 + F.tid) * 64, __ATOMIC_RELAXED, __HIP_MEMORY_SCOPE_AGENT);
            __syncthreads();
            if (F.tid == 0) { int s = 0; for (int e = 0; e < 16; ++e) { mt[16 + e] = s; s += (mt[e] + 255) >> 8; } mt[32] = s; }
            __syncthreads();
        }
        for (int rep_ = 0; rep_ < (MK_REP == (101) ? 2 : 1); ++rep_) if (EN(101) && IN(pb + 1)) { if (rep_) { SEAM_FORCE(); } MKF();
            tgx::GuSched S{(const char*)(ws + WS_HA), (const char*)(ws + WS_WGU), (const int*)(ws + WS_LIST), mt, F.G, F.vcu, mt[32]};
            tgx::EpiGu E{(bf16*)(ws + WS_HS)};
            tg::tgemm_phase<true>(F.lds, F.tid, 1024, 1024, 1024, S, E);
            TAIL_CONVERT(mt[32] * 8, 1, layer);
        }
        SEAM(pb + 1);
        for (int rep_ = 0; rep_ < (MK_REP == (102) ? 2 : 1); ++rep_) if (EN(102) && IN(pb + 2)) { if (rep_) { SEAM_FORCE(); } MKF();
            tgx::DnSched S{(const char*)(ws + WS_HS), (const char*)(ws + WS_WD), mt, F.G, F.vcu, mt[32]};
            tgx::EpiDn E{(bf16*)(ws + WS_Y2), (const int*)(ws + WS_LIST), (const float*)(ws + WS_TOKW), mt};
            tg::tgemm_phase<false>(F.lds, F.tid, 1024, 1024, 1024, S, E);
            if (layer + 1 < NLAYER) TAIL_CONVERT(mt[32] * 4, 0, layer + 1);
        }
        SEAM(pb + 2);
#ifdef MK_PRE_DELAY
        if (layer == NLAYER - 1 && IN(pb + 3)) { const unsigned long long t0_ = __builtin_amdgcn_s_memrealtime(); while (__builtin_amdgcn_s_memrealtime() - t0_ < (unsigned long long)MK_PRE_DELAY) __builtin_amdgcn_s_sleep(16); }
#endif
        for (int rep_ = 0; rep_ < ((MK_REP == 203 && layer == 3) ? 2 : 1); ++rep_) if (EN(103) && IN(pb + 3)) { if (rep_) { SEAM_FORCE(); } MKF();
            ln2_phase(F, layer, ka->in[I_LNG], ka->in[I_LNB], ka->out);
        }
        if (layer + 1 < NLAYER) SEAM(pb + 3);
    }
#ifdef MK_FINAL_BARRIER
    if (multi) { XcdBarrier b_ = bar; unsigned* bp_ = b_.bar; asm volatile("" : "+s"(bp_)); b_.bar = bp_; xcd_barrier(b_, wave_s); }
#endif
    asm volatile("s_waitcnt vmcnt(0)" ::: "memory");
    __builtin_amdgcn_fence(__ATOMIC_RELEASE, "");
    asm volatile("s_waitcnt vmcnt(0)" ::: "memory");
    if (SETTLE_TICKS > 0 && lo <= NPH - 1 && NPH - 1 < hi) {
        const unsigned long long t0_ = __builtin_amdgcn_s_memrealtime(); while (__builtin_amdgcn_s_memrealtime() - t0_ < (unsigned long long)SETTLE_TICKS) __builtin_amdgcn_s_sleep(16); }
#undef IN
#undef SEAM
}

#ifdef MK_DBG4
__global__ void __launch_bounds__(256) dbg_sweep(const unsigned* p, size_t n, unsigned* sink) {
    unsigned x = 0; for (size_t i = (size_t)blockIdx.x * 256 + threadIdx.x; i < n; i += (size_t)gridDim.x * 256) x ^= p[i];
    if (x == 0x12345678u) sink[0] = x;
}
__global__ void __launch_bounds__(256) dbg_cmp4(const unsigned* h0, const unsigned* h1, float* out) {
    const int row = blockIdx.x * 4 + (threadIdx.x >> 6), lane = threadIdx.x & 63;
    const float vi = h0[2 * row] != h1[2 * row] ? 100.f : 0.f, vo = h0[2 * row + 1] != h1[2 * row + 1] ? 100.f : 0.f;
    for (int i = lane; i < D; i += 64) out[(size_t)row * D + i] = i < 512 ? vi : vo;
}
#endif
#ifdef MK_DBG9
__global__ void __launch_bounds__(256) dbg_copy(const u32x4* src, u32x4* dst, size_t n16) {
    for (size_t i = (size_t)blockIdx.x * 256 + threadIdx.x; i < n16; i += (size_t)gridDim.x * 256) dst[i] = src[i];
}
__global__ void __launch_bounds__(256) dbg_cmp9(const unsigned* a, const unsigned* b, float* out, size_t npairs) {
    for (size_t i = (size_t)blockIdx.x * 256 + threadIdx.x; i < npairs; i += (size_t)gridDim.x * 256) { const float v = (a[i] != b[i]) ? 1.0e4f : 0.f; out[2 * i] = v; out[2 * i + 1] = v; }
}
#endif
#ifdef MK_DBG7
__global__ void __launch_bounds__(256) dbg_y2_hash(const unsigned* Y2, unsigned* h) {
    const int row = blockIdx.x * 4 + (threadIdx.x >> 6), lane = threadIdx.x & 63; unsigned x = 0;
    for (int i = lane; i < 512; i += 64) x = x * 0x9E3779B1u + Y2[(size_t)row * 512 + i] * (2u * i + 1u);
    for (int o = 1; o < 64; o <<= 1) x += __shfl_xor(x, o) * 31u;
    if (lane == 0) h[row] = x;
}
__global__ void __launch_bounds__(256) dbg_cmp7(const unsigned* h0, const unsigned* h1, float* out) {
    const int row = blockIdx.x * 4 + (threadIdx.x >> 6), lane = threadIdx.x & 63; const float v = (h0[2 * row] != h1[2 * row] || h0[2 * row + 1] != h1[2 * row + 1]) ? 100.f : 0.f;
    for (int i = lane; i < D; i += 64) out[(size_t)row * D + i] = v;
}
#endif
#ifdef MK_DBG6
__global__ void __launch_bounds__(256) dbg_hs_hash(const int* LIST, const unsigned* CNT, const unsigned* HS, unsigned* h) {
    const int e = blockIdx.y; int tstart = 0; for (int k = 0; k < e; ++k) tstart += ((int)CNT[k * 64] + 255) >> 8;
    const int cnt = (int)CNT[e * 64], lane = threadIdx.x & 63;
    for (int idx = blockIdx.x * 4 + (threadIdx.x >> 6); idx < cnt; idx += gridDim.x * 4) {
        const unsigned* row = HS + ((size_t)tstart * 256 + idx) * 512; unsigned x = 0;
        for (int i = lane; i < 512; i += 64) x = x * 0x9E3779B1u + row[i] * (2u * i + 1u);
        for (int o = 1; o < 64; o <<= 1) x += __shfl_xor(x, o) * 31u;
        if (lane == 0) h[LIST[(size_t)e * T + idx]] = x;
    }
}
__global__ void __launch_bounds__(256) dbg_cmp6(const unsigned* h0, const unsigned* h1, float* out) {
    const int row = blockIdx.x * 4 + (threadIdx.x >> 6), lane = threadIdx.x & 63; const float v = (h0[row] != h1[row] || h0[row + T] != h1[row + T]) ? 100.f : 0.f;
    for (int i = lane; i < D; i += 64) out[(size_t)row * D + i] = v;
}
#endif
#ifdef MK_DBG5
__global__ void __launch_bounds__(256) dbg_list_mark(const int* LIST, const unsigned* CNT, int* seen) {
    const int e = blockIdx.y; const int cnt = (int)CNT[e * 64];
    for (int i = blockIdx.x * 256 + threadIdx.x; i < cnt; i += gridDim.x * 256) { const int s = LIST[(size_t)e * T + i]; if (s >= 0 && s < 2 * T) atomicAdd(seen + s, 1); else atomicAdd(seen + 2 * T, 1); }
}
__global__ void __launch_bounds__(256) dbg_list_out(const int* seen, float* out) {
    const int row = blockIdx.x * 4 + (threadIdx.x >> 6), lane = threadIdx.x & 63;
    const float v = (seen[row] != 1 || seen[row + T] != 1 || (row == 0 && seen[2 * T] != 0)) ? 100.f : 0.f;
    for (int i = lane; i < D; i += 64) out[(size_t)row * D + i] = v;
}
#endif
#ifdef MK_DBG3
__global__ void __launch_bounds__(256) dbg_hash(const unsigned* out, unsigned* h) {
    const int row = blockIdx.x * 4 + (threadIdx.x >> 6), lane = threadIdx.x & 63; unsigned x = 0;
    for (int i = lane; i < D; i += 64) x = x * 0x9E3779B1u + out[(size_t)row * D + i] * (2u * i + 1u);
    for (int o = 1; o < 64; o <<= 1) x += __shfl_xor(x, o) * 31u;
    if (lane == 0) h[row] = x;
}
__global__ void __launch_bounds__(256) dbg_cmp3(const unsigned* h0, const unsigned* h1, float* out) {
    const int row = blockIdx.x * 4 + (threadIdx.x >> 6), lane = threadIdx.x & 63; const float v = h0[row] != h1[row] ? 100.f : 0.f;
    for (int i = lane; i < D; i += 64) out[(size_t)row * D + i] = v;
}
#endif
#if defined(MK_DBG2) || defined(MK_DBG8)
__global__ void __launch_bounds__(256) dbg_cmp(const unsigned* a, const unsigned* b, float* out, size_t npairs, size_t nout) {
    for (size_t i = (size_t)blockIdx.x * 256 + threadIdx.x; i < npairs; i += (size_t)gridDim.x * 256) out[nout / 2 + i] = (a[i] != b[i]) ? 1.0e4f : 0.f;
}
__global__ void __launch_bounds__(256) dbg_zero(float* out, size_t n) {
    for (size_t i = (size_t)blockIdx.x * 256 + threadIdx.x; i < n; i += (size_t)gridDim.x * 256) out[i] = 0.f;
}
#endif
#ifdef MK_DBG_STOP
__global__ void __launch_bounds__(256) dbg_dump(const unsigned short* src, float* out, size_t n) {
    for (size_t i = (size_t)blockIdx.x * 256 + threadIdx.x; i < n; i += (size_t)gridDim.x * 256) out[i] = __uint_as_float((unsigned)src[i] << 16);
}
#endif
#ifdef MK_TAIL
__global__ void __launch_bounds__(256) dbg_tail(unsigned* p) { p[blockIdx.x * 256 + threadIdx.x] = 1u; }
#endif
extern "C" void kernel_launch(void* const* d_in, const int* in_sizes, int n_in, void* d_out, int out_size, void* d_ws, size_t ws_size, hipStream_t stream) {
    static int grid = 0;
    if (grid == 0) {
        if (n_in != 34 || in_sizes[0] != T * D || out_size != T * D || ws_size < WS_END) {
            fprintf(stderr, "kernel_launch: unexpected shapes: n_in %d in0 %d out %d ws %zu (need %zu)\n", n_in, n_in > 0 ? in_sizes[0] : -1, out_size, ws_size, (size_t)WS_END); grid = -1; return; }
        int dev = 0, cus = 0, per_cu = 0;
        if (hipGetDevice(&dev) != hipSuccess || hipDeviceGetAttribute(&cus, hipDeviceAttributeMultiprocessorCount, dev) != hipSuccess) { grid = -1; return; }
        if (hipFuncSetAttribute((const void*)mk_fwd, hipFuncAttributeMaxDynamicSharedMemorySize, LDS_BYTES) != hipSuccess) { fprintf(stderr, "kernel_launch: hipFuncSetAttribute failed\n"); grid = -1; return; }
        if (hipOccupancyMaxActiveBlocksPerMultiprocessor(&per_cu, (const void*)mk_fwd, NTHR, LDS_BYTES) != hipSuccess || per_cu < 1) fprintf(stderr, "kernel_launch: occupancy query says %d\n", per_cu);
        (void)hipGetLastError();
        grid = 256; while (grid > cus) grid >>= 1;
    }
    if (grid < 0) return;
#ifdef MK_SENT
    (void)hipMemsetAsync(d_out, 0xFF, (size_t)T * D * 4, stream);
#endif
#ifdef MK_POISON
    (void)hipMemsetAsync((char*)d_ws, 0xAA, WS_END, stream);
#endif
    (void)hipMemsetAsync((char*)d_ws + WS_CTL, 0, CTL_BYTES, stream);
    Args a{};
    for (int i = 0; i < 34; ++i) a.in[i] = (const float*)d_in[i];
    a.out = (float*)d_out; a.ws = (unsigned char*)d_ws;
#if MK_ONE_LAUNCH
    a.ph_lo = 0; a.ph_hi = NPH;
    hipLaunchKernelGGL(mk_fwd, dim3(grid), dim3(NTHR), LDS_BYTES, stream, a);
#else
#ifdef MK_DBG9
    for (int k = 0; k <= MK_DBG9; ++k) { a.ph_lo = k; a.ph_hi = k + 1; hipLaunchKernelGGL(mk_fwd, dim3(grid), dim3(NTHR), LDS_BYTES, stream, a); }
    a.ph_lo = MK_DBG9; a.ph_hi = MK_DBG9 + 1; hipLaunchKernelGGL(mk_fwd, dim3(grid), dim3(NTHR), LDS_BYTES, stream, a);
    hipLaunchKernelGGL(dbg_copy, dim3(2048), dim3(256), 0, stream, (const u32x4*)((char*)d_ws + MK_DBG_BUF), (u32x4*)((char*)d_ws + MK_DBG_TMP), (size_t)T * D * 2 / 16);
    hipLaunchKernelGGL(mk_fwd, dim3(grid), dim3(NTHR), LDS_BYTES, stream, a);
    hipLaunchKernelGGL(dbg_cmp9, dim3(2048), dim3(256), 0, stream, (const unsigned*)((char*)d_ws + MK_DBG_TMP), (const unsigned*)((char*)d_ws + MK_DBG_BUF), (float*)d_out, (size_t)T * D / 2);
#elif defined(MK_DBG8)
    for (int k = 0; k <= MK_DBG8; ++k) { a.ph_lo = k; a.ph_hi = k + 1; hipLaunchKernelGGL(mk_fwd, dim3(grid), dim3(NTHR), LDS_BYTES, stream, a); }
#ifdef MK_DBG8_TWICE
    a.ph_lo = MK_DBG8; a.ph_hi = MK_DBG8 + 1; hipLaunchKernelGGL(mk_fwd, dim3(grid), dim3(NTHR), LDS_BYTES, stream, a);
#endif
    (void)hipMemcpyAsync(d_out, (char*)d_ws + MK_DBG_BUF, (size_t)T * D * 2, hipMemcpyDeviceToDevice, stream);
#ifndef MK_DBG8_NOMEMSET
    (void)hipMemsetAsync((char*)d_ws + MK_DBG_BUF, 0xAA, (size_t)T * D * 2, stream);
#endif
    a.ph_lo = MK_DBG8; a.ph_hi = MK_DBG8 + 1; hipLaunchKernelGGL(mk_fwd, dim3(grid), dim3(NTHR), LDS_BYTES, stream, a);
    hipLaunchKernelGGL(dbg_cmp, dim3(2048), dim3(256), 0, stream, (const unsigned*)d_out, (const unsigned*)((char*)d_ws + MK_DBG_BUF), (float*)d_out, (size_t)T * D / 2, (size_t)T * D);
    hipLaunchKernelGGL(dbg_zero, dim3(2048), dim3(256), 0, stream, (float*)d_out, (size_t)T * D / 2);
#elif defined(MK_DBG7)
    for (int k = 0; k <= MK_DBG7; ++k) { a.ph_lo = k; a.ph_hi = k + 1; hipLaunchKernelGGL(mk_fwd, dim3(grid), dim3(NTHR), LDS_BYTES, stream, a); }
    hipLaunchKernelGGL(dbg_y2_hash, dim3(2 * T / 4), dim3(256), 0, stream, (const unsigned*)((char*)d_ws + WS_Y2), (unsigned*)((char*)d_ws + 10 * MiB));
    (void)hipMemsetAsync((char*)d_ws + WS_CTL, 0, CTL_BYTES, stream);
    a.flip = 1;
    for (int k = 0; k <= MK_DBG7; ++k) { a.ph_lo = k; a.ph_hi = k + 1; hipLaunchKernelGGL(mk_fwd, dim3(grid), dim3(NTHR), LDS_BYTES, stream, a); }
    hipLaunchKernelGGL(dbg_y2_hash, dim3(2 * T / 4), dim3(256), 0, stream, (const unsigned*)((char*)d_ws + WS_Y2), (unsigned*)((char*)d_ws + 10 * MiB + 512 * 1024));
    hipLaunchKernelGGL(dbg_cmp7, dim3(T / 4), dim3(256), 0, stream, (const unsigned*)((char*)d_ws + 10 * MiB), (const unsigned*)((char*)d_ws + 10 * MiB + 512 * 1024), (float*)d_out);
#elif defined(MK_DBG6)
    for (int k = 0; k <= MK_DBG6; ++k) { a.ph_lo = k; a.ph_hi = k + 1; hipLaunchKernelGGL(mk_fwd, dim3(grid), dim3(NTHR), LDS_BYTES, stream, a); }
    hipLaunchKernelGGL(dbg_hs_hash, dim3(64, 16), dim3(256), 0, stream, (const int*)((char*)d_ws + WS_LIST), (const unsigned*)((char*)d_ws + WS_CTL) + CW_CNT + MK_DBG6_LAYER * 16 * 64, (const unsigned*)((char*)d_ws + WS_HS), (unsigned*)((char*)d_ws + 10 * MiB));
    (void)hipMemsetAsync((char*)d_ws + WS_CTL, 0, CTL_BYTES, stream);
    a.flip = 1;
    for (int k = 0; k <= MK_DBG6; ++k) { a.ph_lo = k; a.ph_hi = k + 1; hipLaunchKernelGGL(mk_fwd, dim3(grid), dim3(NTHR), LDS_BYTES, stream, a); }
    hipLaunchKernelGGL(dbg_hs_hash, dim3(64, 16), dim3(256), 0, stream, (const int*)((char*)d_ws + WS_LIST), (const unsigned*)((char*)d_ws + WS_CTL) + CW_CNT + MK_DBG6_LAYER * 16 * 64, (const unsigned*)((char*)d_ws + WS_HS), (unsigned*)((char*)d_ws + 10 * MiB + 512 * 1024));
    hipLaunchKernelGGL(dbg_cmp6, dim3(T / 4), dim3(256), 0, stream, (const unsigned*)((char*)d_ws + 10 * MiB), (const unsigned*)((char*)d_ws + 10 * MiB + 512 * 1024), (float*)d_out);
#elif defined(MK_DBG5)
    (void)hipMemsetAsync((char*)d_ws + 10 * MiB, 0, (2 * T + 64) * 4, stream);
    for (int k = 0; k <= MK_DBG5; ++k) { a.ph_lo = k; a.ph_hi = k + 1; hipLaunchKernelGGL(mk_fwd, dim3(grid), dim3(NTHR), LDS_BYTES, stream, a); }
    hipLaunchKernelGGL(dbg_list_mark, dim3(64, 16), dim3(256), 0, stream, (const int*)((char*)d_ws + WS_LIST), (const unsigned*)((char*)d_ws + WS_CTL) + CW_CNT + MK_DBG5_LAYER * 16 * 64, (int*)((char*)d_ws + 10 * MiB));
    hipLaunchKernelGGL(dbg_list_out, dim3(T / 4), dim3(256), 0, stream, (const int*)((char*)d_ws + 10 * MiB), (float*)d_out);
#elif defined(MK_DBG4)
    a.flip = 0;
    for (int k = 0; k < NPH; ++k) { a.ph_lo = k; a.ph_hi = k + 1; hipLaunchKernelGGL(mk_fwd, dim3(grid), dim3(NTHR), LDS_BYTES, stream, a); }
    (void)hipMemsetAsync((char*)d_ws + 12 * MiB, 0xAA, WS_END - 12 * MiB, stream);
    (void)hipMemsetAsync((char*)d_ws, 0xAA, 10 * MiB, stream);
    hipLaunchKernelGGL(dbg_sweep, dim3(4096), dim3(256), 0, stream, (const unsigned*)d_in[31], (size_t)64 * 1024 * 1024, (unsigned*)((char*)d_ws + 9 * MiB));
    (void)hipMemsetAsync((char*)d_ws + WS_CTL, 0, CTL_BYTES, stream);
    a.flip = 1;
    for (int k = 0; k < NPH; ++k) { a.ph_lo = k; a.ph_hi = k + 1; hipLaunchKernelGGL(mk_fwd, dim3(grid), dim3(NTHR), LDS_BYTES, stream, a); }
    hipLaunchKernelGGL(dbg_cmp4, dim3(T / 4), dim3(256), 0, stream, (const unsigned*)((char*)d_ws + 10 * MiB), (const unsigned*)((char*)d_ws + 11 * MiB), (float*)d_out);
#elif defined(MK_DBG3)
    for (int k = 0; k < NPH; ++k) { a.ph_lo = k; a.ph_hi = k + 1; hipLaunchKernelGGL(mk_fwd, dim3(grid), dim3(NTHR), LDS_BYTES, stream, a); }
    hipLaunchKernelGGL(dbg_hash, dim3(T / 4), dim3(256), 0, stream, (const unsigned*)d_out, (unsigned*)((char*)d_ws + 10 * MiB));
#ifdef MK_DBG3_POISON
    (void)hipMemsetAsync((char*)d_ws + 12 * MiB, 0xAA, WS_END - 12 * MiB, stream);
    (void)hipMemsetAsync((char*)d_ws, 0xAA, 10 * MiB, stream);
#endif
    (void)hipMemsetAsync((char*)d_ws + WS_CTL, 0, CTL_BYTES, stream);
    a.flip = 1;
    for (int k = 0; k < NPH; ++k) { a.ph_lo = k; a.ph_hi = k + 1; hipLaunchKernelGGL(mk_fwd, dim3(grid), dim3(NTHR), LDS_BYTES, stream, a); }
    hipLaunchKernelGGL(dbg_hash, dim3(T / 4), dim3(256), 0, stream, (const unsigned*)d_out, (unsigned*)((char*)d_ws + 11 * MiB));
    hipLaunchKernelGGL(dbg_cmp3, dim3(T / 4), dim3(256), 0, stream, (const unsigned*)((char*)d_ws + 10 * MiB), (const unsigned*)((char*)d_ws + 11 * MiB), (float*)d_out);
#elif defined(MK_DBG2)
    for (int k = 0; k <= MK_DBG2; ++k) { a.ph_lo = k; a.ph_hi = k + 1; hipLaunchKernelGGL(mk_fwd, dim3(grid), dim3(NTHR), LDS_BYTES, stream, a); }
    (void)hipMemcpyAsync(d_out, (char*)d_ws + MK_DBG_BUF, (size_t)T * D * 2, hipMemcpyDeviceToDevice, stream);
    (void)hipMemsetAsync((char*)d_ws, 0xAA, WS_END, stream);
    (void)hipMemsetAsync((char*)d_ws + WS_CTL, 0, CTL_BYTES, stream);
    a.flip = 1;
    for (int k = 0; k <= MK_DBG2; ++k) { a.ph_lo = k; a.ph_hi = k + 1; hipLaunchKernelGGL(mk_fwd, dim3(grid), dim3(NTHR), LDS_BYTES, stream, a); }
    hipLaunchKernelGGL(dbg_cmp, dim3(2048), dim3(256), 0, stream, (const unsigned*)d_out, (const unsigned*)((char*)d_ws + MK_DBG_BUF), (float*)d_out, (size_t)T * D / 2, (size_t)T * D);
    hipLaunchKernelGGL(dbg_zero, dim3(2048), dim3(256), 0, stream, (float*)d_out, (size_t)T * D / 2);
#elif defined(MK_DBG_STOP)
    for (int k = 0; k <= MK_DBG_STOP; ++k) { a.ph_lo = k; a.ph_hi = k + 1; hipLaunchKernelGGL(mk_fwd, dim3(grid), dim3(NTHR), LDS_BYTES, stream, a); }
#ifdef MK_DBG_F32
    (void)hipMemcpyAsync(d_out, (char*)d_ws + MK_DBG_BUF, (size_t)T * D * 4, hipMemcpyDeviceToDevice, stream);
#else
    hipLaunchKernelGGL(dbg_dump, dim3(2048), dim3(256), 0, stream, (const unsigned short*)((char*)d_ws + MK_DBG_BUF), (float*)d_out, (size_t)T * D);
#endif
#else
    for (int k = 0; k < NPH; ++k) { a.ph_lo = k; a.ph_hi = k + 1; hipLaunchKernelGGL(mk_fwd, dim3(grid), dim3(NTHR), LDS_BYTES, stream, a); }
#endif
#endif
#ifdef MK_TAIL
    hipLaunchKernelGGL(dbg_tail, dim3(256), dim3(256), 0, stream, (unsigned*)((char*)d_ws + 10 * MiB));
#endif
    const hipError_t le = hipPeekAtLastError();
    if (le != hipSuccess) fprintf(stderr, "kernel_launch: launch failed: %s\n", hipGetErrorName(le));
}
```
